# Optimizing an MI355X kernel written in HIP

```python
import math
import jax, jax.numpy as jnp
from jax import lax
import numpy as np

D_MODEL = 1024
BATCH = 8
SEQ = 2048
DEPTH = 4

CHUNK = 64
Q_BLOCK = 128
N_MEM = 256
EPS = 1e-6
F32 = jnp.float32

GLA_HEADS = 4
GLA_DK = 32
GLA_DV = 64
GLA_GATE_RANK = 16
GLA_GATE_TAU = 16.0
GLA_QK = GLA_HEADS * GLA_DK
GLA_V = GLA_HEADS * GLA_DV
S5_GROUPS = 16
S5_GROUP_CH = 16
S5_STATE = 64
S5_WIDTH = S5_GROUPS * S5_GROUP_CH
S5_DT_MIN = 1e-3
S5_DT_MAX = 1e-1
FOX_HEADS = 8
FOX_DH = 64
FOX_W = FOX_HEADS * FOX_DH
XA_HEADS = 4
XA_DH = D_MODEL // XA_HEADS
D_FF = 2816
N_BRANCH = 3
IN_SIZES = (GLA_QK, GLA_QK, GLA_V, GLA_V, GLA_GATE_RANK, S5_WIDTH, FOX_W, FOX_W, FOX_W, FOX_HEADS, N_BRANCH * D_MODEL)
D_IN = GLA_QK + GLA_QK + GLA_V + GLA_V + GLA_GATE_RANK + S5_WIDTH + 3 * FOX_W + FOX_HEADS + N_BRANCH * D_MODEL

kernel_name = 'hybrid_gla_s5_fox_macaron_sandwich'


def rms_norm(x, g):
    xf = x.astype(F32)
    y = xf * lax.rsqrt(jnp.mean(xf * xf, axis=-1, keepdims=True) + EPS)
    return (y * g.astype(F32)).astype(x.dtype)


def swiglu(h, w_gu, w_down):
    gate, up = jnp.split(h @ w_gu, 2, axis=-1)
    return (jax.nn.silu(gate) * up) @ w_down


def split_cols(p, sizes):
    outs, off = [], 0
    for s in sizes:
        outs.append(p[..., off:off + s])
        off += s
    return outs


def gla_chunked(q, k, v, log_a):
    b, l, h, dk = q.shape
    dv = v.shape[-1]
    n = l // CHUNK

    def to_chunks(t):
        return t.astype(F32).reshape(b, n, CHUNK, h, t.shape[-1]).transpose(0, 3, 1, 2, 4)

    qc = to_chunks(q) * (dk ** -0.5)
    kc = to_chunks(k)
    vc = to_chunks(v)
    g = jnp.cumsum(to_chunks(log_a), axis=3)
    g_last = g[:, :, :, -1:, :]
    eg, ieg = jnp.exp(g), jnp.exp(-g)
    q_fwd = qc * eg
    a_fwd = jnp.einsum('bhnid,bhnjd->bhnij', q_fwd, kc * ieg)
    a_bwd = jnp.einsum('bhnid,bhnjd->bhnij', qc * ieg, kc * eg)
    lower = jnp.tril(jnp.ones((CHUNK, CHUNK), dtype=bool))
    attn = jnp.where(lower, a_fwd, a_bwd)
    o_intra = jnp.einsum('bhnij,bhnje->bhnie', attn, vc)
    ds = jnp.einsum('bhncd,bhnce->nbhde', kc * jnp.exp(g_last - g), vc)
    decay = jnp.exp(g_last[:, :, :, 0, :]).transpose(2, 0, 1, 3)

    def step(s, inp):
        d, dsn = inp
        return d[..., None] * s + dsn, s

    _, s_prev = lax.scan(step, jnp.zeros((b, h, dk, dv), F32), (decay, ds))
    o_inter = jnp.einsum('bhncd,nbhde->bhnce', q_fwd, s_prev)
    o = (o_intra + o_inter).transpose(0, 2, 3, 1, 4).reshape(b, l, h, dv)
    return o.astype(v.dtype)


def s5_ssm(u, a_re, a_im, log_dt, b_re, b_im, c_re, c_im, d_skip):
    bsz, l, _ = u.shape
    uf = u.astype(F32).reshape(bsz, l, S5_GROUPS, S5_GROUP_CH)
    lam_re = jnp.minimum(a_re.astype(F32), -1e-4)
    lam_im = a_im.astype(F32)
    dt = jnp.exp(log_dt.astype(F32))[:, None]
    mag = jnp.exp(lam_re * dt)
    ab_re = mag * jnp.cos(lam_im * dt)
    ab_im = mag * jnp.sin(lam_im * dt)
    den = lam_re * lam_re + lam_im * lam_im
    z_re = ((ab_re - 1.0) * lam_re + ab_im * lam_im) / den
    z_im = (ab_im * lam_re - (ab_re - 1.0) * lam_im) / den
    br, bi = b_re.astype(F32), b_im.astype(F32)
    bb_re = z_re[..., None] * br - z_im[..., None] * bi
    bb_im = z_re[..., None] * bi + z_im[..., None] * br
    bu_re = jnp.einsum('gph,blgh->blgp', bb_re, uf)
    bu_im = jnp.einsum('gph,blgh->blgp', bb_im, uf)

    def combine(e1, e2):
        a1r, a1i, b1r, b1i = e1
        a2r, a2i, b2r, b2i = e2
        return (a2r * a1r - a2i * a1i, a2r * a1i + a2i * a1r,
                a2r * b1r - a2i * b1i + b2r, a2r * b1i + a2i * b1r + b2i)

    shp = bu_re.shape
    _, _, x_re, x_im = lax.associative_scan(
        combine, (jnp.broadcast_to(ab_re, shp), jnp.broadcast_to(ab_im, shp), bu_re, bu_im), axis=1)
    y = (jnp.einsum('ghp,blgp->blgh', c_re.astype(F32), x_re)
         - jnp.einsum('ghp,blgp->blgh', c_im.astype(F32), x_im))
    y = y + d_skip.astype(F32).reshape(S5_GROUPS, S5_GROUP_CH) * uf
    return y.reshape(bsz, l, S5_WIDTH).astype(u.dtype)


def forgetting_attention(q, k, v, log_f):
    b, l, h, dh = q.shape
    fcum = jnp.cumsum(log_f, axis=1).transpose(0, 2, 1)
    qh, kh, vh = (t.transpose(0, 2, 1, 3) for t in (q, k, v))
    scale = dh ** -0.5
    neg = jnp.finfo(F32).min
    outs = []
    for i in range(l // Q_BLOCK):
        s0, s1 = i * Q_BLOCK, (i + 1) * Q_BLOCK
        logits = (jnp.einsum('bhqd,bhkd->bhqk', qh[:, :, s0:s1], kh[:, :, :s1]).astype(F32) * scale
                  + fcum[:, :, s0:s1, None] - fcum[:, :, None, :s1])
        mask = (s0 + jnp.arange(Q_BLOCK))[:, None] >= jnp.arange(s1)[None, :]
        p = jax.nn.softmax(jnp.where(mask, logits, neg), axis=-1)
        outs.append(jnp.einsum('bhqk,bhkd->bhqd', p.astype(vh.dtype), vh[:, :, :s1]))
    o = jnp.concatenate(outs, axis=2)
    return o.transpose(0, 2, 1, 3).reshape(b, l, h * dh)


def hybrid_mixer(h, w_in, gla_gate_w, gla_gate_b, gla_norm_g, w_gla_up,
                 s5_a_re, s5_a_im, s5_log_dt, s5_b_re, s5_b_im, s5_c_re, s5_c_im, s5_d,
                 s5_glu_w, s5_glu_b, w_s5_up, fox_f_b, w_fox_up, w_mix_out):
    b, l, _ = h.shape
    (gq, gk, gv, gr, gdown, su, fq, fk, fv, ff, gates) = split_cols(h @ w_in, IN_SIZES)
    log_a = jax.nn.log_sigmoid((gdown @ gla_gate_w + gla_gate_b).astype(F32)) / GLA_GATE_TAU
    o = gla_chunked(gq.reshape(b, l, GLA_HEADS, GLA_DK), gk.reshape(b, l, GLA_HEADS, GLA_DK),
                    gv.reshape(b, l, GLA_HEADS, GLA_DV), log_a.reshape(b, l, GLA_HEADS, GLA_DK))
    o = rms_norm(o, gla_norm_g.reshape(GLA_HEADS, GLA_DV)).reshape(b, l, GLA_V)
    gla_out = (o * jax.nn.silu(gr)) @ w_gla_up
    y = jax.nn.gelu(s5_ssm(su, s5_a_re, s5_a_im, s5_log_dt, s5_b_re, s5_b_im, s5_c_re, s5_c_im, s5_d))
    s5_out = (y * jax.nn.sigmoid(y @ s5_glu_w + s5_glu_b)) @ w_s5_up
    log_f = jax.nn.log_sigmoid(ff.astype(F32) + fox_f_b.astype(F32))
    fo = forgetting_attention(fq.reshape(b, l, FOX_HEADS, FOX_DH), fk.reshape(b, l, FOX_HEADS, FOX_DH),
                              fv.reshape(b, l, FOX_HEADS, FOX_DH), log_f)
    fox_out = fo @ w_fox_up
    g = jax.nn.sigmoid(gates.reshape(b, l, N_BRANCH, D_MODEL))
    mix = g[:, :, 0] * gla_out + g[:, :, 1] * s5_out + g[:, :, 2] * fox_out
    return mix @ w_mix_out


def memory_cross_attention(h, mem_n, w_q, w_kv, w_o):
    b, l, _ = h.shape
    m = mem_n.shape[1]
    q = (h @ w_q).reshape(b, l, XA_HEADS, XA_DH)
    k, v = jnp.split(mem_n @ w_kv, 2, axis=-1)
    k = k.reshape(b, m, XA_HEADS, XA_DH)
    v = v.reshape(b, m, XA_HEADS, XA_DH)
    logits = jnp.einsum('blhd,bmhd->bhlm', q, k).astype(F32) * (XA_DH ** -0.5)
    p = jax.nn.softmax(logits, axis=-1)
    o = jnp.einsum('bhlm,bmhd->blhd', p.astype(v.dtype), v).reshape(b, l, D_MODEL)
    return o @ w_o


def _normal(key, shape, scale):
    return jax.random.normal(key, shape, F32) * scale


def _gain(key, shape):
    return 1.0 + 0.02 * jax.random.normal(key, shape, F32)


def setup_inputs(seed: int = 0) -> dict:
    key = jax.random.key(seed)
    ks = list(jax.random.split(key, 48))
    L, D, P, G, HC = DEPTH, D_MODEL, S5_STATE, S5_GROUPS, S5_GROUP_CH
    inp = {}
    inp['x'] = _normal(ks[0], (BATCH, SEQ, D), 1.0)
    inp['mem'] = _normal(ks[1], (BATCH, N_MEM, D), 1.0)
    inp['ffn1_pre_g'] = _gain(ks[2], (L, D))
    inp['ffn1_w_gu'] = _normal(ks[3], (L, D, 2 * D_FF), D ** -0.5)
    inp['ffn1_w_down'] = _normal(ks[4], (L, D_FF, D), D_FF ** -0.5)
    inp['ffn1_post_g'] = _gain(ks[5], (L, D))
    inp['mix_pre_g'] = _gain(ks[6], (L, D))
    inp['w_in'] = _normal(ks[7], (L, D, D_IN), D ** -0.5)
    inp['gla_gate_w'] = _normal(ks[8], (L, GLA_GATE_RANK, GLA_QK), GLA_GATE_RANK ** -0.5)
    inp['gla_gate_b'] = _normal(ks[9], (L, GLA_QK), 0.1)
    inp['gla_norm_g'] = _gain(ks[10], (L, GLA_V))
    inp['w_gla_up'] = _normal(ks[11], (L, GLA_V, D), GLA_V ** -0.5)
    inp['s5_a_re'] = -0.5 + _normal(ks[12], (L, G, P), 0.01)
    inp['s5_a_im'] = jnp.pi * jnp.arange(P, dtype=F32) + _normal(ks[13], (L, G, P), 0.01)
    inp['s5_log_dt'] = jax.random.uniform(ks[14], (L, G), F32, math.log(S5_DT_MIN), math.log(S5_DT_MAX))
    inp['s5_b_re'] = _normal(ks[15], (L, G, P, HC), (HC ** -0.5) * math.sqrt(0.5))
    inp['s5_b_im'] = _normal(ks[16], (L, G, P, HC), (HC ** -0.5) * math.sqrt(0.5))
    inp['s5_c_re'] = _normal(ks[17], (L, G, HC, P), (P ** -0.5) * math.sqrt(0.5))
    inp['s5_c_im'] = _normal(ks[18], (L, G, HC, P), (P ** -0.5) * math.sqrt(0.5))
    inp['s5_d'] = _normal(ks[19], (L, S5_WIDTH), 1.0)
    inp['s5_glu_w'] = _normal(ks[20], (L, S5_WIDTH, S5_WIDTH), S5_WIDTH ** -0.5)
    inp['s5_glu_b'] = _normal(ks[21], (L, S5_WIDTH), 0.01)
    inp['w_s5_up'] = _normal(ks[22], (L, S5_WIDTH, D), S5_WIDTH ** -0.5)
    inp['fox_f_b'] = 2.0 + _normal(ks[23], (L, FOX_HEADS), 0.1)
    inp['w_fox_up'] = _normal(ks[24], (L, FOX_W, D), FOX_W ** -0.5)
    inp['w_mix_out'] = _normal(ks[25], (L, D, D), D ** -0.5)
    inp['mix_post_g'] = _gain(ks[26], (L, D))
    inp['xa_pre_g'] = _gain(ks[27], (L, D))
    inp['xa_mem_g'] = _gain(ks[28], (L, D))
    inp['xa_w_q'] = _normal(ks[29], (L, D, D), D ** -0.5)
    inp['xa_w_kv'] = _normal(ks[30], (L, D, 2 * D), D ** -0.5)
    inp['xa_w_o'] = _normal(ks[31], (L, D, D), D ** -0.5)
    inp['xa_post_g'] = _gain(ks[32], (L, D))
    inp['ffn2_pre_g'] = _gain(ks[33], (L, D))
    inp['ffn2_w_gu'] = _normal(ks[34], (L, D, 2 * D_FF), D ** -0.5)
    inp['ffn2_w_down'] = _normal(ks[35], (L, D_FF, D), D_FF ** -0.5)
    inp['ffn2_post_g'] = _gain(ks[36], (L, D))
    return inp


def reference(x, mem, ffn1_pre_g, ffn1_w_gu, ffn1_w_down, ffn1_post_g,
              mix_pre_g, w_in, gla_gate_w, gla_gate_b, gla_norm_g, w_gla_up,
              s5_a_re, s5_a_im, s5_log_dt, s5_b_re, s5_b_im, s5_c_re, s5_c_im, s5_d,
              s5_glu_w, s5_glu_b, w_s5_up, fox_f_b, w_fox_up, w_mix_out, mix_post_g,
              xa_pre_g, xa_mem_g, xa_w_q, xa_w_kv, xa_w_o, xa_post_g,
              ffn2_pre_g, ffn2_w_gu, ffn2_w_down, ffn2_post_g):
    for l in range(DEPTH):
        h = rms_norm(x, ffn1_pre_g[l])
        x = x + 0.5 * rms_norm(swiglu(h, ffn1_w_gu[l], ffn1_w_down[l]), ffn1_post_g[l])
        h = rms_norm(x, mix_pre_g[l])
        y = hybrid_mixer(h, w_in[l], gla_gate_w[l], gla_gate_b[l], gla_norm_g[l], w_gla_up[l],
                         s5_a_re[l], s5_a_im[l], s5_log_dt[l], s5_b_re[l], s5_b_im[l],
                         s5_c_re[l], s5_c_im[l], s5_d[l], s5_glu_w[l], s5_glu_b[l], w_s5_up[l],
                         fox_f_b[l], w_fox_up[l], w_mix_out[l])
        x = x + rms_norm(y, mix_post_g[l])
        h = rms_norm(x, xa_pre_g[l])
        mem_n = rms_norm(mem, xa_mem_g[l])
        x = x + rms_norm(memory_cross_attention(h, mem_n, xa_w_q[l], xa_w_kv[l], xa_w_o[l]), xa_post_g[l])
        h = rms_norm(x, ffn2_pre_g[l])
        x = x + 0.5 * rms_norm(swiglu(h, ffn2_w_gu[l], ffn2_w_down[l]), ffn2_post_g[l])
    return x
```

```cpp
#include <hip/hip_runtime.h>
#include <hip/hip_cooperative_groups.h>
#include <cstdio>
#include <cstdint>
namespace cg = cooperative_groups;
namespace pg8 {
#define PG8_LAS __attribute__((address_space(3)))
typedef unsigned short bf16_t;
typedef short bf16x8 __attribute__((ext_vector_type(8)));
typedef float f32x4 __attribute__((ext_vector_type(4)));
typedef unsigned u32x4 __attribute__((ext_vector_type(4)));
constexpr int BM = 256, BK = 64, HALF = 128, HTB = HALF * BK * 2  , STAGE_BYTES = 8 * HTB, NXCD = 8, WGM = 8;

__host__ __device__ __forceinline__ int lds_byte(int r, int c) { const int st = (r >> 4) * 2 + (c >> 5), rr = r & 15, cc = c & 31, ob = rr * 64 + cc * 2; return st * 1024 + (ob ^ (((ob >> 9) & 1) << 5)); }
__host__ __device__ __forceinline__ void stage_rc(int b, int& R, int& C) { const int st = b / 1024, sb = b % 1024, swz = sb ^ (((sb >> 9) & 1) << 5); R = (st >> 1) * 16 + swz / 64; C = (st & 1) * 32 + (swz % 64) / 2; }
__host__ __device__ __forceinline__ int perm32(int rho) { const int n = rho >> 4, i = rho & 15; return 8 * (i >> 2) + 4 * n + (i & 3); }

struct Unit { int pm, pn; };
struct Gemm { const bf16_t* A; const bf16_t* Bt; int M, N, K; };

struct StaticOrder {
    int nM, nN, nwg, G, c;
    __host__ __device__ void init(int M, int N, int G_, int c_) { nM = M / BM; nN = N / BM; nwg = nM * nN; G = G_; c = c_; }
    __host__ __device__ bool next(int i, Unit& u) const {
        const long L = (long)i * G + c; if (L >= nwg) return false;
        int wgid = (int)L; { const int q = nwg / NXCD, r = nwg % NXCD, xcd = wgid % NXCD, off = wgid / NXCD; wgid = (xcd < r ? xcd * (q + 1) : r * (q + 1) + (xcd - r) * q) + off; }
        const int nig = WGM * nN, gid = wgid / nig, fm = gid * WGM, gsz = (nM - fm) < WGM ? (nM - fm) : WGM;
        u.pm = fm + ((wgid % nig) % gsz); u.pn = (wgid % nig) / gsz; return true;
    }
    __device__ __forceinline__ void a_ready(const Unit&) const {}
    __device__ __forceinline__ void done(const Unit&) const {}
};

__device__ __forceinline__ unsigned cvt_pk_bf16(float lo, float hi) { unsigned r; asm volatile("v_cvt_pk_bf16_f32 %0, %1, %2" : "=v"(r) : "v"(lo), "v"(hi)); return r; }
typedef float f32x2 __attribute__((ext_vector_type(2)));
typedef unsigned u32x2 __attribute__((ext_vector_type(2)));
__device__ __forceinline__ float fast_sigmoid(float x) { return __builtin_amdgcn_rcpf(1.0f + __expf(-x)); }
__device__ __forceinline__ float bf_lo(unsigned w) { return __uint_as_float(w << 16); }
__device__ __forceinline__ float bf_hi(unsigned w) { return __uint_as_float(w & 0xffff0000u); }
struct EpiBf16 {
    static constexpr bool PERM = true, AFTER_DRAIN = false;
    bf16_t* O; int ldc;
    __device__ __forceinline__ void operator()(const f32x4 (&acc)[2][2][4][2], const Unit& u, int wr, int wc, int fr, int fq) const {
        const int row0 = u.pm * BM + wr * 64 + fr; const int col0 = u.pn * BM + wc * 32 + 8 * fq;
#pragma unroll
        for (int ai = 0; ai < 2; ++ai)
#pragma unroll
            for (int m = 0; m < 4; ++m) { bf16_t* rowp = O + (size_t)(row0 + ai * HALF + m * 16) * ldc + col0;
#pragma unroll
                for (int bj = 0; bj < 2; ++bj) { const f32x4 v0 = acc[ai][bj][m][0], v1 = acc[ai][bj][m][1];
                    u32x4 w; w.x = cvt_pk_bf16(v0[0], v0[1]); w.y = cvt_pk_bf16(v0[2], v0[3]); w.z = cvt_pk_bf16(v1[0], v1[1]); w.w = cvt_pk_bf16(v1[2], v1[3]);
                    *(u32x4*)(rowp + bj * HALF) = w; } }
    }
};
struct EpiSwiGLU {
    static constexpr bool PERM = true, AFTER_DRAIN = false;
    bf16_t* O; int ldc;
    __device__ __forceinline__ void operator()(const f32x4 (&acc)[2][2][4][2], const Unit& u, int wr, int wc, int fr, int fq) const {
        const int row0 = u.pm * BM + wr * 64 + fr; const int col0 = u.pn * HALF + wc * 32 + 8 * fq;
#pragma unroll
        for (int ai = 0; ai < 2; ++ai)
#pragma unroll
            for (int m = 0; m < 4; ++m) { bf16_t* rowp = O + (size_t)(row0 + ai * HALF + m * 16) * ldc + col0;
                float r[8];
#pragma unroll
                for (int n = 0; n < 2; ++n)
#pragma unroll
                    for (int j = 0; j < 4; ++j) { const float g = acc[ai][0][m][n][j], up = acc[ai][1][m][n][j]; r[n * 4 + j] = g * fast_sigmoid(g) * up; }
                u32x4 w; w.x = cvt_pk_bf16(r[0], r[1]); w.y = cvt_pk_bf16(r[2], r[3]); w.z = cvt_pk_bf16(r[4], r[5]); w.w = cvt_pk_bf16(r[6], r[7]);
                *(u32x4*)rowp = w; }
    }
};
struct EpiF32 {
    static constexpr bool PERM = false, AFTER_DRAIN = false;
    float* O; int ldc;
    __device__ __forceinline__ void operator()(const f32x4 (&acc)[2][2][4][2], const Unit& u, int wr, int wc, int fr, int fq) const {
        const int row0 = u.pm * BM + wr * 64 + fr; const int col0 = u.pn * BM + wc * 32 + 4 * fq;
#pragma unroll
        for (int ai = 0; ai < 2; ++ai)
#pragma unroll
            for (int m = 0; m < 4; ++m) { float* rowp = O + (size_t)(row0 + ai * HALF + m * 16) * ldc + col0;
#pragma unroll
                for (int bj = 0; bj < 2; ++bj)
#pragma unroll
                    for (int n = 0; n < 2; ++n) *(f32x4*)(rowp + bj * HALF + n * 16) = acc[ai][bj][m][n]; }
    }
};
template <int MODE> struct EpiMerge {
    static constexpr bool PERM = false, AFTER_DRAIN = false;
    float* F; bf16_t* B; const bf16_t* G; int ldg;
    __device__ __forceinline__ void operator()(const f32x4 (&acc)[2][2][4][2], const Unit& u, int wr, int wc, int fr, int fq) const {
        const int row0 = u.pm * BM + wr * 64 + fr; const int col0 = u.pn * BM + wc * 32 + 4 * fq;
#pragma unroll
        for (int ai = 0; ai < 2; ++ai)
#pragma unroll
            for (int m = 0; m < 4; ++m) { const size_t row = (size_t)(row0 + ai * HALF + m * 16);
#pragma unroll
                for (int bj = 0; bj < 2; ++bj)
#pragma unroll
                    for (int n = 0; n < 2; ++n) { const int c = col0 + bj * HALF + n * 16;
                        const u32x2 gw = *(const u32x2*)(G + row * ldg + c);
                        f32x4 s; s[0] = fast_sigmoid(bf_lo(gw.x)); s[1] = fast_sigmoid(bf_hi(gw.x)); s[2] = fast_sigmoid(bf_lo(gw.y)); s[3] = fast_sigmoid(bf_hi(gw.y));
                        f32x4 v = s * acc[ai][bj][m][n];
                        float* fp = F + row * 1024 + c;
                        if (MODE >= 1) v += *(const f32x4*)fp;
                        if (MODE <= 1) *(f32x4*)fp = v;
                        else { u32x2 w; w.x = cvt_pk_bf16(v[0], v[1]); w.y = cvt_pk_bf16(v[2], v[3]); *(u32x2*)(B + row * 1024 + c) = w; } } }
    }
};
template <class Epi, class Sched, bool ALIGN_EPI = false, bool SP2 = false>
__device__ __forceinline__ void gemm_phase(PG8_LAS unsigned char* lds, const Gemm g, const Sched& S, const Epi& E, const int tid) {
    const int wid = __builtin_amdgcn_readfirstlane(tid >> 6), lane = tid & 63, wr = wid >> 2, wc = wid & 3, fr = lane & 15, fq = lane >> 4;
    const int K = g.K, nt = K / BK;
    unsigned voffA[2], voffB[2];
#pragma unroll
    for (int i = 0; i < 2; ++i) { int R, C; stage_rc(tid * 16 + i * 8192, R, C); const int Rb = Epi::PERM ? ((R & ~31) + perm32(R & 31)) : R;
        voffA[i] = (unsigned)(R * K + C) * 2u; voffB[i] = (unsigned)(Rb * K + C) * 2u; }
    const size_t kstep = (size_t)(BK * 2);
    const size_t hstep = (size_t)HALF * K * 2;
    const size_t tstep = 2 * hstep;
    const unsigned ldsw = (unsigned)wid * 1024u;
    const int aoff = lds_byte(wr * 64 + fr, fq * 8), boff = lds_byte(wc * 32 + fr, fq * 8);
#define PG8_SA(b, h) (((b) * 2 + (h)) * HTB)
#define PG8_SB(b, h) ((4 + (b) * 2 + (h)) * HTB)
#define PG8_STAGE(bufoff, gbase, voff) do { _Pragma("unroll") for (int _i = 0; _i < 2; ++_i) \
        __builtin_amdgcn_global_load_lds((const unsigned*)((const char*)(gbase) + (voff)[_i]), (PG8_LAS unsigned*)(lds + (bufoff) + ldsw + _i * 8192), 16, 0, 0); } while (0)
#define PG8_LDA(dst, b, h) do { _Pragma("unroll") for (int m = 0; m < 4; ++m) _Pragma("unroll") for (int k = 0; k < 2; ++k) dst[m][k] = *(const PG8_LAS bf16x8*)(lds + PG8_SA(b, h) + aoff + m * 2048 + k * 1024); } while (0)
#define PG8_LDB(dst, b, h) do { _Pragma("unroll") for (int n = 0; n < 2; ++n) _Pragma("unroll") for (int k = 0; k < 2; ++k) dst[n][k] = *(const PG8_LAS bf16x8*)(lds + PG8_SB(b, h) + boff + n * 2048 + k * 1024); } while (0)
#define PG8_MMA(ai, bj, At, Bt) do { __builtin_amdgcn_s_setprio(1); _Pragma("unroll") for (int m = 0; m < 4; ++m) _Pragma("unroll") for (int n = 0; n < 2; ++n) _Pragma("unroll") for (int k = 0; k < 2; ++k) \
        acc[ai][bj][m][n] = __builtin_amdgcn_mfma_f32_16x16x32_bf16(Bt[n][k], At[m][k], acc[ai][bj][m][n], 0, 0, 0); __builtin_amdgcn_s_setprio(0); } while (0)
#define PG8_WAIT_V(n) asm volatile("s_waitcnt vmcnt(" #n ")" ::: "memory")
#define PG8_WAIT_L(n) asm volatile("s_waitcnt lgkmcnt(" #n ")" ::: "memory")
#define PG8_BAR __builtin_amdgcn_s_barrier()
#define PG8_SCHED __builtin_amdgcn_sched_barrier(0)
    Unit cur, nxt; int ui = 0;
    if (!S.next(0, cur)) return;
    f32x4 acc[2][2][4][2];
#pragma unroll
    for (int a = 0; a < 2; ++a)
#pragma unroll
        for (int b = 0; b < 2; ++b)
#pragma unroll
            for (int m = 0; m < 4; ++m)
#pragma unroll
                for (int n = 0; n < 2; ++n) acc[a][b][m][n] = (f32x4){0.f, 0.f, 0.f, 0.f};
    bf16x8 At[4][2], B0[2][2], B1[2][2];
    const char* cA = (const char*)g.A + (size_t)cur.pm * tstep; const char* cB = (const char*)g.Bt + (size_t)cur.pn * tstep;
    S.a_ready(cur);
    if constexpr (SP2) {
        PG8_STAGE(PG8_SB(0, 0), cB, voffB); PG8_STAGE(PG8_SB(0, 1), cB + hstep, voffB); PG8_STAGE(PG8_SA(0, 0), cA, voffA); PG8_STAGE(PG8_SA(0, 1), cA + hstep, voffA);
        if (wr == 1) PG8_BAR;
        PG8_WAIT_V(2); PG8_BAR;
        PG8_STAGE(PG8_SB(1, 0), cB + kstep, voffB); PG8_STAGE(PG8_SA(1, 0), cA + kstep, voffA); PG8_STAGE(PG8_SB(1, 1), cB + hstep + kstep, voffB);
        PG8_WAIT_V(6); PG8_BAR;
    } else {
        PG8_STAGE(PG8_SB(0, 0), cB, voffB); PG8_STAGE(PG8_SA(0, 0), cA, voffA); PG8_STAGE(PG8_SB(0, 1), cB + hstep, voffB); PG8_STAGE(PG8_SA(0, 1), cA + hstep, voffA);
        if (wr == 1) PG8_BAR;
        PG8_WAIT_V(4); PG8_BAR;
        PG8_STAGE(PG8_SB(1, 0), cB + kstep, voffB); PG8_STAGE(PG8_SA(1, 0), cA + kstep, voffA); PG8_STAGE(PG8_SB(1, 1), cB + hstep + kstep, voffB);
        PG8_WAIT_V(6); PG8_BAR;
    }
    for (;;) {
        const bool has_next = S.next(ui + 1, nxt);
        const char* nA = has_next ? (const char*)g.A + (size_t)nxt.pm * tstep : cA; const char* nB = has_next ? (const char*)g.Bt + (size_t)nxt.pn * tstep : cB;
        for (int t = 0; t < nt; t += 2) {
            const bool last = (t == nt - 2);
            const char* a1 = cA + (size_t)(t + 1) * kstep;
            const char* a2 = last ? nA : cA + (size_t)(t + 2) * kstep; const char* b2 = last ? nB : cB + (size_t)(t + 2) * kstep;
            const char* a3 = a2 + kstep; const char* b3 = b2 + kstep;
            if (last && has_next) S.a_ready(nxt);
            if constexpr (SP2) {
            PG8_LDB(B0, 0, 0); PG8_LDB(B1, 0, 1); PG8_SCHED; PG8_LDA(At, 0, 0); PG8_STAGE(PG8_SA(1, 1), a1 + hstep, voffA);
            PG8_WAIT_V(8); PG8_WAIT_L(0); PG8_BAR; PG8_MMA(0, 0, At, B0); PG8_MMA(0, 1, At, B1); PG8_BAR; PG8_SCHED;
            PG8_LDA(At, 0, 1); PG8_STAGE(PG8_SB(0, 0), b2, voffB); PG8_STAGE(PG8_SB(0, 1), b2 + hstep, voffB); PG8_STAGE(PG8_SA(0, 0), a2, voffA);
            PG8_WAIT_V(8); PG8_WAIT_L(0); PG8_BAR; PG8_MMA(1, 0, At, B0); PG8_MMA(1, 1, At, B1); PG8_BAR; PG8_SCHED;
            PG8_LDB(B0, 1, 0); PG8_LDB(B1, 1, 1); PG8_SCHED; PG8_LDA(At, 1, 0); PG8_STAGE(PG8_SA(0, 1), a2 + hstep, voffA);
            PG8_WAIT_V(8); PG8_WAIT_L(0); PG8_BAR; PG8_MMA(0, 0, At, B0); PG8_MMA(0, 1, At, B1); PG8_BAR; PG8_SCHED;
            PG8_LDA(At, 1, 1); PG8_STAGE(PG8_SB(1, 0), b3, voffB); PG8_STAGE(PG8_SB(1, 1), b3 + hstep, voffB); PG8_STAGE(PG8_SA(1, 0), a3, voffA);
            PG8_WAIT_V(8); PG8_WAIT_L(0); PG8_BAR; PG8_MMA(1, 0, At, B0); PG8_MMA(1, 1, At, B1); PG8_BAR; PG8_SCHED;
            } else {
            PG8_LDB(B0, 0, 0); PG8_SCHED; PG8_LDA(At, 0, 0); PG8_STAGE(PG8_SA(1, 1), a1 + hstep, voffA);
            PG8_WAIT_L(8); PG8_BAR; PG8_WAIT_L(0); PG8_MMA(0, 0, At, B0); PG8_BAR; PG8_SCHED;
            PG8_LDB(B1, 0, 1); PG8_STAGE(PG8_SB(0, 0), b2, voffB);
            PG8_BAR; PG8_WAIT_L(0); PG8_MMA(0, 1, At, B1); PG8_BAR;
            PG8_LDA(At, 0, 1); PG8_STAGE(PG8_SA(0, 0), a2, voffA);
            PG8_BAR; PG8_WAIT_L(0); PG8_MMA(1, 0, At, B0); PG8_BAR; PG8_SCHED;
            PG8_STAGE(PG8_SB(0, 1), b2 + hstep, voffB);
            PG8_WAIT_V(6); PG8_BAR; PG8_MMA(1, 1, At, B1); PG8_BAR;
            PG8_LDB(B0, 1, 0); PG8_SCHED; PG8_LDA(At, 1, 0); PG8_STAGE(PG8_SA(0, 1), a2 + hstep, voffA);
            PG8_WAIT_L(8); PG8_BAR; PG8_WAIT_L(0); PG8_MMA(0, 0, At, B0); PG8_BAR; PG8_SCHED;
            PG8_LDB(B1, 1, 1); PG8_STAGE(PG8_SB(1, 0), b3, voffB);
            PG8_BAR; PG8_WAIT_L(0); PG8_MMA(0, 1, At, B1); PG8_BAR;
            PG8_LDA(At, 1, 1); PG8_STAGE(PG8_SA(1, 0), a3, voffA);
            PG8_BAR; PG8_WAIT_L(0); PG8_MMA(1, 0, At, B0); PG8_BAR; PG8_SCHED;
            PG8_STAGE(PG8_SB(1, 1), b3 + hstep, voffB);
            PG8_WAIT_V(6); PG8_BAR; PG8_MMA(1, 1, At, B1); PG8_BAR;
            }
        }
        if constexpr (ALIGN_EPI) { if (wr == 0) PG8_BAR; }
        if constexpr (!Epi::AFTER_DRAIN) { int l2_; asm volatile("v_mbcnt_lo_u32_b32 %0, -1, 0\n\tv_mbcnt_hi_u32_b32 %0, -1, %0" : "=v"(l2_)); E(acc, cur, wr, wc, l2_ & 15, l2_ >> 4); S.done(cur); }
        if (!has_next) break;
#pragma unroll
        for (int a = 0; a < 2; ++a)
#pragma unroll
            for (int b = 0; b < 2; ++b)
#pragma unroll
                for (int m = 0; m < 4; ++m)
#pragma unroll
                    for (int n = 0; n < 2; ++n) acc[a][b][m][n] = (f32x4){0.f, 0.f, 0.f, 0.f};
        cur = nxt; cA = nA; cB = nB; ++ui;
        if constexpr (ALIGN_EPI) { if (wr == 1) PG8_BAR; }
    }
    PG8_WAIT_V(0);
    if constexpr (!ALIGN_EPI) { if (wr == 0) PG8_BAR; }
    PG8_BAR;
    if constexpr (Epi::AFTER_DRAIN) { E.fused(acc, cur, wr, wc, fr, fq, lds, wid, lane); S.done(cur); }
#undef PG8_SA
#undef PG8_SB
#undef PG8_STAGE
#undef PG8_LDA
#undef PG8_LDB
#undef PG8_MMA
#undef PG8_WAIT_V
#undef PG8_WAIT_L
#undef PG8_BAR
#undef PG8_SCHED
}
}
#ifndef EN_S5A
#define EN_S5A 1
#endif
#ifndef EN_GLAA
#define EN_GLAA 1
#endif
#ifndef EN_FOX
#define EN_FOX 1
#endif
#ifndef EN_S5C
#define EN_S5C 1
#endif
#ifndef EN_GLAC
#define EN_GLAC 1
#endif
#ifndef EN_XA
#define EN_XA 1
#endif
#ifndef EN_CONV
#define EN_CONV 1
#endif
typedef unsigned short bf16;
typedef unsigned v4u __attribute__((ext_vector_type(4)));
typedef unsigned v2u __attribute__((ext_vector_type(2)));
typedef float f32x4 __attribute__((ext_vector_type(4)));
typedef short bf16x8 __attribute__((ext_vector_type(8)));
#define LAS __attribute__((address_space(3)))

constexpr int MTOK = 16384, DM = 1024, SEQ = 2048, NB = 8, DFF = 2816, NMEM = 256, MMEM = NB * NMEM, DEPTH = 4;
constexpr int LDP = 5888, D_IN = 5656;
constexpr int PC_GQ = 0, PC_GK = 128, PC_GV = 256, PC_GR = 512, PC_SU = 768, PC_FQ = 1024, PC_FK = 1536, PC_FV = 2048, PC_GD = 2560, PC_FF = 2576, PC_GATE = 2816;
constexpr float EPS = 1e-6f;
constexpr int NTHR = 512, NWAVES = 8;
constexpr int LDS_BYTES = 147456;

constexpr size_t WO_GU1 = 0, WO_DOWN1 = WO_GU1 + (size_t)5632 * 1024, WO_IN = WO_DOWN1 + (size_t)1024 * 2816, WO_GLAUP = WO_IN + (size_t)5888 * 1024, WO_S5UP = WO_GLAUP + 1024 * 256,
                 WO_FOXUP = WO_S5UP + 1024 * 256, WO_GLU = WO_FOXUP + 1024 * 512, WO_MIXOUT = WO_GLU + 256 * 256, WO_Q = WO_MIXOUT + 1024 * 1024, WO_KV = WO_Q + 1024 * 1024,
                 WO_O = WO_KV + 2048 * 1024, WO_GU2 = WO_O + 1024 * 1024, WO_DOWN2 = WO_GU2 + (size_t)5632 * 1024, WO_END = WO_DOWN2 + (size_t)1024 * 2816;
constexpr size_t MiB = (size_t)1 << 20;
constexpr size_t WS_W = 1 * MiB, WS_P = 64 * MiB, WS_H = 248 * MiB, WS_Y = 280 * MiB, WS_BRG = 344 * MiB, WS_BRS = 352 * MiB, WS_BRF = 360 * MiB, WS_MIXB = 376 * MiB,
                 WS_Q = 344 * MiB, WS_XO = 376 * MiB, WS_KV = 408 * MiB, WS_MEMN = 416 * MiB, WS_DS = 420 * MiB, WS_DEC = 428 * MiB, WS_S5L = 429 * MiB, WS_S5P = 431 * MiB, WS_END = 432 * MiB;
static_assert(WS_W + WO_END * 2 <= WS_P, "weights fit");
static_assert(WS_P + (size_t)MTOK * LDP * 2 <= WS_H, "P fits");
constexpr size_t S5P_ABAR = 0, S5P_A64 = 8192, S5P_BBAR = 16384, S5P_CMAT = 16384 + 131072;

struct Params { const float* in[37]; float* out; unsigned char* ws; };

__device__ __forceinline__ unsigned f2bf(float f) { unsigned u = __builtin_bit_cast(unsigned, f); return (u + 0x7fffu + ((u >> 16) & 1u)) >> 16; }
__device__ __forceinline__ unsigned pk2(float lo, float hi) { return f2bf(lo) | (f2bf(hi) << 16); }
__device__ __forceinline__ float bf2f(unsigned h) { return __uint_as_float(h << 16); }
__device__ __forceinline__ float bflo(unsigned w) { return __uint_as_float(w << 16); }
__device__ __forceinline__ float bfhi(unsigned w) { return __uint_as_float(w & 0xffff0000u); }
#define LDS_WAIT() asm volatile("s_waitcnt lgkmcnt(0)" ::: "memory")
__device__ __forceinline__ float wave_sum(float v) {
#pragma unroll
    for (int o = 1; o < 64; o <<= 1) v += __shfl_xor(v, o);
    return v;
}
__device__ __forceinline__ float logsig(float z) { return fminf(z, 0.f) - logf(1.0f + expf(-fabsf(z))); }
__device__ __forceinline__ float sigmoidf_(float x) { return 1.0f / (1.0f + __expf(-x)); }
__device__ __forceinline__ float gelu_tanh(float x) { const float z = 0.7978845608028654f * (x + 0.044715f * x * x * x); const float t = 1.0f - 2.0f / (__expf(2.0f * z) + 1.0f); return 0.5f * x * (1.0f + t); }

__device__ __forceinline__ int srccol(int kind, int j) {
    if (kind == 0) return j;
    if (kind == 1) { const int pn = j >> 8, r = j & 255; return r < 128 ? 128 * pn + r : 2816 + 128 * pn + (r - 128); }
    if (j < 768) return j;
    if (j < 1024) return 784 + (j - 768);
    if (j < 2560) return 1040 + (j - 1024);
    if (j < 2576) return 768 + (j - 2560);
    if (j < 2584) return 2576 + (j - 2576);
    if (j < 2816) return -1;
    return 2584 + (j - 2816);
}
__device__ __forceinline__ void transpose_item(const float* W, int K, int Nsrc, int Ndst, int kind, bf16* WT, float* scr, int item, int lane) {
    const int nblk = Ndst / 32, kb = item / nblk, nb = item % nblk, k0 = 64 * kb, n0 = 32 * nb;
    const int sc = srccol(kind, n0 + (lane & 31));
#pragma unroll 8
    for (int i = 0; i < 32; ++i) { const int kk = 2 * i + (lane >> 5); scr[kk * 33 + (lane & 31)] = sc >= 0 ? W[(size_t)(k0 + kk) * Nsrc + sc] : 0.f; }
    LDS_WAIT();
    const int c = lane & 7;
#pragma unroll
    for (int j = 0; j < 4; ++j) { const int n = (lane >> 3) + 8 * j; const float* s = scr + (8 * c) * 33 + n;
        v4u o; o.x = pk2(s[0 * 33], s[1 * 33]); o.y = pk2(s[2 * 33], s[3 * 33]); o.z = pk2(s[4 * 33], s[5 * 33]); o.w = pk2(s[6 * 33], s[7 * 33]);
        *(v4u*)(WT + (size_t)(n0 + n) * K + k0 + 8 * c) = o; }
    LDS_WAIT();
}
struct ConvJob { int in_idx; int K, Nsrc, Ndst, kind; size_t wo; };
__device__ __forceinline__ void convert_weights(unsigned char* ws, const float* const* tab, int l, char* lds, int gw, int NGW, int wave, int lane) {
    float* scr = (float*)(lds + wave * 8448);
    bf16* Wb = (bf16*)(ws + WS_W);
    const int  jin[13]  = {3, 4, 7, 11, 22, 24, 20, 25, 29, 30, 31, 34, 35};
    const int  jK[13]   = {1024, 2816, 1024, 256, 256, 512, 256, 1024, 1024, 1024, 1024, 1024, 2816};
    const int  jNs[13]  = {5632, 1024, D_IN, 1024, 1024, 1024, 256, 1024, 1024, 2048, 1024, 5632, 1024};
    const int  jNd[13]  = {5632, 1024, 5888, 1024, 1024, 1024, 256, 1024, 1024, 2048, 1024, 5632, 1024};
    const int  jkind[13]= {1, 0, 2, 0, 0, 0, 0, 0, 0, 0, 0, 1, 0};
    const size_t jwo[13]= {WO_GU1, WO_DOWN1, WO_IN, WO_GLAUP, WO_S5UP, WO_FOXUP, WO_GLU, WO_MIXOUT, WO_Q, WO_KV, WO_O, WO_GU2, WO_DOWN2};
    int base = 0;
#pragma unroll
    for (int j = 0; j < 13; ++j) {
        const int K = jK[j], Ns = jNs[j], Nd = jNd[j];
        const int nitems = (K / 64) * (Nd / 32);
        const float* W = tab[jin[j]] + (size_t)l * K * Ns;
        int first = (gw - (base % NGW) + NGW) % NGW;
        for (int it = first; it < nitems; it += NGW) transpose_item(W, K, Ns, Nd, jkind[j], Wb + jwo[j], scr, it, lane);
        base += nitems;
    }
}
__device__ __forceinline__ void s5_prep(unsigned char* ws, const float* const* tab, int l, int gtid, int GT) {
    unsigned char* sp = ws + WS_S5P;
    float2* ABAR = (float2*)(sp + S5P_ABAR); float2* A64 = (float2*)(sp + S5P_A64); float2* BBAR = (float2*)(sp + S5P_BBAR); bf16* CMAT = (bf16*)(sp + S5P_CMAT);
    const float* a_re = tab[12] + l * 1024; const float* a_im = tab[13] + l * 1024; const float* log_dt = tab[14] + l * 16;
    const float* b_re = tab[15] + (size_t)l * 16384; const float* b_im = tab[16] + (size_t)l * 16384;
    const float* c_re = tab[17] + (size_t)l * 16384; const float* c_im = tab[18] + (size_t)l * 16384;
    for (int idx = gtid; idx < 1024; idx += GT) {
        const int g = idx >> 6;
        const float lre = fminf(a_re[idx], -1e-4f), lim = a_im[idx], dt = expf(log_dt[g]);
        const float mag = expf(lre * dt);
        float sn, cs; sincosf(lim * dt, &sn, &cs);
        const float abr = mag * cs, abi = mag * sn;
        const float den = lre * lre + lim * lim;
        const float zr = ((abr - 1.0f) * lre + abi * lim) / den, zi = (abi * lre - (abr - 1.0f) * lim) / den;
        ABAR[idx] = make_float2(abr, abi);
        float pr = abr, pi = abi;
#pragma unroll
        for (int s = 0; s < 6; ++s) { const float nr = pr * pr - pi * pi, ni = 2.0f * pr * pi; pr = nr; pi = ni; }
        A64[idx] = make_float2(pr, pi);
        for (int h = 0; h < 16; ++h) { const float br = b_re[idx * 16 + h], bi = b_im[idx * 16 + h]; BBAR[idx * 16 + h] = make_float2(zr * br - zi * bi, zr * bi + zi * br); }
    }
    for (int idx = gtid; idx < 32768; idx += GT) {
        const int j = idx & 7, ln = (idx >> 3) & 63, ks = (idx >> 9) & 3, g = idx >> 11;
        const int k = 32 * ks + 8 * (ln >> 4) + j, h = ln & 15;
        const float v = k < 64 ? c_re[(g * 16 + h) * 64 + k] : -c_im[(g * 16 + h) * 64 + (k - 64)];
        CMAT[idx] = (bf16)f2bf(v);
    }
}
template <bool HASY, bool HASX, bool HASH>
__device__ __forceinline__ void rowop(const float* xin, float* xout, const float* Y, const float* postg, float coef, const float* preg, bf16* H, int nrows, int gw, int NGW, int lane) {
    for (int m = gw; m < nrows; m += NGW) {
        const f32x4* xr = (const f32x4*)(xin + (size_t)m * DM) + lane;
        f32x4 v[4];
#pragma unroll
        for (int j = 0; j < 4; ++j) v[j] = xr[64 * j];
        if (HASY) {
            const f32x4* yr = (const f32x4*)(Y + (size_t)m * DM) + lane; f32x4 y[4]; float s = 0.f;
#pragma unroll
            for (int j = 0; j < 4; ++j) { y[j] = yr[64 * j]; s += (y[j].x * y[j].x + y[j].y * y[j].y) + (y[j].z * y[j].z + y[j].w * y[j].w); }
            const float r = coef / sqrtf(wave_sum(s) * (1.0f / DM) + EPS);
#pragma unroll
            for (int j = 0; j < 4; ++j) { const f32x4 g = ((const f32x4*)postg)[lane + 64 * j]; v[j] += y[j] * g * r; }
        }
        if (HASX) { f32x4* xo = (f32x4*)(xout + (size_t)m * DM) + lane;
#pragma unroll
            for (int j = 0; j < 4; ++j) xo[64 * j] = v[j]; }
        if (HASH) {
            float s2 = 0.f;
#pragma unroll
            for (int j = 0; j < 4; ++j) s2 += (v[j].x * v[j].x + v[j].y * v[j].y) + (v[j].z * v[j].z + v[j].w * v[j].w);
            const float r2 = 1.0f / sqrtf(wave_sum(s2) * (1.0f / DM) + EPS);
            v2u* ho = (v2u*)(H + (size_t)m * DM) + lane;
#pragma unroll
            for (int j = 0; j < 4; ++j) { const f32x4 g = ((const f32x4*)preg)[lane + 64 * j]; v2u w; w.x = pk2(v[j].x * r2 * g.x, v[j].y * r2 * g.y); w.y = pk2(v[j].z * r2 * g.z, v[j].w * r2 * g.w); ho[64 * j] = w; }
        }
    }
}
template <int DH, bool FOX>
__device__ __forceinline__ void attn_unit(char* lds, const bf16* Qp, int ldq, const bf16* Kp, int ldk, const bf16* Vp, int ldv, bf16* Op, int ldo,
                                          int qpos0, int nkt, const float* Fc, float scale, int tid) {
    constexpr int KS = DH + 8, VS = 72, NPASS = DH / 64, CPR = DH / 8;
    bf16* Ks = (bf16*)lds; bf16* Vt = Ks + 64 * KS;
    const int lane = tid & 63, wave = tid >> 6, li = lane & 15, qd = lane >> 4;
    bf16x8 qf[DH / 32];
    { const bf16* qrow = Qp + (size_t)(wave * 16 + li) * ldq;
#pragma unroll
      for (int ks = 0; ks < DH / 32; ++ks) qf[ks] = *(const bf16x8*)(qrow + 32 * ks + 8 * qd); }
    const int qpos = qpos0 + wave * 16 + li;
    float Fq = 0.f; if (FOX) Fq = Fc[qpos];
    f32x4 oacc[DH / 16];
#pragma unroll
    for (int i = 0; i < DH / 16; ++i) oacc[i] = (f32x4){0.f, 0.f, 0.f, 0.f};
    float mrun = -INFINITY, lsum = 0.f;
    v4u kreg[NPASS], vreg[NPASS];
#pragma unroll
    for (int ps = 0; ps < NPASS; ++ps) { const int c = tid + NTHR * ps, key = c / CPR, dc = c % CPR;
        kreg[ps] = *(const v4u*)(Kp + (size_t)key * ldk + dc * 8); vreg[ps] = *(const v4u*)(Vp + (size_t)key * ldv + dc * 8); }
    for (int kt = 0; kt < nkt; ++kt) {
        __syncthreads();
#pragma unroll
        for (int ps = 0; ps < NPASS; ++ps) { const int c = tid + NTHR * ps, key = c / CPR, dc = c % CPR;
            *(v4u*)(Ks + key * KS + dc * 8) = kreg[ps];
            const v4u vv = vreg[ps];
            bf16* vt = Vt + (dc * 8) * VS + key;
            vt[0 * VS] = (bf16)(vv.x & 0xffffu); vt[1 * VS] = (bf16)(vv.x >> 16); vt[2 * VS] = (bf16)(vv.y & 0xffffu); vt[3 * VS] = (bf16)(vv.y >> 16);
            vt[4 * VS] = (bf16)(vv.z & 0xffffu); vt[5 * VS] = (bf16)(vv.z >> 16); vt[6 * VS] = (bf16)(vv.w & 0xffffu); vt[7 * VS] = (bf16)(vv.w >> 16); }
        __syncthreads();
        if (kt + 1 < nkt) {
#pragma unroll
            for (int ps = 0; ps < NPASS; ++ps) { const int c = tid + NTHR * ps, key = (kt + 1) * 64 + c / CPR, dc = c % CPR;
                kreg[ps] = *(const v4u*)(Kp + (size_t)key * ldk + dc * 8); vreg[ps] = *(const v4u*)(Vp + (size_t)key * ldv + dc * 8); }
        }
        f32x4 s[4];
#pragma unroll
        for (int kb = 0; kb < 4; ++kb) { s[kb] = (f32x4){0.f, 0.f, 0.f, 0.f};
#pragma unroll
            for (int ks = 0; ks < DH / 32; ++ks) { const bf16x8 a = *(const bf16x8*)(Ks + (16 * kb + li) * KS + 32 * ks + 8 * qd); s[kb] = __builtin_amdgcn_mfma_f32_16x16x32_bf16(a, qf[ks], s[kb], 0, 0, 0); } }
        float tmax = -INFINITY;
#pragma unroll
        for (int kb = 0; kb < 4; ++kb)
#pragma unroll
            for (int i = 0; i < 4; ++i) { const int key = kt * 64 + 16 * kb + 4 * qd + i; float v = s[kb][i] * scale;
                if (FOX) { v += Fq - Fc[key]; if (key > qpos) v = -INFINITY; }
                s[kb][i] = v; tmax = fmaxf(tmax, v); }
        tmax = fmaxf(tmax, __shfl_xor(tmax, 16)); tmax = fmaxf(tmax, __shfl_xor(tmax, 32));
        const float mnew = fmaxf(mrun, tmax);
        const float alpha = __expf(mrun - mnew);
        mrun = mnew;
        float psum = 0.f;
#pragma unroll
        for (int kb = 0; kb < 4; ++kb)
#pragma unroll
            for (int i = 0; i < 4; ++i) { const float e = __expf(s[kb][i] - mnew); s[kb][i] = e; psum += e; }
        lsum = lsum * alpha + psum;
#pragma unroll
        for (int i = 0; i < DH / 16; ++i) oacc[i] *= alpha;
        bf16x8 pf[2];
#pragma unroll
        for (int kk = 0; kk < 2; ++kk) { v4u w; w.x = pk2(s[2 * kk][0], s[2 * kk][1]); w.y = pk2(s[2 * kk][2], s[2 * kk][3]); w.z = pk2(s[2 * kk + 1][0], s[2 * kk + 1][1]); w.w = pk2(s[2 * kk + 1][2], s[2 * kk + 1][3]);
            pf[kk] = __builtin_bit_cast(bf16x8, w); }
#pragma unroll
        for (int db = 0; db < DH / 16; ++db)
#pragma unroll
            for (int kk = 0; kk < 2; ++kk) { const bf16* vp = Vt + (16 * db + li) * VS + 32 * kk + 4 * qd;
                const v2u lo = *(const v2u*)vp, hi = *(const v2u*)(vp + 16);
                v4u w; w.x = lo.x; w.y = lo.y; w.z = hi.x; w.w = hi.y;
                oacc[db] = __builtin_amdgcn_mfma_f32_16x16x32_bf16(__builtin_bit_cast(bf16x8, w), pf[kk], oacc[db], 0, 0, 0); }
    }
    lsum += __shfl_xor(lsum, 16); lsum += __shfl_xor(lsum, 32);
    const float inv = 1.0f / lsum;
    bf16* orow = Op + (size_t)(wave * 16 + li) * ldo + 4 * qd;
#pragma unroll
    for (int db = 0; db < DH / 16; ++db) { v2u w; w.x = pk2(oacc[db][0] * inv, oacc[db][1] * inv); w.y = pk2(oacc[db][2] * inv, oacc[db][3] * inv); *(v2u*)(orow + 16 * db) = w; }
}
__device__ __forceinline__ void fox_cumsum(const bf16* P, int b, int h, float fb, float* Fc, float* red, int tid) {
    const int lane = tid & 63, wave = tid >> 6;
    float lf[4];
#pragma unroll
    for (int i = 0; i < 4; ++i) { const float z = bf2f(P[(size_t)(b * SEQ + 4 * tid + i) * LDP + PC_FF + h]) + fb; lf[i] = logsig(z); }
    const float loc = (lf[0] + lf[1]) + (lf[2] + lf[3]);
    float inc = loc;
#pragma unroll
    for (int o = 1; o < 64; o <<= 1) { const float t = __shfl_up(inc, o); if (lane >= o) inc += t; }
    __syncthreads();
    if (lane == 63) red[wave] = inc;
    __syncthreads();
    float off = inc - loc;
    for (int w = 0; w < wave; ++w) off += red[w];
    float run = off;
#pragma unroll
    for (int i = 0; i < 4; ++i) { run += lf[i]; Fc[4 * tid + i] = run; }
    __syncthreads();
}
__device__ __forceinline__ void s5_load_u(const bf16* P, int row0, int g, float* us, int lane) {
    const v4u* src = (const v4u*)(P + (size_t)(row0 + lane) * LDP + PC_SU + g * 16);
    const v4u a = src[0], c = src[1];
    f32x4* dst = (f32x4*)(us + lane * 16);
    dst[0] = (f32x4){bflo(a.x), bfhi(a.x), bflo(a.y), bfhi(a.y)}; dst[1] = (f32x4){bflo(a.z), bfhi(a.z), bflo(a.w), bfhi(a.w)};
    dst[2] = (f32x4){bflo(c.x), bfhi(c.x), bflo(c.y), bfhi(c.y)}; dst[3] = (f32x4){bflo(c.z), bfhi(c.z), bflo(c.w), bfhi(c.w)};
    LDS_WAIT();
}
__device__ __forceinline__ void s5_bu(const float* us, int t, const float (&bre)[16], const float (&bim)[16], float& bur, float& bui) {
    const f32x4* up = (const f32x4*)(us + t * 16);
    bur = 0.f; bui = 0.f;
#pragma unroll
    for (int q = 0; q < 4; ++q) { const f32x4 u4 = up[q];
#pragma unroll
        for (int j = 0; j < 4; ++j) { bur += bre[4 * q + j] * u4[j]; bui += bim[4 * q + j] * u4[j]; } }
}
__device__ __forceinline__ void s5_passA(unsigned char* ws, const float* const* tab, char* lds, int gw, int NGW, int wave, int lane) {
    const bf16* P = (const bf16*)(ws + WS_P);
    const float2* ABAR = (const float2*)(ws + WS_S5P + S5P_ABAR); const float2* BBAR = (const float2*)(ws + WS_S5P + S5P_BBAR);
    float* L = (float*)(ws + WS_S5L);
    float* us = (float*)(lds + wave * 4096);
    for (int u = gw; u < 4096; u += NGW) {
        const int n = u & 31, g = (u >> 5) & 15, b = u >> 9;
        LDS_WAIT();
        s5_load_u(P, b * SEQ + n * 64, g, us, lane);
        float bre[16], bim[16];
#pragma unroll
        for (int h = 0; h < 16; ++h) { const float2 v = BBAR[(g * 64 + lane) * 16 + h]; bre[h] = v.x; bim[h] = v.y; }
        const float2 ab = ABAR[g * 64 + lane];
        float xr = 0.f, xi = 0.f;
        for (int t = 0; t < 64; ++t) { float bur, bui; s5_bu(us, t, bre, bim, bur, bui);
            const float nr = ab.x * xr - ab.y * xi + bur, ni = ab.x * xi + ab.y * xr + bui; xr = nr; xi = ni; }
        L[(size_t)u * 128 + lane] = xr; L[(size_t)u * 128 + 64 + lane] = xi;
    }
}
__device__ __forceinline__ void s5_passC(unsigned char* ws, const float* const* tab, int l, char* lds, int unit, int tid) {
    const int lane = tid & 63, wave = tid >> 6, li = lane & 15, qd = lane >> 4;
    const int b = unit >> 5, n = unit & 31, row0 = b * SEQ + n * 64;
    const bf16* P = (const bf16*)(ws + WS_P);
    const float2* ABAR = (const float2*)(ws + WS_S5P + S5P_ABAR); const float2* A64 = (const float2*)(ws + WS_S5P + S5P_A64);
    const float2* BBAR = (const float2*)(ws + WS_S5P + S5P_BBAR); const bf16* CMAT = (const bf16*)(ws + WS_S5P + S5P_CMAT);
    const float* L = (const float*)(ws + WS_S5L);
    bf16* Xs = (bf16*)(lds + wave * 8704);
    float* us = (float*)(lds + 69632 + wave * 4096);
    bf16* Ys = (bf16*)(lds + 102400);
    __syncthreads();
    for (int gi = 0; gi < 2; ++gi) {
        const int g = 2 * wave + gi;
        LDS_WAIT();
        s5_load_u(P, row0, g, us, lane);
        float xr = 0.f, xi = 0.f;
        { const float2 a64 = A64[g * 64 + lane]; const float* Lb = L + (size_t)((b * 16 + g) * 32) * 128 + lane;
          for (int m = 0; m < n; ++m) { const float lr = Lb[m * 128], lim = Lb[m * 128 + 64]; const float nr = a64.x * xr - a64.y * xi + lr, ni = a64.x * xi + a64.y * xr + lim; xr = nr; xi = ni; } }
        float bre[16], bim[16];
#pragma unroll
        for (int h = 0; h < 16; ++h) { const float2 v = BBAR[(g * 64 + lane) * 16 + h]; bre[h] = v.x; bim[h] = v.y; }
        const float2 ab = ABAR[g * 64 + lane];
        bf16x8 cfr[4];
#pragma unroll
        for (int ks = 0; ks < 4; ++ks) cfr[ks] = *(const bf16x8*)(CMAT + ((size_t)((g * 4 + ks) * 64 + lane)) * 8);
        const float dsk = tab[19][l * 256 + g * 16 + li];
        for (int half = 0; half < 2; ++half) {
            for (int tt = 0; tt < 32; ++tt) { const int t = half * 32 + tt; float bur, bui; s5_bu(us, t, bre, bim, bur, bui);
                const float nr = ab.x * xr - ab.y * xi + bur, ni = ab.x * xi + ab.y * xr + bui; xr = nr; xi = ni;
                Xs[tt * 136 + lane] = (bf16)f2bf(xr); Xs[tt * 136 + 64 + lane] = (bf16)f2bf(xi); }
            LDS_WAIT();
#pragma unroll
            for (int rb = 0; rb < 2; ++rb) { f32x4 acc = (f32x4){0.f, 0.f, 0.f, 0.f};
#pragma unroll
                for (int ks = 0; ks < 4; ++ks) { const bf16x8 a = *(const bf16x8*)(Xs + (16 * rb + li) * 136 + 32 * ks + 8 * qd); acc = __builtin_amdgcn_mfma_f32_16x16x32_bf16(a, cfr[ks], acc, 0, 0, 0); }
#pragma unroll
                for (int i = 0; i < 4; ++i) { const int t = half * 32 + 16 * rb + 4 * qd + i; const float yv = gelu_tanh(acc[i] + dsk * us[t * 16 + li]); Ys[t * 264 + g * 16 + li] = (bf16)f2bf(yv); } }
            LDS_WAIT();
        }
    }
    __syncthreads();
    { const bf16* Wg = (const bf16*)(ws + WS_W) + WO_GLU; const float* gb = tab[21] + l * 256; bf16* BRS = (bf16*)(ws + WS_BRS);
      f32x4 acc[4][2];
#pragma unroll
      for (int rb = 0; rb < 4; ++rb) { acc[rb][0] = (f32x4){0.f, 0.f, 0.f, 0.f}; acc[rb][1] = (f32x4){0.f, 0.f, 0.f, 0.f}; }
#pragma unroll
      for (int ks = 0; ks < 8; ++ks) { bf16x8 bfr[2];
#pragma unroll
          for (int cb = 0; cb < 2; ++cb) bfr[cb] = *(const bf16x8*)(Wg + (size_t)(32 * wave + 16 * cb + li) * 256 + 32 * ks + 8 * qd);
#pragma unroll
          for (int rb = 0; rb < 4; ++rb) { const bf16x8 a = *(const bf16x8*)(Ys + (16 * rb + li) * 264 + 32 * ks + 8 * qd);
#pragma unroll
              for (int cb = 0; cb < 2; ++cb) acc[rb][cb] = __builtin_amdgcn_mfma_f32_16x16x32_bf16(a, bfr[cb], acc[rb][cb], 0, 0, 0); } }
#pragma unroll
      for (int rb = 0; rb < 4; ++rb)
#pragma unroll
          for (int cb = 0; cb < 2; ++cb) { const int col = 32 * wave + 16 * cb + li; const float bias = gb[col];
#pragma unroll
              for (int i = 0; i < 4; ++i) { const int t = 16 * rb + 4 * qd + i; const float yv = bf2f(Ys[t * 264 + col]); const float o = yv * sigmoidf_(acc[rb][cb][i] + bias);
                  BRS[(size_t)(row0 + t) * 256 + col] = (bf16)f2bf(o); } } }
    __syncthreads();
}
struct GlaLds { float* QF; float* QI; float* KI; float* KE; float* G; float* V; float* AT; float* SP; float* GD; };
__device__ __forceinline__ GlaLds gla_lds(char* lds) { GlaLds s; float* f = (float*)lds; s.QF = f; s.QI = f + 2112; s.KI = f + 4224; s.KE = f + 6336; s.G = f + 8448; s.V = f + 10560; s.AT = f + 14656; s.SP = f + 18816; s.GD = f + 20864; return s; }
__device__ __forceinline__ void gla_load(unsigned char* ws, const float* const* tab, int l, const GlaLds& s, int row0, int h, int tid, bool need_q) {
    const bf16* P = (const bf16*)(ws + WS_P);
    const int t = tid >> 3, c8 = tid & 7;
    const bf16* prow = P + (size_t)(row0 + t) * LDP;
    if (need_q) { const v2u w = *(const v2u*)(prow + PC_GQ + h * 32 + 4 * c8); float* d = s.QF + t * 33 + 4 * c8; d[0] = bflo(w.x); d[1] = bfhi(w.x); d[2] = bflo(w.y); d[3] = bfhi(w.y); }
    { const v2u w = *(const v2u*)(prow + PC_GK + h * 32 + 4 * c8); float* d = s.KI + t * 33 + 4 * c8; d[0] = bflo(w.x); d[1] = bfhi(w.x); d[2] = bflo(w.y); d[3] = bfhi(w.y); }
    { const v4u w = *(const v4u*)(prow + PC_GV + h * 64 + 8 * c8); f32x4* d = (f32x4*)(s.V + t * 64 + 8 * c8); d[0] = (f32x4){bflo(w.x), bfhi(w.x), bflo(w.y), bfhi(w.y)}; d[1] = (f32x4){bflo(w.z), bfhi(w.z), bflo(w.w), bfhi(w.w)}; }
    if (tid < 128) { const int tt = tid >> 1, hf = tid & 1; const v4u w = *(const v4u*)(P + (size_t)(row0 + tt) * LDP + PC_GD + 8 * hf); float* d = s.GD + tt * 16 + 8 * hf;
        d[0] = bflo(w.x); d[1] = bfhi(w.x); d[2] = bflo(w.y); d[3] = bfhi(w.y); d[4] = bflo(w.z); d[5] = bfhi(w.z); d[6] = bflo(w.w); d[7] = bfhi(w.w); }
    __syncthreads();
    const float* gw = tab[8] + l * 2048; const float* gbias = tab[9] + l * 128;
#pragma unroll
    for (int i = 0; i < 4; ++i) { const int d = 4 * c8 + i; float z = gbias[h * 32 + d];
#pragma unroll
        for (int r = 0; r < 16; ++r) z += s.GD[t * 16 + r] * gw[r * 128 + h * 32 + d];
        s.G[t * 33 + d] = logsig(z) * (1.0f / 16.0f); }
    __syncthreads();
    if (tid < 32) { float run = 0.f; for (int tt = 0; tt < 64; ++tt) { run += s.G[tt * 33 + tid]; s.G[tt * 33 + tid] = run; } }
    __syncthreads();
}
__device__ __forceinline__ void gla_passA(unsigned char* ws, const float* const* tab, int l, char* lds, int unit, int tid) {
    const GlaLds s = gla_lds(lds);
    const int b = unit >> 5, n = unit & 31, row0 = b * SEQ + n * 64;
    float* DS = (float*)(ws + WS_DS); float* DEC = (float*)(ws + WS_DEC);
    __syncthreads();
    for (int h = 0; h < 4; ++h) {
        gla_load(ws, tab, l, s, row0, h, tid, false);
        { const int t = tid >> 3, c8 = tid & 7;
#pragma unroll
          for (int i = 0; i < 4; ++i) { const int d = 4 * c8 + i; s.KI[t * 33 + d] *= expf(s.G[63 * 33 + d] - s.G[t * 33 + d]); } }
        __syncthreads();
        { const int d = tid >> 4, e0 = 4 * (tid & 15); f32x4 acc = (f32x4){0.f, 0.f, 0.f, 0.f};
          for (int c = 0; c < 64; ++c) acc += s.KI[c * 33 + d] * *(const f32x4*)(s.V + c * 64 + e0);
          const size_t ub = (size_t)((b * 4 + h) * 32 + n);
          *(f32x4*)(DS + ub * 2048 + d * 64 + e0) = acc;
          if ((tid & 15) == 0) DEC[ub * 32 + d] = expf(s.G[63 * 33 + d]); }
        __syncthreads();
    }
}
__device__ __forceinline__ void gla_passC(unsigned char* ws, const float* const* tab, int l, char* lds, int unit, int tid) {
    const GlaLds s = gla_lds(lds);
    const int b = unit >> 5, n = unit & 31, row0 = b * SEQ + n * 64;
    const float* DS = (const float*)(ws + WS_DS); const float* DEC = (const float*)(ws + WS_DEC);
    const bf16* P = (const bf16*)(ws + WS_P); bf16* BRG = (bf16*)(ws + WS_BRG);
    const float* gn = tab[10] + l * 256;
    __syncthreads();
    for (int h = 0; h < 4; ++h) {
        gla_load(ws, tab, l, s, row0, h, tid, true);
        { const int t = tid >> 3, c8 = tid & 7;
#pragma unroll
          for (int i = 0; i < 4; ++i) { const int d = 4 * c8 + i; const float g = s.G[t * 33 + d]; const float eg = expf(g), ieg = expf(-g);
              const float q = s.QF[t * 33 + d] * 0.17677669529663687f, k = s.KI[t * 33 + d];
              s.QF[t * 33 + d] = q * eg; s.QI[t * 33 + d] = q * ieg; s.KI[t * 33 + d] = k * ieg; s.KE[t * 33 + d] = k * eg; } }
        __syncthreads();
        { const int i = tid >> 3, jb = tid & 7;
#pragma unroll
          for (int jj = 0; jj < 8; ++jj) { const int j = jb + 8 * jj; const float* qa = (j <= i) ? s.QF : s.QI; const float* kb = (j <= i) ? s.KI : s.KE; float dot = 0.f;
#pragma unroll
              for (int d = 0; d < 32; ++d) dot += qa[i * 33 + d] * kb[j * 33 + d];
              s.AT[i * 65 + j] = dot; } }
        { const int idx4 = tid * 4, d = idx4 >> 6; f32x4 S = (f32x4){0.f, 0.f, 0.f, 0.f};
          const float* base = DS + (size_t)((b * 4 + h) * 32) * 2048 + idx4; const float* decb = DEC + (size_t)((b * 4 + h) * 32) * 32 + d;
          for (int m = 0; m < n; ++m) { const float dd = decb[m * 32]; const f32x4 v = *(const f32x4*)(base + (size_t)m * 2048); S = S * dd + v; }
          *(f32x4*)(s.SP + idx4) = S; }
        __syncthreads();
        { const int i = tid >> 3, e0 = 8 * (tid & 7); f32x4 a0 = (f32x4){0.f, 0.f, 0.f, 0.f}, a1 = a0;
          for (int j = 0; j < 64; ++j) { const float a = s.AT[i * 65 + j]; a0 += a * *(const f32x4*)(s.V + j * 64 + e0); a1 += a * *(const f32x4*)(s.V + j * 64 + e0 + 4); }
          for (int d = 0; d < 32; ++d) { const float a = s.QF[i * 33 + d]; a0 += a * *(const f32x4*)(s.SP + d * 64 + e0); a1 += a * *(const f32x4*)(s.SP + d * 64 + e0 + 4); }
          float ss = (a0[0] * a0[0] + a0[1] * a0[1]) + (a0[2] * a0[2] + a0[3] * a0[3]) + (a1[0] * a1[0] + a1[1] * a1[1]) + (a1[2] * a1[2] + a1[3] * a1[3]);
          ss += __shfl_xor(ss, 1); ss += __shfl_xor(ss, 2); ss += __shfl_xor(ss, 4);
          const float r = 1.0f / sqrtf(ss * (1.0f / 64.0f) + EPS);
          const v4u gr = *(const v4u*)(P + (size_t)(row0 + i) * LDP + PC_GR + h * 64 + e0);
          const float grv[8] = {bflo(gr.x), bfhi(gr.x), bflo(gr.y), bfhi(gr.y), bflo(gr.z), bfhi(gr.z), bflo(gr.w), bfhi(gr.w)};
          float o[8];
#pragma unroll
          for (int k = 0; k < 8; ++k) { const float v = (k < 4 ? a0[k & 3] : a1[k & 3]) * r * gn[h * 64 + e0 + k]; const float gg = grv[k]; o[k] = v * gg * sigmoidf_(gg); }
          v4u w; w.x = pk2(o[0], o[1]); w.y = pk2(o[2], o[3]); w.z = pk2(o[4], o[5]); w.w = pk2(o[6], o[7]);
          *(v4u*)(BRG + (size_t)(row0 + i) * 256 + h * 64 + e0) = w; }
        __syncthreads();
    }
}

__device__ __forceinline__ void gsync(unsigned char* wsb, unsigned G, int wave_s, unsigned& nsync) {
    unsigned char* wl_ = wsb; asm volatile("" : "+s"(wl_)); unsigned* ctr = (unsigned*)(wl_ + 1024);
    int ln_; asm volatile("v_mbcnt_lo_u32_b32 %0, -1, 0\n\tv_mbcnt_hi_u32_b32 %0, -1, %0" : "=v"(ln_));
    const bool leader = (wave_s == 0) && (ln_ == 0);
    asm volatile("s_waitcnt vmcnt(0)" ::: "memory");
    __syncthreads();
    if (leader) {
        __builtin_amdgcn_fence(__ATOMIC_RELEASE, "agent");
        asm volatile("s_waitcnt vmcnt(0)" ::: "memory");
        (void)__hip_atomic_fetch_add(ctr, 1u, __ATOMIC_RELAXED, __HIP_MEMORY_SCOPE_AGENT);
        const unsigned want = (nsync + 1u) * G;
        while (__hip_atomic_load(ctr, __ATOMIC_RELAXED, __HIP_MEMORY_SCOPE_AGENT) < want) __builtin_amdgcn_s_sleep(2);
        __builtin_amdgcn_fence(__ATOMIC_ACQUIRE, "agent");
        asm volatile("s_waitcnt vmcnt(0)" ::: "memory");
    }
    __syncthreads();
}
__global__ void __launch_bounds__(NTHR, 2) fwd_mega(Params p) {
    extern __shared__ __attribute__((aligned(16))) unsigned char lds_raw[];
    char* lds = (char*)lds_raw;
    PG8_LAS unsigned char* ldsg = (PG8_LAS unsigned char*)lds_raw;
    cg::grid_group grid = cg::this_grid();
    const int G = gridDim.x, bid = blockIdx.x;
    const int wave_s = __builtin_amdgcn_readfirstlane(threadIdx.x >> 6);
    const int NGW = G * NWAVES;
#define TIDS() int tid; { int ln_; asm volatile("v_mbcnt_lo_u32_b32 %0, -1, 0\n\tv_mbcnt_hi_u32_b32 %0, -1, %0" : "=v"(ln_)); tid = wave_s * 64 + ln_; } const int lane = tid & 63, wave = __builtin_amdgcn_readfirstlane(tid >> 6), gw = bid * NWAVES + wave; (void)lane; (void)gw
    if (threadIdx.x < 38) ((const float**)p.ws)[threadIdx.x] = threadIdx.x < 37 ? p.in[threadIdx.x] : (const float*)p.out;
    grid.sync();
#define PTRS() unsigned char* ws = p.ws; asm volatile("" : "+s"(ws)); const float* const* tab = (const float* const*)ws; (void)tab
#define GSYNC() grid.sync()
#define Wb ((bf16*)(ws + WS_W))
#define P ((bf16*)(ws + WS_P))
#define ACT ((bf16*)(ws + WS_P))
#define H ((bf16*)(ws + WS_H))
#define Y ((float*)(ws + WS_Y))
#define BRG ((bf16*)(ws + WS_BRG))
#define BRS ((bf16*)(ws + WS_BRS))
#define BRF ((bf16*)(ws + WS_BRF))
#define MIXB ((bf16*)(ws + WS_MIXB))
#define Qb ((bf16*)(ws + WS_Q))
#define XO ((bf16*)(ws + WS_XO))
#define KV ((bf16*)(ws + WS_KV))
#define MEMN ((bf16*)(ws + WS_MEMN))
#define X ((float*)tab[37])

#define GEMM(EpiT, epi, Ap, Bp, Mv, Nv, Kv) do { pg8::Gemm g_{(const pg8::bf16_t*)(Ap), (const pg8::bf16_t*)(Bp), (Mv), (Nv), (Kv)}; int bid_ = bid, G_ = G; asm volatile("" : "+s"(bid_), "+s"(G_)); pg8::StaticOrder S_; S_.init((Mv), (Nv), G_, bid_); \
        TIDS(); pg8::gemm_phase<EpiT, pg8::StaticOrder, true, true>(ldsg, g_, S_, epi, tid); __syncthreads(); } while (0)

    { PTRS(); TIDS();
#if EN_CONV
      convert_weights(ws, tab, 0, lds, gw, NGW, wave, lane);
      s5_prep(ws, tab, 0, bid * NTHR + tid, G * NTHR);
#endif
      rowop<false, false, true>(tab[1], nullptr, nullptr, nullptr, 0.f, tab[28], MEMN, MMEM, gw, NGW, lane);
      rowop<false, true, true>(tab[0], X, nullptr, nullptr, 0.f, tab[2], H, MTOK, gw, NGW, lane); }
    GSYNC();

    for (int l = 0; l < DEPTH; ++l) {
        { PTRS(); pg8::EpiSwiGLU e{ACT, DFF}; GEMM(pg8::EpiSwiGLU, e, H, Wb + WO_GU1, MTOK, 5632, 1024); }
        GSYNC();
        { PTRS(); pg8::EpiF32 e{Y, DM}; GEMM(pg8::EpiF32, e, ACT, Wb + WO_DOWN1, MTOK, 1024, DFF); }
        GSYNC();
        { PTRS(); TIDS(); rowop<true, true, true>(X, X, Y, tab[5] + l * DM, 0.5f, tab[6] + l * DM, H, MTOK, gw, NGW, lane); }
        GSYNC();
        { PTRS(); pg8::EpiBf16 e{P, LDP}; GEMM(pg8::EpiBf16, e, H, Wb + WO_IN, MTOK, LDP, 1024); }
        { PTRS(); pg8::EpiBf16 e{KV, 2048}; GEMM(pg8::EpiBf16, e, MEMN, Wb + WO_KV, MMEM, 2048, 1024); }
        GSYNC();
#if EN_S5A
        { PTRS(); TIDS(); s5_passA(ws, tab, lds, gw, NGW, wave, lane); }
#endif
#if EN_GLAA
        { PTRS(); TIDS(); for (int u = bid; u < 256; u += G) gla_passA(ws, tab, l, lds, u, tid); }
#endif
#if EN_FOX
        { PTRS(); TIDS();
          for (int pr = bid; pr < 512; pr += G) {
            const int bh = pr >> 3, pp = pr & 7, b = bh >> 3, h = bh & 7;
            float* Fc = (float*)(lds + 24576); float* red = (float*)(lds + 24576 + 8192);
            __syncthreads();
            fox_cumsum(P, b, h, tab[23][l * 8 + h], Fc, red, tid);
            for (int hf = 0; hf < 2; ++hf) { const int qb = hf ? 15 - pp : pp;
                const size_t rq = (size_t)(b * SEQ + qb * 128);
                attn_unit<64, true>(lds, P + rq * LDP + PC_FQ + h * 64, LDP, P + (size_t)(b * SEQ) * LDP + PC_FK + h * 64, LDP, P + (size_t)(b * SEQ) * LDP + PC_FV + h * 64, LDP,
                                    BRF + rq * 512 + h * 64, 512, qb * 128, 2 * qb + 2, Fc, 0.125f, tid); }
          } }
#endif
        GSYNC();
#if EN_S5C
        { PTRS(); TIDS(); for (int u = bid; u < 256; u += G) s5_passC(ws, tab, l, lds, u, tid); }
#endif
#if EN_GLAC
        { PTRS(); TIDS(); for (int u = bid; u < 256; u += G) gla_passC(ws, tab, l, lds, u, tid); }
#endif
        GSYNC();
        { PTRS(); pg8::EpiMerge<0> e{Y, MIXB, P + PC_GATE, LDP}; GEMM(pg8::EpiMerge<0>, e, BRG, Wb + WO_GLAUP, MTOK, 1024, 256); }
        { PTRS(); pg8::EpiMerge<1> e{Y, MIXB, P + PC_GATE + 1024, LDP}; GEMM(pg8::EpiMerge<1>, e, BRS, Wb + WO_S5UP, MTOK, 1024, 256); }
        { PTRS(); pg8::EpiMerge<2> e{Y, MIXB, P + PC_GATE + 2048, LDP}; GEMM(pg8::EpiMerge<2>, e, BRF, Wb + WO_FOXUP, MTOK, 1024, 512); }
        GSYNC();
        { PTRS(); pg8::EpiF32 e{Y, DM}; GEMM(pg8::EpiF32, e, MIXB, Wb + WO_MIXOUT, MTOK, 1024, 1024); }
        GSYNC();
        { PTRS(); TIDS(); rowop<true, true, true>(X, X, Y, tab[26] + l * DM, 1.0f, tab[27] + l * DM, H, MTOK, gw, NGW, lane); }
        GSYNC();
        { PTRS(); pg8::EpiBf16 e{Qb, DM}; GEMM(pg8::EpiBf16, e, H, Wb + WO_Q, MTOK, 1024, 1024); }
        GSYNC();
#if EN_XA
        { PTRS(); TIDS();
          for (int u = bid; u < 512; u += G) { const int qb = u & 15, hd = (u >> 4) & 3, b = u >> 6;
            const size_t rq = (size_t)(b * SEQ + qb * 128);
            attn_unit<256, false>(lds, Qb + rq * DM + hd * 256, DM, KV + (size_t)(b * NMEM) * 2048 + hd * 256, 2048, KV + (size_t)(b * NMEM) * 2048 + 1024 + hd * 256, 2048,
                                  XO + rq * DM + hd * 256, DM, 0, 4, nullptr, 0.0625f, tid); } }
#endif
        GSYNC();
        { PTRS(); pg8::EpiF32 e{Y, DM}; GEMM(pg8::EpiF32, e, XO, Wb + WO_O, MTOK, 1024, 1024); }
        GSYNC();
        { PTRS(); TIDS(); rowop<true, true, true>(X, X, Y, tab[32] + l * DM, 1.0f, tab[33] + l * DM, H, MTOK, gw, NGW, lane); }
        GSYNC();
        { PTRS(); pg8::EpiSwiGLU e{ACT, DFF}; GEMM(pg8::EpiSwiGLU, e, H, Wb + WO_GU2, MTOK, 5632, 1024); }
        GSYNC();
        { PTRS(); pg8::EpiF32 e{Y, DM}; GEMM(pg8::EpiF32, e, ACT, Wb + WO_DOWN2, MTOK, 1024, DFF); }
        GSYNC();
        if (l + 1 < DEPTH) {
            { PTRS(); TIDS(); rowop<true, true, true>(X, X, Y, tab[36] + l * DM, 0.5f, tab[2] + (l + 1) * DM, H, MTOK, gw, NGW, lane); }
            __syncthreads();
            { PTRS(); TIDS();
#if EN_CONV
              convert_weights(ws, tab, l + 1, lds, gw, NGW, wave, lane);
              s5_prep(ws, tab, l + 1, bid * NTHR + tid, G * NTHR);
#endif
              rowop<false, false, true>(tab[1], nullptr, nullptr, nullptr, 0.f, tab[28] + (l + 1) * DM, MEMN, MMEM, gw, NGW, lane); }
            GSYNC();
        } else {
            { PTRS(); TIDS(); rowop<true, true, false>(X, X, Y, tab[36] + l * DM, 0.5f, nullptr, nullptr, MTOK, gw, NGW, lane); }
        }
    }
}

extern "C" void kernel_launch(void* const* d_in, const int* in_sizes, int n_in, void* d_out, int out_size, void* d_ws, size_t ws_size, hipStream_t stream) {
    static int grid = 0;
    if (grid == 0) {
        if (n_in != 37 || out_size != MTOK * DM || ws_size < WS_END) { fprintf(stderr, "kernel_launch: unexpected shapes (n_in %d out %d ws %zu need %zu)\n", n_in, out_size, ws_size, (size_t)WS_END); grid = -1; return; }
        int dev = 0, cus = 0, per_cu = 0;
        hipGetDevice(&dev); hipDeviceGetAttribute(&cus, hipDeviceAttributeMultiprocessorCount, dev);
        if (hipFuncSetAttribute((const void*)fwd_mega, hipFuncAttributeMaxDynamicSharedMemorySize, LDS_BYTES) != hipSuccess) { fprintf(stderr, "kernel_launch: hipFuncSetAttribute failed\n"); grid = -1; return; }
        hipOccupancyMaxActiveBlocksPerMultiprocessor(&per_cu, (const void*)fwd_mega, NTHR, LDS_BYTES);
        (void)hipGetLastError();
        if (per_cu < 1) { fprintf(stderr, "kernel_launch: occupancy query says %d blocks/CU\n", per_cu); }
        grid = cus;
    }
    if (grid < 0) return;
    Params p{};
    for (int i = 0; i < 37; ++i) p.in[i] = (const float*)d_in[i];
    p.out = (float*)d_out; p.ws = (unsigned char*)d_ws;
    void* args[] = {&p};
    hipError_t e = hipLaunchCooperativeKernel((const void*)fwd_mega, dim3(grid), dim3(NTHR), args, LDS_BYTES, stream);
    if (e != hipSuccess) fprintf(stderr, "cooperative launch failed: %s (grid %d)\n", hipGetErrorString(e), grid);
}
```

```cpp
#include <hip/hip_runtime.h>
#include <hip/hip_cooperative_groups.h>
#include <cstdio>
#include <cstdint>
namespace cg = cooperative_groups;
namespace pg8 {
#define PG8_LAS __attribute__((address_space(3)))
typedef unsigned short bf16_t;
typedef short bf16x8 __attribute__((ext_vector_type(8)));
typedef float f32x4 __attribute__((ext_vector_type(4)));
typedef unsigned u32x4 __attribute__((ext_vector_type(4)));
constexpr int BM = 256, BK = 64, HALF = 128, HTB = HALF * BK * 2  , STAGE_BYTES = 8 * HTB, NXCD = 8, WGM = 8;

__host__ __device__ __forceinline__ int lds_byte(int r, int c) { const int st = (r >> 4) * 2 + (c >> 5), rr = r & 15, cc = c & 31, ob = rr * 64 + cc * 2; return st * 1024 + (ob ^ (((ob >> 9) & 1) << 5)); }
__host__ __device__ __forceinline__ void stage_rc(int b, int& R, int& C) { const int st = b / 1024, sb = b % 1024, swz = sb ^ (((sb >> 9) & 1) << 5); R = (st >> 1) * 16 + swz / 64; C = (st & 1) * 32 + (swz % 64) / 2; }
__host__ __device__ __forceinline__ int perm32(int rho) { const int n = rho >> 4, i = rho & 15; return 8 * (i >> 2) + 4 * n + (i & 3); }

struct Unit { int pm, pn; };
struct Gemm { const bf16_t* A; const bf16_t* Bt; int M, N, K; };

struct StaticOrder {
    int nM, nN, nwg, G, c;
    __host__ __device__ void init(int M, int N, int G_, int c_) { nM = M / BM; nN = N / BM; nwg = nM * nN; G = G_; c = c_; }
    __host__ __device__ bool next(int i, Unit& u) const {
        const long L = (long)i * G + c; if (L >= nwg) return false;
        int wgid = (int)L; { const int q = nwg / NXCD, r = nwg % NXCD, xcd = wgid % NXCD, off = wgid / NXCD; wgid = (xcd < r ? xcd * (q + 1) : r * (q + 1) + (xcd - r) * q) + off; }
        const int nig = WGM * nN, gid = wgid / nig, fm = gid * WGM, gsz = (nM - fm) < WGM ? (nM - fm) : WGM;
        u.pm = fm + ((wgid % nig) % gsz); u.pn = (wgid % nig) / gsz; return true;
    }
    __device__ __forceinline__ void a_ready(const Unit&) const {}
    __device__ __forceinline__ void done(const Unit&) const {}
};

__device__ __forceinline__ unsigned cvt_pk_bf16(float lo, float hi) { unsigned r; asm volatile("v_cvt_pk_bf16_f32 %0, %1, %2" : "=v"(r) : "v"(lo), "v"(hi)); return r; }
typedef float f32x2 __attribute__((ext_vector_type(2)));
typedef unsigned u32x2 __attribute__((ext_vector_type(2)));
__device__ __forceinline__ float fast_sigmoid(float x) { return __builtin_amdgcn_rcpf(1.0f + __expf(-x)); }
__device__ __forceinline__ float bf_lo(unsigned w) { return __uint_as_float(w << 16); }
__device__ __forceinline__ float bf_hi(unsigned w) { return __uint_as_float(w & 0xffff0000u); }
struct EpiBf16 {
    static constexpr bool PERM = true, AFTER_DRAIN = false;
    bf16_t* O; int ldc;
    __device__ __forceinline__ void operator()(const f32x4 (&acc)[2][2][4][2], const Unit& u, int wr, int wc, int fr, int fq) const {
        const int row0 = u.pm * BM + wr * 64 + fr; const int col0 = u.pn * BM + wc * 32 + 8 * fq;
#pragma unroll
        for (int ai = 0; ai < 2; ++ai)
#pragma unroll
            for (int m = 0; m < 4; ++m) { bf16_t* rowp = O + (size_t)(row0 + ai * HALF + m * 16) * ldc + col0;
#pragma unroll
                for (int bj = 0; bj < 2; ++bj) { const f32x4 v0 = acc[ai][bj][m][0], v1 = acc[ai][bj][m][1];
                    u32x4 w; w.x = cvt_pk_bf16(v0[0], v0[1]); w.y = cvt_pk_bf16(v0[2], v0[3]); w.z = cvt_pk_bf16(v1[0], v1[1]); w.w = cvt_pk_bf16(v1[2], v1[3]);
                    *(u32x4*)(rowp + bj * HALF) = w; } }
    }
};
struct EpiSwiGLU {
    static constexpr bool PERM = true, AFTER_DRAIN = false;
    bf16_t* O; int ldc;
    __device__ __forceinline__ void operator()(const f32x4 (&acc)[2][2][4][2], const Unit& u, int wr, int wc, int fr, int fq) const {
        const int row0 = u.pm * BM + wr * 64 + fr; const int col0 = u.pn * HALF + wc * 32 + 8 * fq;
#pragma unroll
        for (int ai = 0; ai < 2; ++ai)
#pragma unroll
            for (int m = 0; m < 4; ++m) { bf16_t* rowp = O + (size_t)(row0 + ai * HALF + m * 16) * ldc + col0;
                float r[8];
#pragma unroll
                for (int n = 0; n < 2; ++n)
#pragma unroll
                    for (int j = 0; j < 4; ++j) { const float g = acc[ai][0][m][n][j], up = acc[ai][1][m][n][j]; r[n * 4 + j] = g * fast_sigmoid(g) * up; }
                u32x4 w; w.x = cvt_pk_bf16(r[0], r[1]); w.y = cvt_pk_bf16(r[2], r[3]); w.z = cvt_pk_bf16(r[4], r[5]); w.w = cvt_pk_bf16(r[6], r[7]);
                *(u32x4*)rowp = w; }
    }
};
struct EpiF32 {
    static constexpr bool PERM = false, AFTER_DRAIN = false;
    float* O; int ldc;
    __device__ __forceinline__ void operator()(const f32x4 (&acc)[2][2][4][2], const Unit& u, int wr, int wc, int fr, int fq) const {
        const int row0 = u.pm * BM + wr * 64 + fr; const int col0 = u.pn * BM + wc * 32 + 4 * fq;
#pragma unroll
        for (int ai = 0; ai < 2; ++ai)
#pragma unroll
            for (int m = 0; m < 4; ++m) { float* rowp = O + (size_t)(row0 + ai * HALF + m * 16) * ldc + col0;
#pragma unroll
                for (int bj = 0; bj < 2; ++bj)
#pragma unroll
                    for (int n = 0; n < 2; ++n) *(f32x4*)(rowp + bj * HALF + n * 16) = acc[ai][bj][m][n]; }
    }
};
template <int MODE> struct EpiMerge {
    static constexpr bool PERM = false, AFTER_DRAIN = false;
    float* F; bf16_t* B; const bf16_t* G; int ldg;
    __device__ __forceinline__ void operator()(const f32x4 (&acc)[2][2][4][2], const Unit& u, int wr, int wc, int fr, int fq) const {
        const int row0 = u.pm * BM + wr * 64 + fr; const int col0 = u.pn * BM + wc * 32 + 4 * fq;
#pragma unroll
        for (int ai = 0; ai < 2; ++ai)
#pragma unroll
            for (int m = 0; m < 4; ++m) { const size_t row = (size_t)(row0 + ai * HALF + m * 16);
#pragma unroll
                for (int bj = 0; bj < 2; ++bj)
#pragma unroll
                    for (int n = 0; n < 2; ++n) { const int c = col0 + bj * HALF + n * 16;
                        const u32x2 gw = *(const u32x2*)(G + row * ldg + c);
                        f32x4 s; s[0] = fast_sigmoid(bf_lo(gw.x)); s[1] = fast_sigmoid(bf_hi(gw.x)); s[2] = fast_sigmoid(bf_lo(gw.y)); s[3] = fast_sigmoid(bf_hi(gw.y));
                        f32x4 v = s * acc[ai][bj][m][n];
                        float* fp = F + row * 1024 + c;
                        if (MODE >= 1) v += *(const f32x4*)fp;
                        if (MODE <= 1) *(f32x4*)fp = v;
                        else { u32x2 w; w.x = cvt_pk_bf16(v[0], v[1]); w.y = cvt_pk_bf16(v[2], v[3]); *(u32x2*)(B + row * 1024 + c) = w; } } }
    }
};
template <class Epi, class Sched, bool ALIGN_EPI = false, bool SP2 = false>
__device__ __forceinline__ void gemm_phase(PG8_LAS unsigned char* lds, const Gemm g, const Sched& S, const Epi& E, const int tid) {
    const int wid = __builtin_amdgcn_readfirstlane(tid >> 6), lane = tid & 63, wr = wid >> 2, wc = wid & 3, fr = lane & 15, fq = lane >> 4;
    const int K = g.K, nt = K / BK;
    unsigned voffA[2], voffB[2];
#pragma unroll
    for (int i = 0; i < 2; ++i) { int R, C; stage_rc(tid * 16 + i * 8192, R, C); const int Rb = Epi::PERM ? ((R & ~31) + perm32(R & 31)) : R;
        voffA[i] = (unsigned)(R * K + C) * 2u; voffB[i] = (unsigned)(Rb * K + C) * 2u; }
    const size_t kstep = (size_t)(BK * 2);
    const size_t hstep = (size_t)HALF * K * 2;
    const size_t tstep = 2 * hstep;
    const unsigned ldsw = (unsigned)wid * 1024u;
    const int aoff = lds_byte(wr * 64 + fr, fq * 8), boff = lds_byte(wc * 32 + fr, fq * 8);
#define PG8_SA(b, h) (((b) * 2 + (h)) * HTB)
#define PG8_SB(b, h) ((4 + (b) * 2 + (h)) * HTB)
#define PG8_STAGE(bufoff, gbase, voff) do { _Pragma("unroll") for (int _i = 0; _i < 2; ++_i) \
        __builtin_amdgcn_global_load_lds((const unsigned*)((const char*)(gbase) + (voff)[_i]), (PG8_LAS unsigned*)(lds + (bufoff) + ldsw + _i * 8192), 16, 0, 0); } while (0)
#define PG8_LDA(dst, b, h) do { _Pragma("unroll") for (int m = 0; m < 4; ++m) _Pragma("unroll") for (int k = 0; k < 2; ++k) dst[m][k] = *(const PG8_LAS bf16x8*)(lds + PG8_SA(b, h) + aoff + m * 2048 + k * 1024); } while (0)
#define PG8_LDB(dst, b, h) do { _Pragma("unroll") for (int n = 0; n < 2; ++n) _Pragma("unroll") for (int k = 0; k < 2; ++k) dst[n][k] = *(const PG8_LAS bf16x8*)(lds + PG8_SB(b, h) + boff + n * 2048 + k * 1024); } while (0)
#define PG8_MMA(ai, bj, At, Bt) do { __builtin_amdgcn_s_setprio(1); _Pragma("unroll") for (int m = 0; m < 4; ++m) _Pragma("unroll") for (int n = 0; n < 2; ++n) _Pragma("unroll") for (int k = 0; k < 2; ++k) \
        acc[ai][bj][m][n] = __builtin_amdgcn_mfma_f32_16x16x32_bf16(Bt[n][k], At[m][k], acc[ai][bj][m][n], 0, 0, 0); __builtin_amdgcn_s_setprio(0); } while (0)
#define PG8_WAIT_V(n) asm volatile("s_waitcnt vmcnt(" #n ")" ::: "memory")
#define PG8_WAIT_L(n) asm volatile("s_waitcnt lgkmcnt(" #n ")" ::: "memory")
#define PG8_BAR __builtin_amdgcn_s_barrier()
#define PG8_SCHED __builtin_amdgcn_sched_barrier(0)
    Unit cur, nxt; int ui = 0;
    if (!S.next(0, cur)) return;
    f32x4 acc[2][2][4][2];
#pragma unroll
    for (int a = 0; a < 2; ++a)
#pragma unroll
        for (int b = 0; b < 2; ++b)
#pragma unroll
            for (int m = 0; m < 4; ++m)
#pragma unroll
                for (int n = 0; n < 2; ++n) acc[a][b][m][n] = (f32x4){0.f, 0.f, 0.f, 0.f};
    bf16x8 At[4][2], B0[2][2], B1[2][2];
    const char* cA = (const char*)g.A + (size_t)cur.pm * tstep; const char* cB = (const char*)g.Bt + (size_t)cur.pn * tstep;
    S.a_ready(cur);
    if constexpr (SP2) {
        PG8_STAGE(PG8_SB(0, 0), cB, voffB); PG8_STAGE(PG8_SB(0, 1), cB + hstep, voffB); PG8_STAGE(PG8_SA(0, 0), cA, voffA); PG8_STAGE(PG8_SA(0, 1), cA + hstep, voffA);
        if (wr == 1) PG8_BAR;
        PG8_WAIT_V(2); PG8_BAR;
        PG8_STAGE(PG8_SB(1, 0), cB + kstep, voffB); PG8_STAGE(PG8_SA(1, 0), cA + kstep, voffA); PG8_STAGE(PG8_SB(1, 1), cB + hstep + kstep, voffB);
        PG8_WAIT_V(6); PG8_BAR;
    } else {
        PG8_STAGE(PG8_SB(0, 0), cB, voffB); PG8_STAGE(PG8_SA(0, 0), cA, voffA); PG8_STAGE(PG8_SB(0, 1), cB + hstep, voffB); PG8_STAGE(PG8_SA(0, 1), cA + hstep, voffA);
        if (wr == 1) PG8_BAR;
        PG8_WAIT_V(4); PG8_BAR;
        PG8_STAGE(PG8_SB(1, 0), cB + kstep, voffB); PG8_STAGE(PG8_SA(1, 0), cA + kstep, voffA); PG8_STAGE(PG8_SB(1, 1), cB + hstep + kstep, voffB);
        PG8_WAIT_V(6); PG8_BAR;
    }
    for (;;) {
        const bool has_next = S.next(ui + 1, nxt);
        const char* nA = has_next ? (const char*)g.A + (size_t)nxt.pm * tstep : cA; const char* nB = has_next ? (const char*)g.Bt + (size_t)nxt.pn * tstep : cB;
        for (int t = 0; t < nt; t += 2) {
            const bool last = (t == nt - 2);
            const char* a1 = cA + (size_t)(t + 1) * kstep;
            const char* a2 = last ? nA : cA + (size_t)(t + 2) * kstep; const char* b2 = last ? nB : cB + (size_t)(t + 2) * kstep;
            const char* a3 = a2 + kstep; const char* b3 = b2 + kstep;
            if (last && has_next) S.a_ready(nxt);
            if constexpr (SP2) {
            PG8_LDB(B0, 0, 0); PG8_LDB(B1, 0, 1); PG8_SCHED; PG8_LDA(At, 0, 0); PG8_STAGE(PG8_SA(1, 1), a1 + hstep, voffA);
            PG8_WAIT_V(8); PG8_WAIT_L(0); PG8_BAR; PG8_MMA(0, 0, At, B0); PG8_MMA(0, 1, At, B1); PG8_BAR; PG8_SCHED;
            PG8_LDA(At, 0, 1); PG8_STAGE(PG8_SB(0, 0), b2, voffB); PG8_STAGE(PG8_SB(0, 1), b2 + hstep, voffB); PG8_STAGE(PG8_SA(0, 0), a2, voffA);
            PG8_WAIT_V(8); PG8_WAIT_L(0); PG8_BAR; PG8_MMA(1, 0, At, B0); PG8_MMA(1, 1, At, B1); PG8_BAR; PG8_SCHED;
            PG8_LDB(B0, 1, 0); PG8_LDB(B1, 1, 1); PG8_SCHED; PG8_LDA(At, 1, 0); PG8_STAGE(PG8_SA(0, 1), a2 + hstep, voffA);
            PG8_WAIT_V(8); PG8_WAIT_L(0); PG8_BAR; PG8_MMA(0, 0, At, B0); PG8_MMA(0, 1, At, B1); PG8_BAR; PG8_SCHED;
            PG8_LDA(At, 1, 1); PG8_STAGE(PG8_SB(1, 0), b3, voffB); PG8_STAGE(PG8_SB(1, 1), b3 + hstep, voffB); PG8_STAGE(PG8_SA(1, 0), a3, voffA);
            PG8_WAIT_V(8); PG8_WAIT_L(0); PG8_BAR; PG8_MMA(1, 0, At, B0); PG8_MMA(1, 1, At, B1); PG8_BAR; PG8_SCHED;
            } else {
            PG8_LDB(B0, 0, 0); PG8_SCHED; PG8_LDA(At, 0, 0); PG8_STAGE(PG8_SA(1, 1), a1 + hstep, voffA);
            PG8_WAIT_L(8); PG8_BAR; PG8_WAIT_L(0); PG8_MMA(0, 0, At, B0); PG8_BAR; PG8_SCHED;
            PG8_LDB(B1, 0, 1); PG8_STAGE(PG8_SB(0, 0), b2, voffB);
            PG8_BAR; PG8_WAIT_L(0); PG8_MMA(0, 1, At, B1); PG8_BAR;
            PG8_LDA(At, 0, 1); PG8_STAGE(PG8_SA(0, 0), a2, voffA);
            PG8_BAR; PG8_WAIT_L(0); PG8_MMA(1, 0, At, B0); PG8_BAR; PG8_SCHED;
            PG8_STAGE(PG8_SB(0, 1), b2 + hstep, voffB);
            PG8_WAIT_V(6); PG8_BAR; PG8_MMA(1, 1, At, B1); PG8_BAR;
            PG8_LDB(B0, 1, 0); PG8_SCHED; PG8_LDA(At, 1, 0); PG8_STAGE(PG8_SA(0, 1), a2 + hstep, voffA);
            PG8_WAIT_L(8); PG8_BAR; PG8_WAIT_L(0); PG8_MMA(0, 0, At, B0); PG8_BAR; PG8_SCHED;
            PG8_LDB(B1, 1, 1); PG8_STAGE(PG8_SB(1, 0), b3, voffB);
            PG8_BAR; PG8_WAIT_L(0); PG8_MMA(0, 1, At, B1); PG8_BAR;
            PG8_LDA(At, 1, 1); PG8_STAGE(PG8_SA(1, 0), a3, voffA);
            PG8_BAR; PG8_WAIT_L(0); PG8_MMA(1, 0, At, B0); PG8_BAR; PG8_SCHED;
            PG8_STAGE(PG8_SB(1, 1), b3 + hstep, voffB);
            PG8_WAIT_V(6); PG8_BAR; PG8_MMA(1, 1, At, B1); PG8_BAR;
            }
        }
        if constexpr (ALIGN_EPI) { if (wr == 0) PG8_BAR; }
        if constexpr (!Epi::AFTER_DRAIN) { int l2_; asm volatile("v_mbcnt_lo_u32_b32 %0, -1, 0\n\tv_mbcnt_hi_u32_b32 %0, -1, %0" : "=v"(l2_)); E(acc, cur, wr, wc, l2_ & 15, l2_ >> 4); S.done(cur); }
        if (!has_next) break;
#pragma unroll
        for (int a = 0; a < 2; ++a)
#pragma unroll
            for (int b = 0; b < 2; ++b)
#pragma unroll
                for (int m = 0; m < 4; ++m)
#pragma unroll
                    for (int n = 0; n < 2; ++n) acc[a][b][m][n] = (f32x4){0.f, 0.f, 0.f, 0.f};
        cur = nxt; cA = nA; cB = nB; ++ui;
        if constexpr (ALIGN_EPI) { if (wr == 1) PG8_BAR; }
    }
    PG8_WAIT_V(0);
    if constexpr (!ALIGN_EPI) { if (wr == 0) PG8_BAR; }
    PG8_BAR;
    if constexpr (Epi::AFTER_DRAIN) { E.fused(acc, cur, wr, wc, fr, fq, lds, wid, lane); S.done(cur); }
#undef PG8_SA
#undef PG8_SB
#undef PG8_STAGE
#undef PG8_LDA
#undef PG8_LDB
#undef PG8_MMA
#undef PG8_WAIT_V
#undef PG8_WAIT_L
#undef PG8_BAR
#undef PG8_SCHED
}
}
#ifndef EN_S5A
#define EN_S5A 1
#endif
#ifndef EN_GLAA
#define EN_GLAA 1
#endif
#ifndef EN_FOX
#define EN_FOX 1
#endif
#ifndef EN_S5C
#define EN_S5C 1
#endif
#ifndef EN_GLAC
#define EN_GLAC 1
#endif
#ifndef EN_XA
#define EN_XA 1
#endif
#ifndef EN_CONV
#define EN_CONV 1
#endif
typedef unsigned short bf16;
typedef unsigned v4u __attribute__((ext_vector_type(4)));
typedef unsigned v2u __attribute__((ext_vector_type(2)));
typedef float f32x4 __attribute__((ext_vector_type(4)));
typedef short bf16x8 __attribute__((ext_vector_type(8)));
#define LAS __attribute__((address_space(3)))

constexpr int MTOK = 16384, DM = 1024, SEQ = 2048, NB = 8, DFF = 2816, NMEM = 256, MMEM = NB * NMEM, DEPTH = 4;
constexpr int LDP = 5888, D_IN = 5656;
constexpr int PC_GQ = 0, PC_GK = 128, PC_GV = 256, PC_GR = 512, PC_SU = 768, PC_FQ = 1024, PC_FK = 1536, PC_FV = 2048, PC_GD = 2560, PC_FF = 2576, PC_GATE = 2816;
constexpr float EPS = 1e-6f;
constexpr int NTHR = 512, NWAVES = 8;
constexpr int LDS_BYTES = 147456;

constexpr size_t WO_GU1 = 0, WO_DOWN1 = WO_GU1 + (size_t)5632 * 1024, WO_IN = WO_DOWN1 + (size_t)1024 * 2816, WO_GLAUP = WO_IN + (size_t)5888 * 1024, WO_S5UP = WO_GLAUP + 1024 * 256,
                 WO_FOXUP = WO_S5UP + 1024 * 256, WO_GLU = WO_FOXUP + 1024 * 512, WO_MIXOUT = WO_GLU + 256 * 256, WO_Q = WO_MIXOUT + 1024 * 1024, WO_KV = WO_Q + 1024 * 1024,
                 WO_O = WO_KV + 2048 * 1024, WO_GU2 = WO_O + 1024 * 1024, WO_DOWN2 = WO_GU2 + (size_t)5632 * 1024, WO_END = WO_DOWN2 + (size_t)1024 * 2816;
constexpr size_t MiB = (size_t)1 << 20;
constexpr size_t WS_W = 1 * MiB, WS_P = 64 * MiB, WS_H = 248 * MiB, WS_Y = 280 * MiB, WS_BRG = 344 * MiB, WS_BRS = 352 * MiB, WS_BRF = 360 * MiB, WS_MIXB = 376 * MiB,
                 WS_Q = 344 * MiB, WS_XO = 376 * MiB, WS_KV = 408 * MiB, WS_MEMN = 416 * MiB, WS_DS = 420 * MiB, WS_DEC = 428 * MiB, WS_S5L = 429 * MiB, WS_S5P = 431 * MiB, WS_END = 432 * MiB;
static_assert(WS_W + WO_END * 2 <= WS_P, "weights fit");
static_assert(WS_P + (size_t)MTOK * LDP * 2 <= WS_H, "P fits");
constexpr size_t S5P_ABAR = 0, S5P_A64 = 8192, S5P_BBAR = 16384, S5P_CMAT = 16384 + 131072;

struct Params { const float* in[37]; float* out; unsigned char* ws; };

__device__ __forceinline__ unsigned f2bf(float f) { unsigned u = __builtin_bit_cast(unsigned, f); return (u + 0x7fffu + ((u >> 16) & 1u)) >> 16; }
__device__ __forceinline__ unsigned pk2(float lo, float hi) { return f2bf(lo) | (f2bf(hi) << 16); }
__device__ __forceinline__ float bf2f(unsigned h) { return __uint_as_float(h << 16); }
__device__ __forceinline__ float bflo(unsigned w) { return __uint_as_float(w << 16); }
__device__ __forceinline__ float bfhi(unsigned w) { return __uint_as_float(w & 0xffff0000u); }
#define LDS_WAIT() asm volatile("s_waitcnt lgkmcnt(0)" ::: "memory")
__device__ __forceinline__ float wave_sum(float v) {
#pragma unroll
    for (int o = 1; o < 64; o <<= 1) v += __shfl_xor(v, o);
    return v;
}
__device__ __forceinline__ float logsig(float z) { return fminf(z, 0.f) - logf(1.0f + expf(-fabsf(z))); }
__device__ __forceinline__ float sigmoidf_(float x) { return 1.0f / (1.0f + __expf(-x)); }
__device__ __forceinline__ float gelu_tanh(float x) { const float z = 0.7978845608028654f * (x + 0.044715f * x * x * x); const float t = 1.0f - 2.0f / (__expf(2.0f * z) + 1.0f); return 0.5f * x * (1.0f + t); }

__device__ __forceinline__ int srccol(int kind, int j) {
    if (kind == 0) return j;
    if (kind == 1) { const int pn = j >> 8, r = j & 255; return r < 128 ? 128 * pn + r : 2816 + 128 * pn + (r - 128); }
    if (j < 768) return j;
    if (j < 1024) return 784 + (j - 768);
    if (j < 2560) return 1040 + (j - 1024);
    if (j < 2576) return 768 + (j - 2560);
    if (j < 2584) return 2576 + (j - 2576);
    if (j < 2816) return -1;
    return 2584 + (j - 2816);
}
__device__ __forceinline__ void transpose_item(const float* W, int K, int Nsrc, int Ndst, int kind, bf16* WT, float* scr, int item, int lane) {
    const int nblk = Ndst / 32, kb = item / nblk, nb = item % nblk, k0 = 64 * kb, n0 = 32 * nb;
    const int sc = srccol(kind, n0 + (lane & 31));
#pragma unroll 8
    for (int i = 0; i < 32; ++i) { const int kk = 2 * i + (lane >> 5); scr[kk * 33 + (lane & 31)] = sc >= 0 ? W[(size_t)(k0 + kk) * Nsrc + sc] : 0.f; }
    LDS_WAIT();
    const int c = lane & 7;
#pragma unroll
    for (int j = 0; j < 4; ++j) { const int n = (lane >> 3) + 8 * j; const float* s = scr + (8 * c) * 33 + n;
        v4u o; o.x = pk2(s[0 * 33], s[1 * 33]); o.y = pk2(s[2 * 33], s[3 * 33]); o.z = pk2(s[4 * 33], s[5 * 33]); o.w = pk2(s[6 * 33], s[7 * 33]);
        *(v4u*)(WT + (size_t)(n0 + n) * K + k0 + 8 * c) = o; }
    LDS_WAIT();
}
struct ConvJob { int in_idx; int K, Nsrc, Ndst, kind; size_t wo; };
__device__ __forceinline__ void convert_weights(unsigned char* ws, const float* const* tab, int l, char* lds, int gw, int NGW, int wave, int lane) {
    float* scr = (float*)(lds + wave * 8448);
    bf16* Wb = (bf16*)(ws + WS_W);
    const int  jin[13]  = {3, 4, 7, 11, 22, 24, 20, 25, 29, 30, 31, 34, 35};
    const int  jK[13]   = {1024, 2816, 1024, 256, 256, 512, 256, 1024, 1024, 1024, 1024, 1024, 2816};
    const int  jNs[13]  = {5632, 1024, D_IN, 1024, 1024, 1024, 256, 1024, 1024, 2048, 1024, 5632, 1024};
    const int  jNd[13]  = {5632, 1024, 5888, 1024, 1024, 1024, 256, 1024, 1024, 2048, 1024, 5632, 1024};
    const int  jkind[13]= {1, 0, 2, 0, 0, 0, 0, 0, 0, 0, 0, 1, 0};
    const size_t jwo[13]= {WO_GU1, WO_DOWN1, WO_IN, WO_GLAUP, WO_S5UP, WO_FOXUP, WO_GLU, WO_MIXOUT, WO_Q, WO_KV, WO_O, WO_GU2, WO_DOWN2};
    int base = 0;
#pragma unroll
    for (int j = 0; j < 13; ++j) {
        const int K = jK[j], Ns = jNs[j], Nd = jNd[j];
        const int nitems = (K / 64) * (Nd / 32);
        const float* W = tab[jin[j]] + (size_t)l * K * Ns;
        int first = (gw - (base % NGW) + NGW) % NGW;
        for (int it = first; it < nitems; it += NGW) transpose_item(W, K, Ns, Nd, jkind[j], Wb + jwo[j], scr, it, lane);
        base += nitems;
    }
}
__device__ __forceinline__ void s5_prep(unsigned char* ws, const float* const* tab, int l, int gtid, int GT) {
    unsigned char* sp = ws + WS_S5P;
    float2* ABAR = (float2*)(sp + S5P_ABAR); float2* A64 = (float2*)(sp + S5P_A64); float2* BBAR = (float2*)(sp + S5P_BBAR); bf16* CMAT = (bf16*)(sp + S5P_CMAT);
    const float* a_re = tab[12] + l * 1024; const float* a_im = tab[13] + l * 1024; const float* log_dt = tab[14] + l * 16;
    const float* b_re = tab[15] + (size_t)l * 16384; const float* b_im = tab[16] + (size_t)l * 16384;
    const float* c_re = tab[17] + (size_t)l * 16384; const float* c_im = tab[18] + (size_t)l * 16384;
    for (int idx = gtid; idx < 1024; idx += GT) {
        const int g = idx >> 6;
        const float lre = fminf(a_re[idx], -1e-4f), lim = a_im[idx], dt = expf(log_dt[g]);
        const float mag = expf(lre * dt);
        float sn, cs; sincosf(lim * dt, &sn, &cs);
        const float abr = mag * cs, abi = mag * sn;
        const float den = lre * lre + lim * lim;
        const float zr = ((abr - 1.0f) * lre + abi * lim) / den, zi = (abi * lre - (abr - 1.0f) * lim) / den;
        ABAR[idx] = make_float2(abr, abi);
        float pr = abr, pi = abi;
#pragma unroll
        for (int s = 0; s < 6; ++s) { const float nr = pr * pr - pi * pi, ni = 2.0f * pr * pi; pr = nr; pi = ni; }
        A64[idx] = make_float2(pr, pi);
        for (int h = 0; h < 16; ++h) { const float br = b_re[idx * 16 + h], bi = b_im[idx * 16 + h]; BBAR[idx * 16 + h] = make_float2(zr * br - zi * bi, zr * bi + zi * br); }
    }
    for (int idx = gtid; idx < 32768; idx += GT) {
        const int j = idx & 7, ln = (idx >> 3) & 63, ks = (idx >> 9) & 3, g = idx >> 11;
        const int k = 32 * ks + 8 * (ln >> 4) + j, h = ln & 15;
        const float v = k < 64 ? c_re[(g * 16 + h) * 64 + k] : -c_im[(g * 16 + h) * 64 + (k - 64)];
        CMAT[idx] = (bf16)f2bf(v);
    }
}
template <bool HASY, bool HASX, bool HASH>
__device__ __forceinline__ void rowop(const float* xin, float* xout, const float* Y, const float* postg, float coef, const float* preg, bf16* H, int nrows, int gw, int NGW, int lane) {
    for (int m = gw; m < nrows; m += NGW) {
        const f32x4* xr = (const f32x4*)(xin + (size_t)m * DM) + lane;
        f32x4 v[4];
#pragma unroll
        for (int j = 0; j < 4; ++j) v[j] = xr[64 * j];
        if (HASY) {
            const f32x4* yr = (const f32x4*)(Y + (size_t)m * DM) + lane; f32x4 y[4]; float s = 0.f;
#pragma unroll
            for (int j = 0; j < 4; ++j) { y[j] = yr[64 * j]; s += (y[j].x * y[j].x + y[j].y * y[j].y) + (y[j].z * y[j].z + y[j].w * y[j].w); }
            const float r = coef / sqrtf(wave_sum(s) * (1.0f / DM) + EPS);
#pragma unroll
            for (int j = 0; j < 4; ++j) { const f32x4 g = ((const f32x4*)postg)[lane + 64 * j]; v[j] += y[j] * g * r; }
        }
        if (HASX) { f32x4* xo = (f32x4*)(xout + (size_t)m * DM) + lane;
#pragma unroll
            for (int j = 0; j < 4; ++j) xo[64 * j] = v[j]; }
        if (HASH) {
            float s2 = 0.f;
#pragma unroll
            for (int j = 0; j < 4; ++j) s2 += (v[j].x * v[j].x + v[j].y * v[j].y) + (v[j].z * v[j].z + v[j].w * v[j].w);
            const float r2 = 1.0f / sqrtf(wave_sum(s2) * (1.0f / DM) + EPS);
            v2u* ho = (v2u*)(H + (size_t)m * DM) + lane;
#pragma unroll
            for (int j = 0; j < 4; ++j) { const f32x4 g = ((const f32x4*)preg)[lane + 64 * j]; v2u w; w.x = pk2(v[j].x * r2 * g.x, v[j].y * r2 * g.y); w.y = pk2(v[j].z * r2 * g.z, v[j].w * r2 * g.w); ho[64 * j] = w; }
        }
    }
}
template <int DH, bool FOX>
__device__ __forceinline__ void attn_unit(char* lds, const bf16* Qp, int ldq, const bf16* Kp, int ldk, const bf16* Vp, int ldv, bf16* Op, int ldo,
                                          int qpos0, int nkt, const float* Fc, float scale, int tid) {
    constexpr int KS = DH + 8, VS = 72, NPASS = DH / 64, CPR = DH / 8;
    bf16* Ks = (bf16*)lds; bf16* Vt = Ks + 64 * KS;
    const int lane = tid & 63, wave = tid >> 6, li = lane & 15, qd = lane >> 4;
    bf16x8 qf[DH / 32];
    { const bf16* qrow = Qp + (size_t)(wave * 16 + li) * ldq;
#pragma unroll
      for (int ks = 0; ks < DH / 32; ++ks) qf[ks] = *(const bf16x8*)(qrow + 32 * ks + 8 * qd); }
    const int qpos = qpos0 + wave * 16 + li;
    float Fq = 0.f; if (FOX) Fq = Fc[qpos];
    f32x4 oacc[DH / 16];
#pragma unroll
    for (int i = 0; i < DH / 16; ++i) oacc[i] = (f32x4){0.f, 0.f, 0.f, 0.f};
    float mrun = -INFINITY, lsum = 0.f;
    v4u kreg[NPASS], vreg[NPASS];
#pragma unroll
    for (int ps = 0; ps < NPASS; ++ps) { const int c = tid + NTHR * ps, key = c / CPR, dc = c % CPR;
        kreg[ps] = *(const v4u*)(Kp + (size_t)key * ldk + dc * 8); vreg[ps] = *(const v4u*)(Vp + (size_t)key * ldv + dc * 8); }
    for (int kt = 0; kt < nkt; ++kt) {
        __syncthreads();
#pragma unroll
        for (int ps = 0; ps < NPASS; ++ps) { const int c = tid + NTHR * ps, key = c / CPR, dc = c % CPR;
            *(v4u*)(Ks + key * KS + dc * 8) = kreg[ps];
            const v4u vv = vreg[ps];
            bf16* vt = Vt + (dc * 8) * VS + key;
            vt[0 * VS] = (bf16)(vv.x & 0xffffu); vt[1 * VS] = (bf16)(vv.x >> 16); vt[2 * VS] = (bf16)(vv.y & 0xffffu); vt[3 * VS] = (bf16)(vv.y >> 16);
            vt[4 * VS] = (bf16)(vv.z & 0xffffu); vt[5 * VS] = (bf16)(vv.z >> 16); vt[6 * VS] = (bf16)(vv.w & 0xffffu); vt[7 * VS] = (bf16)(vv.w >> 16); }
        __syncthreads();
        if (kt + 1 < nkt) {
#pragma unroll
            for (int ps = 0; ps < NPASS; ++ps) { const int c = tid + NTHR * ps, key = (kt + 1) * 64 + c / CPR, dc = c % CPR;
                kreg[ps] = *(const v4u*)(Kp + (size_t)key * ldk + dc * 8); vreg[ps] = *(const v4u*)(Vp + (size_t)key * ldv + dc * 8); }
        }
        f32x4 s[4];
#pragma unroll
        for (int kb = 0; kb < 4; ++kb) { s[kb] = (f32x4){0.f, 0.f, 0.f, 0.f};
#pragma unroll
            for (int ks = 0; ks < DH / 32; ++ks) { const bf16x8 a = *(const bf16x8*)(Ks + (16 * kb + li) * KS + 32 * ks + 8 * qd); s[kb] = __builtin_amdgcn_mfma_f32_16x16x32_bf16(a, qf[ks], s[kb], 0, 0, 0); } }
        float tmax = -INFINITY;
#pragma unroll
        for (int kb = 0; kb < 4; ++kb)
#pragma unroll
            for (int i = 0; i < 4; ++i) { const int key = kt * 64 + 16 * kb + 4 * qd + i; float v = s[kb][i] * scale;
                if (FOX) { v += Fq - Fc[key]; if (key > qpos) v = -INFINITY; }
                s[kb][i] = v; tmax = fmaxf(tmax, v); }
        tmax = fmaxf(tmax, __shfl_xor(tmax, 16)); tmax = fmaxf(tmax, __shfl_xor(tmax, 32));
        const float mnew = fmaxf(mrun, tmax);
        const float alpha = __expf(mrun - mnew);
        mrun = mnew;
        float psum = 0.f;
#pragma unroll
        for (int kb = 0; kb < 4; ++kb)
#pragma unroll
            for (int i = 0; i < 4; ++i) { const float e = __expf(s[kb][i] - mnew); s[kb][i] = e; psum += e; }
        lsum = lsum * alpha + psum;
#pragma unroll
        for (int i = 0; i < DH / 16; ++i) oacc[i] *= alpha;
        bf16x8 pf[2];
#pragma unroll
        for (int kk = 0; kk < 2; ++kk) { v4u w; w.x = pk2(s[2 * kk][0], s[2 * kk][1]); w.y = pk2(s[2 * kk][2], s[2 * kk][3]); w.z = pk2(s[2 * kk + 1][0], s[2 * kk + 1][1]); w.w = pk2(s[2 * kk + 1][2], s[2 * kk + 1][3]);
            pf[kk] = __builtin_bit_cast(bf16x8, w); }
#pragma unroll
        for (int db = 0; db < DH / 16; ++db)
#pragma unroll
            for (int kk = 0; kk < 2; ++kk) { const bf16* vp = Vt + (16 * db + li) * VS + 32 * kk + 4 * qd;
                const v2u lo = *(const v2u*)vp, hi = *(const v2u*)(vp + 16);
                v4u w; w.x = lo.x; w.y = lo.y; w.z = hi.x; w.w = hi.y;
                oacc[db] = __builtin_amdgcn_mfma_f32_16x16x32_bf16(__builtin_bit_cast(bf16x8, w), pf[kk], oacc[db], 0, 0, 0); }
    }
    lsum += __shfl_xor(lsum, 16); lsum += __shfl_xor(lsum, 32);
    const float inv = 1.0f / lsum;
    bf16* orow = Op + (size_t)(wave * 16 + li) * ldo + 4 * qd;
#pragma unroll
    for (int db = 0; db < DH / 16; ++db) { v2u w; w.x = pk2(oacc[db][0] * inv, oacc[db][1] * inv); w.y = pk2(oacc[db][2] * inv, oacc[db][3] * inv); *(v2u*)(orow + 16 * db) = w; }
}
__device__ __forceinline__ void fox_cumsum(const bf16* P, int b, int h, float fb, float* Fc, float* red, int tid) {
    const int lane = tid & 63, wave = tid >> 6;
    float lf[4];
#pragma unroll
    for (int i = 0; i < 4; ++i) { const float z = bf2f(P[(size_t)(b * SEQ + 4 * tid + i) * LDP + PC_FF + h]) + fb; lf[i] = logsig(z); }
    const float loc = (lf[0] + lf[1]) + (lf[2] + lf[3]);
    float inc = loc;
#pragma unroll
    for (int o = 1; o < 64; o <<= 1) { const float t = __shfl_up(inc, o); if (lane >= o) inc += t; }
    __syncthreads();
    if (lane == 63) red[wave] = inc;
    __syncthreads();
    float off = inc - loc;
    for (int w = 0; w < wave; ++w) off += red[w];
    float run = off;
#pragma unroll
    for (int i = 0; i < 4; ++i) { run += lf[i]; Fc[4 * tid + i] = run; }
    __syncthreads();
}
__device__ __forceinline__ void s5_load_u(const bf16* P, int row0, int g, float* us, int lane) {
    const v4u* src = (const v4u*)(P + (size_t)(row0 + lane) * LDP + PC_SU + g * 16);
    const v4u a = src[0], c = src[1];
    f32x4* dst = (f32x4*)(us + lane * 16);
    dst[0] = (f32x4){bflo(a.x), bfhi(a.x), bflo(a.y), bfhi(a.y)}; dst[1] = (f32x4){bflo(a.z), bfhi(a.z), bflo(a.w), bfhi(a.w)};
    dst[2] = (f32x4){bflo(c.x), bfhi(c.x), bflo(c.y), bfhi(c.y)}; dst[3] = (f32x4){bflo(c.z), bfhi(c.z), bflo(c.w), bfhi(c.w)};
    LDS_WAIT();
}
__device__ __forceinline__ void s5_bu(const float* us, int t, const float (&bre)[16], const float (&bim)[16], float& bur, float& bui) {
    const f32x4* up = (const f32x4*)(us + t * 16);
    bur = 0.f; bui = 0.f;
#pragma unroll
    for (int q = 0; q < 4; ++q) { const f32x4 u4 = up[q];
#pragma unroll
        for (int j = 0; j < 4; ++j) { bur += bre[4 * q + j] * u4[j]; bui += bim[4 * q + j] * u4[j]; } }
}
__device__ __forceinline__ void s5_passA(unsigned char* ws, const float* const* tab, char* lds, int gw, int NGW, int wave, int lane) {
    const bf16* P = (const bf16*)(ws + WS_P);
    const float2* ABAR = (const float2*)(ws + WS_S5P + S5P_ABAR); const float2* BBAR = (const float2*)(ws + WS_S5P + S5P_BBAR);
    float* L = (float*)(ws + WS_S5L);
    float* us = (float*)(lds + wave * 4096);
    for (int u = gw; u < 4096; u += NGW) {
        const int n = u & 31, g = (u >> 5) & 15, b = u >> 9;
        LDS_WAIT();
        s5_load_u(P, b * SEQ + n * 64, g, us, lane);
        float bre[16], bim[16];
#pragma unroll
        for (int h = 0; h < 16; ++h) { const float2 v = BBAR[(g * 64 + lane) * 16 + h]; bre[h] = v.x; bim[h] = v.y; }
        const float2 ab = ABAR[g * 64 + lane];
        float xr = 0.f, xi = 0.f;
        for (int t = 0; t < 64; ++t) { float bur, bui; s5_bu(us, t, bre, bim, bur, bui);
            const float nr = ab.x * xr - ab.y * xi + bur, ni = ab.x * xi + ab.y * xr + bui; xr = nr; xi = ni; }
        L[(size_t)u * 128 + lane] = xr; L[(size_t)u * 128 + 64 + lane] = xi;
    }
}
__device__ __forceinline__ void s5_passC(unsigned char* ws, const float* const* tab, int l, char* lds, int unit, int tid) {
    const int lane = tid & 63, wave = tid >> 6, li = lane & 15, qd = lane >> 4;
    const int b = unit >> 5, n = unit & 31, row0 = b * SEQ + n * 64;
    const bf16* P = (const bf16*)(ws + WS_P);
    const float2* ABAR = (const float2*)(ws + WS_S5P + S5P_ABAR); const float2* A64 = (const float2*)(ws + WS_S5P + S5P_A64);
    const float2* BBAR = (const float2*)(ws + WS_S5P + S5P_BBAR); const bf16* CMAT = (const bf16*)(ws + WS_S5P + S5P_CMAT);
    const float* L = (const float*)(ws + WS_S5L);
    bf16* Xs = (bf16*)(lds + wave * 8704);
    float* us = (float*)(lds + 69632 + wave * 4096);
    bf16* Ys = (bf16*)(lds + 102400);
    __syncthreads();
    for (int gi = 0; gi < 2; ++gi) {
        const int g = 2 * wave + gi;
        LDS_WAIT();
        s5_load_u(P, row0, g, us, lane);
        float xr = 0.f, xi = 0.f;
        { const float2 a64 = A64[g * 64 + lane]; const float* Lb = L + (size_t)((b * 16 + g) * 32) * 128 + lane;
          for (int m = 0; m < n; ++m) { const float lr = Lb[m * 128], lim = Lb[m * 128 + 64]; const float nr = a64.x * xr - a64.y * xi + lr, ni = a64.x * xi + a64.y * xr + lim; xr = nr; xi = ni; } }
        float bre[16], bim[16];
#pragma unroll
        for (int h = 0; h < 16; ++h) { const float2 v = BBAR[(g * 64 + lane) * 16 + h]; bre[h] = v.x; bim[h] = v.y; }
        const float2 ab = ABAR[g * 64 + lane];
        bf16x8 cfr[4];
#pragma unroll
        for (int ks = 0; ks < 4; ++ks) cfr[ks] = *(const bf16x8*)(CMAT + ((size_t)((g * 4 + ks) * 64 + lane)) * 8);
        const float dsk = tab[19][l * 256 + g * 16 + li];
        for (int half = 0; half < 2; ++half) {
            for (int tt = 0; tt < 32; ++tt) { const int t = half * 32 + tt; float bur, bui; s5_bu(us, t, bre, bim, bur, bui);
                const float nr = ab.x * xr - ab.y * xi + bur, ni = ab.x * xi + ab.y * xr + bui; xr = nr; xi = ni;
                Xs[tt * 136 + lane] = (bf16)f2bf(xr); Xs[tt * 136 + 64 + lane] = (bf16)f2bf(xi); }
            LDS_WAIT();
#pragma unroll
            for (int rb = 0; rb < 2; ++rb) { f32x4 acc = (f32x4){0.f, 0.f, 0.f, 0.f};
#pragma unroll
                for (int ks = 0; ks < 4; ++ks) { const bf16x8 a = *(const bf16x8*)(Xs + (16 * rb + li) * 136 + 32 * ks + 8 * qd); acc = __builtin_amdgcn_mfma_f32_16x16x32_bf16(a, cfr[ks], acc, 0, 0, 0); }
#pragma unroll
                for (int i = 0; i < 4; ++i) { const int t = half * 32 + 16 * rb + 4 * qd + i; const float yv = gelu_tanh(acc[i] + dsk * us[t * 16 + li]); Ys[t * 264 + g * 16 + li] = (bf16)f2bf(yv); } }
            LDS_WAIT();
        }
    }
    __syncthreads();
    { const bf16* Wg = (const bf16*)(ws + WS_W) + WO_GLU; const float* gb = tab[21] + l * 256; bf16* BRS = (bf16*)(ws + WS_BRS);
      f32x4 acc[4][2];
#pragma unroll
      for (int rb = 0; rb < 4; ++rb) { acc[rb][0] = (f32x4){0.f, 0.f, 0.f, 0.f}; acc[rb][1] = (f32x4){0.f, 0.f, 0.f, 0.f}; }
#pragma unroll
      for (int ks = 0; ks < 8; ++ks) { bf16x8 bfr[2];
#pragma unroll
          for (int cb = 0; cb < 2; ++cb) bfr[cb] = *(const bf16x8*)(Wg + (size_t)(32 * wave + 16 * cb + li) * 256 + 32 * ks + 8 * qd);
#pragma unroll
          for (int rb = 0; rb < 4; ++rb) { const bf16x8 a = *(const bf16x8*)(Ys + (16 * rb + li) * 264 + 32 * ks + 8 * qd);
#pragma unroll
              for (int cb = 0; cb < 2; ++cb) acc[rb][cb] = __builtin_amdgcn_mfma_f32_16x16x32_bf16(a, bfr[cb], acc[rb][cb], 0, 0, 0); } }
#pragma unroll
      for (int rb = 0; rb < 4; ++rb)
#pragma unroll
          for (int cb = 0; cb < 2; ++cb) { const int col = 32 * wave + 16 * cb + li; const float bias = gb[col];
#pragma unroll
              for (int i = 0; i < 4; ++i) { const int t = 16 * rb + 4 * qd + i; const float yv = bf2f(Ys[t * 264 + col]); const float o = yv * sigmoidf_(acc[rb][cb][i] + bias);
                  BRS[(size_t)(row0 + t) * 256 + col] = (bf16)f2bf(o); } } }
    __syncthreads();
}
struct GlaLds { float* QF; float* QI; float* KI; float* KE; float* G; float* V; float* AT; float* SP; float* GD; };
__device__ __forceinline__ GlaLds gla_lds(char* lds) { GlaLds s; float* f = (float*)lds; s.QF = f; s.QI = f + 2112; s.KI = f + 4224; s.KE = f + 6336; s.G = f + 8448; s.V = f + 10560; s.AT = f + 14656; s.SP = f + 18816; s.GD = f + 20864; return s; }
__device__ __forceinline__ void gla_load(unsigned char* ws, const float* const* tab, int l, const GlaLds& s, int row0, int h, int tid, bool need_q) {
    const bf16* P = (const bf16*)(ws + WS_P);
    const int t = tid >> 3, c8 = tid & 7;
    const bf16* prow = P + (size_t)(row0 + t) * LDP;
    if (need_q) { const v2u w = *(const v2u*)(prow + PC_GQ + h * 32 + 4 * c8); float* d = s.QF + t * 33 + 4 * c8; d[0] = bflo(w.x); d[1] = bfhi(w.x); d[2] = bflo(w.y); d[3] = bfhi(w.y); }
    { const v2u w = *(const v2u*)(prow + PC_GK + h * 32 + 4 * c8); float* d = s.KI + t * 33 + 4 * c8; d[0] = bflo(w.x); d[1] = bfhi(w.x); d[2] = bflo(w.y); d[3] = bfhi(w.y); }
    { const v4u w = *(const v4u*)(prow + PC_GV + h * 64 + 8 * c8); f32x4* d = (f32x4*)(s.V + t * 64 + 8 * c8); d[0] = (f32x4){bflo(w.x), bfhi(w.x), bflo(w.y), bfhi(w.y)}; d[1] = (f32x4){bflo(w.z), bfhi(w.z), bflo(w.w), bfhi(w.w)}; }
    if (tid < 128) { const int tt = tid >> 1, hf = tid & 1; const v4u w = *(const v4u*)(P + (size_t)(row0 + tt) * LDP + PC_GD + 8 * hf); float* d = s.GD + tt * 16 + 8 * hf;
        d[0] = bflo(w.x); d[1] = bfhi(w.x); d[2] = bflo(w.y); d[3] = bfhi(w.y); d[4] = bflo(w.z); d[5] = bfhi(w.z); d[6] = bflo(w.w); d[7] = bfhi(w.w); }
    __syncthreads();
    const float* gw = tab[8] + l * 2048; const float* gbias = tab[9] + l * 128;
#pragma unroll
    for (int i = 0; i < 4; ++i) { const int d = 4 * c8 + i; float z = gbias[h * 32 + d];
#pragma unroll
        for (int r = 0; r < 16; ++r) z += s.GD[t * 16 + r] * gw[r * 128 + h * 32 + d];
        s.G[t * 33 + d] = logsig(z) * (1.0f / 16.0f); }
    __syncthreads();
    if (tid < 32) { float run = 0.f; for (int tt = 0; tt < 64; ++tt) { run += s.G[tt * 33 + tid]; s.G[tt * 33 + tid] = run; } }
    __syncthreads();
}
__device__ __forceinline__ void gla_passA(unsigned char* ws, const float* const* tab, int l, char* lds, int unit, int tid) {
    const GlaLds s = gla_lds(lds);
    const int b = unit >> 5, n = unit & 31, row0 = b * SEQ + n * 64;
    float* DS = (float*)(ws + WS_DS); float* DEC = (float*)(ws + WS_DEC);
    __syncthreads();
    for (int h = 0; h < 4; ++h) {
        gla_load(ws, tab, l, s, row0, h, tid, false);
        { const int t = tid >> 3, c8 = tid & 7;
#pragma unroll
          for (int i = 0; i < 4; ++i) { const int d = 4 * c8 + i; s.KI[t * 33 + d] *= expf(s.G[63 * 33 + d] - s.G[t * 33 + d]); } }
        __syncthreads();
        { const int d = tid >> 4, e0 = 4 * (tid & 15); f32x4 acc = (f32x4){0.f, 0.f, 0.f, 0.f};
          for (int c = 0; c < 64; ++c) acc += s.KI[c * 33 + d] * *(const f32x4*)(s.V + c * 64 + e0);
          const size_t ub = (size_t)((b * 4 + h) * 32 + n);
          *(f32x4*)(DS + ub * 2048 + d * 64 + e0) = acc;
          if ((tid & 15) == 0) DEC[ub * 32 + d] = expf(s.G[63 * 33 + d]); }
        __syncthreads();
    }
}
__device__ __forceinline__ void gla_passC(unsigned char* ws, const float* const* tab, int l, char* lds, int unit, int tid) {
    const GlaLds s = gla_lds(lds);
    const int b = unit >> 5, n = unit & 31, row0 = b * SEQ + n * 64;
    const float* DS = (const float*)(ws + WS_DS); const float* DEC = (const float*)(ws + WS_DEC);
    const bf16* P = (const bf16*)(ws + WS_P); bf16* BRG = (bf16*)(ws + WS_BRG);
    const float* gn = tab[10] + l * 256;
    __syncthreads();
    for (int h = 0; h < 4; ++h) {
        gla_load(ws, tab, l, s, row0, h, tid, true);
        { const int t = tid >> 3, c8 = tid & 7;
#pragma unroll
          for (int i = 0; i < 4; ++i) { const int d = 4 * c8 + i; const float g = s.G[t * 33 + d]; const float eg = expf(g), ieg = expf(-g);
              const float q = s.QF[t * 33 + d] * 0.17677669529663687f, k = s.KI[t * 33 + d];
              s.QF[t * 33 + d] = q * eg; s.QI[t * 33 + d] = q * ieg; s.KI[t * 33 + d] = k * ieg; s.KE[t * 33 + d] = k * eg; } }
        __syncthreads();
        { const int i = tid >> 3, jb = tid & 7;
#pragma unroll
          for (int jj = 0; jj < 8; ++jj) { const int j = jb + 8 * jj; const float* qa = (j <= i) ? s.QF : s.QI; const float* kb = (j <= i) ? s.KI : s.KE; float dot = 0.f;
#pragma unroll
              for (int d = 0; d < 32; ++d) dot += qa[i * 33 + d] * kb[j * 33 + d];
              s.AT[i * 65 + j] = dot; } }
        { const int idx4 = tid * 4, d = idx4 >> 6; f32x4 S = (f32x4){0.f, 0.f, 0.f, 0.f};
          const float* base = DS + (size_t)((b * 4 + h) * 32) * 2048 + idx4; const float* decb = DEC + (size_t)((b * 4 + h) * 32) * 32 + d;
          for (int m = 0; m < n; ++m) { const float dd = decb[m * 32]; const f32x4 v = *(const f32x4*)(base + (size_t)m * 2048); S = S * dd + v; }
          *(f32x4*)(s.SP + idx4) = S; }
        __syncthreads();
        { const int i = tid >> 3, e0 = 8 * (tid & 7); f32x4 a0 = (f32x4){0.f, 0.f, 0.f, 0.f}, a1 = a0;
          for (int j = 0; j < 64; ++j) { const float a = s.AT[i * 65 + j]; a0 += a * *(const f32x4*)(s.V + j * 64 + e0); a1 += a * *(const f32x4*)(s.V + j * 64 + e0 + 4); }
          for (int d = 0; d < 32; ++d) { const float a = s.QF[i * 33 + d]; a0 += a * *(const f32x4*)(s.SP + d * 64 + e0); a1 += a * *(const f32x4*)(s.SP + d * 64 + e0 + 4); }
          float ss = (a0[0] * a0[0] + a0[1] * a0[1]) + (a0[2] * a0[2] + a0[3] * a0[3]) + (a1[0] * a1[0] + a1[1] * a1[1]) + (a1[2] * a1[2] + a1[3] * a1[3]);
          ss += __shfl_xor(ss, 1); ss += __shfl_xor(ss, 2); ss += __shfl_xor(ss, 4);
          const float r = 1.0f / sqrtf(ss * (1.0f / 64.0f) + EPS);
          const v4u gr = *(const v4u*)(P + (size_t)(row0 + i) * LDP + PC_GR + h * 64 + e0);
          const float grv[8] = {bflo(gr.x), bfhi(gr.x), bflo(gr.y), bfhi(gr.y), bflo(gr.z), bfhi(gr.z), bflo(gr.w), bfhi(gr.w)};
          float o[8];
#pragma unroll
          for (int k = 0; k < 8; ++k) { const float v = (k < 4 ? a0[k & 3] : a1[k & 3]) * r * gn[h * 64 + e0 + k]; const float gg = grv[k]; o[k] = v * gg * sigmoidf_(gg); }
          v4u w; w.x = pk2(o[0], o[1]); w.y = pk2(o[2], o[3]); w.z = pk2(o[4], o[5]); w.w = pk2(o[6], o[7]);
          *(v4u*)(BRG + (size_t)(row0 + i) * 256 + h * 64 + e0) = w; }
        __syncthreads();
    }
}

__device__ __forceinline__ void gsync(unsigned char* wsb, unsigned G, int wave_s) {
    unsigned char* wl_ = wsb; asm volatile("" : "+s"(wl_)); unsigned* ctr = (unsigned*)(wl_ + 1024);
    int ln_; asm volatile("v_mbcnt_lo_u32_b32 %0, -1, 0\n\tv_mbcnt_hi_u32_b32 %0, -1, %0" : "=v"(ln_));
    const bool leader = (wave_s == 0) && (ln_ == 0);
    asm volatile("s_waitcnt vmcnt(0)" ::: "memory");
    __syncthreads();
    if (leader) {
        __builtin_amdgcn_fence(__ATOMIC_RELEASE, "agent");
        asm volatile("s_waitcnt vmcnt(0)" ::: "memory");
        const unsigned old = __hip_atomic_fetch_add(ctr, 1u, __ATOMIC_RELAXED, __HIP_MEMORY_SCOPE_AGENT);
        const unsigned want = (old | (G - 1u)) + 1u;
        while (__hip_atomic_load(ctr, __ATOMIC_RELAXED, __HIP_MEMORY_SCOPE_AGENT) < want) __builtin_amdgcn_s_sleep(2);
        __builtin_amdgcn_fence(__ATOMIC_ACQUIRE, "agent");
        asm volatile("s_waitcnt vmcnt(0)" ::: "memory");
    }
    __syncthreads();
}
__global__ void __launch_bounds__(NTHR, 2) fwd_mega(Params p) {
    extern __shared__ __attribute__((aligned(16))) unsigned char lds_raw[];
    char* lds = (char*)lds_raw;
    PG8_LAS unsigned char* ldsg = (PG8_LAS unsigned char*)lds_raw;
    cg::grid_group grid = cg::this_grid();
    constexpr int G = 256; const int bid = blockIdx.x;
    const int wave_s = __builtin_amdgcn_readfirstlane(threadIdx.x >> 6);
    const int NGW = G * NWAVES;
#define TIDS() int tid; { int ln_; asm volatile("v_mbcnt_lo_u32_b32 %0, -1, 0\n\tv_mbcnt_hi_u32_b32 %0, -1, %0" : "=v"(ln_)); tid = wave_s * 64 + ln_; } const int lane = tid & 63, wave = __builtin_amdgcn_readfirstlane(tid >> 6), gw = bid * NWAVES + wave; (void)lane; (void)gw
    if (threadIdx.x < 38) ((const float**)p.ws)[threadIdx.x] = threadIdx.x < 37 ? p.in[threadIdx.x] : (const float*)p.out;
    if (bid == 0 && threadIdx.x >= 64 && threadIdx.x < 128) ((unsigned*)(p.ws + 1024))[threadIdx.x - 64] = 0u;
    grid.sync();
#define PTRS() unsigned char* ws = p.ws; asm volatile("" : "+s"(ws)); const float* const* tab = (const float* const*)ws; (void)tab
#define GSYNC() gsync(p.ws, 256u, wave_s)
#define Wb ((bf16*)(ws + WS_W))
#define P ((bf16*)(ws + WS_P))
#define ACT ((bf16*)(ws + WS_P))
#define H ((bf16*)(ws + WS_H))
#define Y ((float*)(ws + WS_Y))
#define BRG ((bf16*)(ws + WS_BRG))
#define BRS ((bf16*)(ws + WS_BRS))
#define BRF ((bf16*)(ws + WS_BRF))
#define MIXB ((bf16*)(ws + WS_MIXB))
#define Qb ((bf16*)(ws + WS_Q))
#define XO ((bf16*)(ws + WS_XO))
#define KV ((bf16*)(ws + WS_KV))
#define MEMN ((bf16*)(ws + WS_MEMN))
#define X ((float*)tab[37])

#define GEMM(EpiT, epi, Ap, Bp, Mv, Nv, Kv) do { pg8::Gemm g_{(const pg8::bf16_t*)(Ap), (const pg8::bf16_t*)(Bp), (Mv), (Nv), (Kv)}; int bid_ = bid; const int G_ = G; asm volatile("" : "+s"(bid_)); pg8::StaticOrder S_; S_.init((Mv), (Nv), G_, bid_); \
        TIDS(); pg8::gemm_phase<EpiT, pg8::StaticOrder, true, true>(ldsg, g_, S_, epi, tid); __syncthreads(); } while (0)

    { PTRS(); TIDS();
#if EN_CONV
      convert_weights(ws, tab, 0, lds, gw, NGW, wave, lane);
      s5_prep(ws, tab, 0, bid * NTHR + tid, G * NTHR);
#endif
      rowop<false, false, true>(tab[1], nullptr, nullptr, nullptr, 0.f, tab[28], MEMN, MMEM, gw, NGW, lane);
      rowop<false, true, true>(tab[0], X, nullptr, nullptr, 0.f, tab[2], H, MTOK, gw, NGW, lane); }
    GSYNC();

    for (int l = 0; l < DEPTH; ++l) {
        { PTRS(); pg8::EpiSwiGLU e{ACT, DFF}; GEMM(pg8::EpiSwiGLU, e, H, Wb + WO_GU1, MTOK, 5632, 1024); }
        GSYNC();
        { PTRS(); pg8::EpiF32 e{Y, DM}; GEMM(pg8::EpiF32, e, ACT, Wb + WO_DOWN1, MTOK, 1024, DFF); }
        GSYNC();
        { PTRS(); TIDS(); rowop<true, true, true>(X, X, Y, tab[5] + l * DM, 0.5f, tab[6] + l * DM, H, MTOK, gw, NGW, lane); }
        GSYNC();
        { PTRS(); pg8::EpiBf16 e{P, LDP}; GEMM(pg8::EpiBf16, e, H, Wb + WO_IN, MTOK, LDP, 1024); }
        { PTRS(); pg8::EpiBf16 e{KV, 2048}; GEMM(pg8::EpiBf16, e, MEMN, Wb + WO_KV, MMEM, 2048, 1024); }
        GSYNC();
#if EN_S5A
        { PTRS(); TIDS(); s5_passA(ws, tab, lds, gw, NGW, wave, lane); }
#endif
#if EN_GLAA
        { PTRS(); TIDS(); for (int u = bid; u < 256; u += G) gla_passA(ws, tab, l, lds, u, tid); }
#endif
#if EN_FOX
        { PTRS(); TIDS();
          for (int pr = bid; pr < 512; pr += G) {
            const int bh = pr >> 3, pp = pr & 7, b = bh >> 3, h = bh & 7;
            float* Fc = (float*)(lds + 24576); float* red = (float*)(lds + 24576 + 8192);
            __syncthreads();
            fox_cumsum(P, b, h, tab[23][l * 8 + h], Fc, red, tid);
            for (int hf = 0; hf < 2; ++hf) { const int qb = hf ? 15 - pp : pp;
                const size_t rq = (size_t)(b * SEQ + qb * 128);
                attn_unit<64, true>(lds, P + rq * LDP + PC_FQ + h * 64, LDP, P + (size_t)(b * SEQ) * LDP + PC_FK + h * 64, LDP, P + (size_t)(b * SEQ) * LDP + PC_FV + h * 64, LDP,
                                    BRF + rq * 512 + h * 64, 512, qb * 128, 2 * qb + 2, Fc, 0.125f, tid); }
          } }
#endif
        GSYNC();
#if EN_S5C
        { PTRS(); TIDS(); for (int u = bid; u < 256; u += G) s5_passC(ws, tab, l, lds, u, tid); }
#endif
#if EN_GLAC
        { PTRS(); TIDS(); for (int u = bid; u < 256; u += G) gla_passC(ws, tab, l, lds, u, tid); }
#endif
        GSYNC();
        { PTRS(); pg8::EpiMerge<0> e{Y, MIXB, P + PC_GATE, LDP}; GEMM(pg8::EpiMerge<0>, e, BRG, Wb + WO_GLAUP, MTOK, 1024, 256); }
        { PTRS(); pg8::EpiMerge<1> e{Y, MIXB, P + PC_GATE + 1024, LDP}; GEMM(pg8::EpiMerge<1>, e, BRS, Wb + WO_S5UP, MTOK, 1024, 256); }
        { PTRS(); pg8::EpiMerge<2> e{Y, MIXB, P + PC_GATE + 2048, LDP}; GEMM(pg8::EpiMerge<2>, e, BRF, Wb + WO_FOXUP, MTOK, 1024, 512); }
        GSYNC();
        { PTRS(); pg8::EpiF32 e{Y, DM}; GEMM(pg8::EpiF32, e, MIXB, Wb + WO_MIXOUT, MTOK, 1024, 1024); }
        GSYNC();
        { PTRS(); TIDS(); rowop<true, true, true>(X, X, Y, tab[26] + l * DM, 1.0f, tab[27] + l * DM, H, MTOK, gw, NGW, lane); }
        GSYNC();
        { PTRS(); pg8::EpiBf16 e{Qb, DM}; GEMM(pg8::EpiBf16, e, H, Wb + WO_Q, MTOK, 1024, 1024); }
        GSYNC();
#if EN_XA
        { PTRS(); TIDS();
          for (int u = bid; u < 512; u += G) { const int qb = u & 15, hd = (u >> 4) & 3, b = u >> 6;
            const size_t rq = (size_t)(b * SEQ + qb * 128);
            attn_unit<256, false>(lds, Qb + rq * DM + hd * 256, DM, KV + (size_t)(b * NMEM) * 2048 + hd * 256, 2048, KV + (size_t)(b * NMEM) * 2048 + 1024 + hd * 256, 2048,
                                  XO + rq * DM + hd * 256, DM, 0, 4, nullptr, 0.0625f, tid); } }
#endif
        GSYNC();
        { PTRS(); pg8::EpiF32 e{Y, DM}; GEMM(pg8::EpiF32, e, XO, Wb + WO_O, MTOK, 1024, 1024); }
        GSYNC();
        { PTRS(); TIDS(); rowop<true, true, true>(X, X, Y, tab[32] + l * DM, 1.0f, tab[33] + l * DM, H, MTOK, gw, NGW, lane); }
        GSYNC();
        { PTRS(); pg8::EpiSwiGLU e{ACT, DFF}; GEMM(pg8::EpiSwiGLU, e, H, Wb + WO_GU2, MTOK, 5632, 1024); }
        GSYNC();
        { PTRS(); pg8::EpiF32 e{Y, DM}; GEMM(pg8::EpiF32, e, ACT, Wb + WO_DOWN2, MTOK, 1024, DFF); }
        GSYNC();
        if (l + 1 < DEPTH) {
            { PTRS(); TIDS(); rowop<true, true, true>(X, X, Y, tab[36] + l * DM, 0.5f, tab[2] + (l + 1) * DM, H, MTOK, gw, NGW, lane); }
            __syncthreads();
            { PTRS(); TIDS();
#if EN_CONV
              convert_weights(ws, tab, l + 1, lds, gw, NGW, wave, lane);
              s5_prep(ws, tab, l + 1, bid * NTHR + tid, G * NTHR);
#endif
              rowop<false, false, true>(tab[1], nullptr, nullptr, nullptr, 0.f, tab[28] + (l + 1) * DM, MEMN, MMEM, gw, NGW, lane); }
            GSYNC();
        } else {
            { PTRS(); TIDS(); rowop<true, true, false>(X, X, Y, tab[36] + l * DM, 0.5f, nullptr, nullptr, MTOK, gw, NGW, lane); }
        }
    }
}

extern "C" void kernel_launch(void* const* d_in, const int* in_sizes, int n_in, void* d_out, int out_size, void* d_ws, size_t ws_size, hipStream_t stream) {
    static int grid = 0;
    if (grid == 0) {
        if (n_in != 37 || out_size != MTOK * DM || ws_size < WS_END) { fprintf(stderr, "kernel_launch: unexpected shapes (n_in %d out %d ws %zu need %zu)\n", n_in, out_size, ws_size, (size_t)WS_END); grid = -1; return; }
        int dev = 0, cus = 0, per_cu = 0;
        hipGetDevice(&dev); hipDeviceGetAttribute(&cus, hipDeviceAttributeMultiprocessorCount, dev);
        if (hipFuncSetAttribute((const void*)fwd_mega, hipFuncAttributeMaxDynamicSharedMemorySize, LDS_BYTES) != hipSuccess) { fprintf(stderr, "kernel_launch: hipFuncSetAttribute failed\n"); grid = -1; return; }
        hipOccupancyMaxActiveBlocksPerMultiprocessor(&per_cu, (const void*)fwd_mega, NTHR, LDS_BYTES);
        (void)hipGetLastError();
        if (per_cu < 1) { fprintf(stderr, "kernel_launch: occupancy query says %d blocks/CU\n", per_cu); }
        if (cus < 256) { fprintf(stderr, "kernel_launch: needs 256 CUs, device has %d\n", cus); grid = -1; return; }
        grid = 256;
    }
    if (grid < 0) return;
    Params p{};
    for (int i = 0; i < 37; ++i) p.in[i] = (const float*)d_in[i];
    p.out = (float*)d_out; p.ws = (unsigned char*)d_ws;
    void* args[] = {&p};
    hipError_t e = hipLaunchCooperativeKernel((const void*)fwd_mega, dim3(grid), dim3(NTHR), args, LDS_BYTES, stream);
    if (e != hipSuccess) fprintf(stderr, "cooperative launch failed: %s (grid %d)\n", hipGetErrorString(e), grid);
}
```

```cpp
#include <hip/hip_runtime.h>
#include <hip/hip_cooperative_groups.h>
#include <cstdio>
#include <cstdint>
namespace cg = cooperative_groups;
namespace pg8 {
#define PG8_LAS __attribute__((address_space(3)))
typedef unsigned short bf16_t;
typedef short bf16x8 __attribute__((ext_vector_type(8)));
typedef float f32x4 __attribute__((ext_vector_type(4)));
typedef unsigned u32x4 __attribute__((ext_vector_type(4)));
constexpr int BM = 256, BK = 64, HALF = 128, HTB = HALF * BK * 2  , STAGE_BYTES = 8 * HTB, NXCD = 8, WGM = 8;

__host__ __device__ __forceinline__ int lds_byte(int r, int c) { const int st = (r >> 4) * 2 + (c >> 5), rr = r & 15, cc = c & 31, ob = rr * 64 + cc * 2; return st * 1024 + (ob ^ (((ob >> 9) & 1) << 5)); }
__host__ __device__ __forceinline__ void stage_rc(int b, int& R, int& C) { const int st = b / 1024, sb = b % 1024, swz = sb ^ (((sb >> 9) & 1) << 5); R = (st >> 1) * 16 + swz / 64; C = (st & 1) * 32 + (swz % 64) / 2; }
__host__ __device__ __forceinline__ int perm32(int rho) { const int n = rho >> 4, i = rho & 15; return 8 * (i >> 2) + 4 * n + (i & 3); }

struct Unit { int pm, pn; };
struct Gemm { const bf16_t* A; const bf16_t* Bt; int M, N, K; };

struct StaticOrder {
    int nM, nN, nwg, G, c;
    __host__ __device__ void init(int M, int N, int G_, int c_) { nM = M / BM; nN = N / BM; nwg = nM * nN; G = G_; c = c_; }
    __host__ __device__ bool next(int i, Unit& u) const {
        const long L = (long)i * G + c; if (L >= nwg) return false;
        int wgid = (int)L; { const int q = nwg / NXCD, r = nwg % NXCD, xcd = wgid % NXCD, off = wgid / NXCD; wgid = (xcd < r ? xcd * (q + 1) : r * (q + 1) + (xcd - r) * q) + off; }
        const int nig = WGM * nN, gid = wgid / nig, fm = gid * WGM, gsz = (nM - fm) < WGM ? (nM - fm) : WGM;
        u.pm = fm + ((wgid % nig) % gsz); u.pn = (wgid % nig) / gsz; return true;
    }
    __device__ __forceinline__ void a_ready(const Unit&) const {}
    __device__ __forceinline__ void done(const Unit&) const {}
};

__device__ __forceinline__ unsigned cvt_pk_bf16(float lo, float hi) { unsigned r; asm volatile("v_cvt_pk_bf16_f32 %0, %1, %2" : "=v"(r) : "v"(lo), "v"(hi)); return r; }
typedef float f32x2 __attribute__((ext_vector_type(2)));
typedef unsigned u32x2 __attribute__((ext_vector_type(2)));
__device__ __forceinline__ float fast_sigmoid(float x) { return __builtin_amdgcn_rcpf(1.0f + __expf(-x)); }
__device__ __forceinline__ float bf_lo(unsigned w) { return __uint_as_float(w << 16); }
__device__ __forceinline__ float bf_hi(unsigned w) { return __uint_as_float(w & 0xffff0000u); }
struct EpiBf16 {
    static constexpr bool PERM = true, AFTER_DRAIN = false;
    bf16_t* O; int ldc;
    __device__ __forceinline__ void operator()(const f32x4 (&acc)[2][2][4][2], const Unit& u, int wr, int wc, int fr, int fq) const {
        const int row0 = u.pm * BM + wr * 64 + fr; const int col0 = u.pn * BM + wc * 32 + 8 * fq;
#pragma unroll
        for (int ai = 0; ai < 2; ++ai)
#pragma unroll
            for (int m = 0; m < 4; ++m) { bf16_t* rowp = O + (size_t)(row0 + ai * HALF + m * 16) * ldc + col0;
#pragma unroll
                for (int bj = 0; bj < 2; ++bj) { const f32x4 v0 = acc[ai][bj][m][0], v1 = acc[ai][bj][m][1];
                    u32x4 w; w.x = cvt_pk_bf16(v0[0], v0[1]); w.y = cvt_pk_bf16(v0[2], v0[3]); w.z = cvt_pk_bf16(v1[0], v1[1]); w.w = cvt_pk_bf16(v1[2], v1[3]);
                    *(u32x4*)(rowp + bj * HALF) = w; } }
    }
};
struct EpiSwiGLU {
    static constexpr bool PERM = true, AFTER_DRAIN = false;
    bf16_t* O; int ldc;
    __device__ __forceinline__ void operator()(const f32x4 (&acc)[2][2][4][2], const Unit& u, int wr, int wc, int fr, int fq) const {
        const int row0 = u.pm * BM + wr * 64 + fr; const int col0 = u.pn * HALF + wc * 32 + 8 * fq;
#pragma unroll
        for (int ai = 0; ai < 2; ++ai)
#pragma unroll
            for (int m = 0; m < 4; ++m) { bf16_t* rowp = O + (size_t)(row0 + ai * HALF + m * 16) * ldc + col0;
                float r[8];
#pragma unroll
                for (int n = 0; n < 2; ++n)
#pragma unroll
                    for (int j = 0; j < 4; ++j) { const float g = acc[ai][0][m][n][j], up = acc[ai][1][m][n][j]; r[n * 4 + j] = g * fast_sigmoid(g) * up; }
                u32x4 w; w.x = cvt_pk_bf16(r[0], r[1]); w.y = cvt_pk_bf16(r[2], r[3]); w.z = cvt_pk_bf16(r[4], r[5]); w.w = cvt_pk_bf16(r[6], r[7]);
                *(u32x4*)rowp = w; }
    }
};
struct EpiF32 {
    static constexpr bool PERM = false, AFTER_DRAIN = false;
    float* O; int ldc;
    __device__ __forceinline__ void operator()(const f32x4 (&acc)[2][2][4][2], const Unit& u, int wr, int wc, int fr, int fq) const {
        const int row0 = u.pm * BM + wr * 64 + fr; const int col0 = u.pn * BM + wc * 32 + 4 * fq;
#pragma unroll
        for (int ai = 0; ai < 2; ++ai)
#pragma unroll
            for (int m = 0; m < 4; ++m) { float* rowp = O + (size_t)(row0 + ai * HALF + m * 16) * ldc + col0;
#pragma unroll
                for (int bj = 0; bj < 2; ++bj)
#pragma unroll
                    for (int n = 0; n < 2; ++n) *(f32x4*)(rowp + bj * HALF + n * 16) = acc[ai][bj][m][n]; }
    }
};
template <int MODE> struct EpiMerge {
    static constexpr bool PERM = false, AFTER_DRAIN = false;
    float* F; bf16_t* B; const bf16_t* G; int ldg;
    __device__ __forceinline__ void operator()(const f32x4 (&acc)[2][2][4][2], const Unit& u, int wr, int wc, int fr, int fq) const {
        const int row0 = u.pm * BM + wr * 64 + fr; const int col0 = u.pn * BM + wc * 32 + 4 * fq;
#pragma unroll
        for (int ai = 0; ai < 2; ++ai)
#pragma unroll
            for (int m = 0; m < 4; ++m) { const size_t row = (size_t)(row0 + ai * HALF + m * 16);
#pragma unroll
                for (int bj = 0; bj < 2; ++bj)
#pragma unroll
                    for (int n = 0; n < 2; ++n) { const int c = col0 + bj * HALF + n * 16;
                        const u32x2 gw = *(const u32x2*)(G + row * ldg + c);
                        f32x4 s; s[0] = fast_sigmoid(bf_lo(gw.x)); s[1] = fast_sigmoid(bf_hi(gw.x)); s[2] = fast_sigmoid(bf_lo(gw.y)); s[3] = fast_sigmoid(bf_hi(gw.y));
                        f32x4 v = s * acc[ai][bj][m][n];
                        float* fp = F + row * 1024 + c;
                        if (MODE >= 1) v += *(const f32x4*)fp;
                        if (MODE <= 1) *(f32x4*)fp = v;
                        else { u32x2 w; w.x = cvt_pk_bf16(v[0], v[1]); w.y = cvt_pk_bf16(v[2], v[3]); *(u32x2*)(B + row * 1024 + c) = w; } } }
    }
};
template <class Epi, class Sched, bool ALIGN_EPI = false, bool SP2 = false>
__device__ __forceinline__ void gemm_phase(PG8_LAS unsigned char* lds, const Gemm g, const Sched& S, const Epi& E, const int tid) {
    const int wid = __builtin_amdgcn_readfirstlane(tid >> 6), lane = tid & 63, wr = wid >> 2, wc = wid & 3, fr = lane & 15, fq = lane >> 4;
    const int K = g.K, nt = K / BK;
    unsigned voffA[2], voffB[2];
#pragma unroll
    for (int i = 0; i < 2; ++i) { int R, C; stage_rc(tid * 16 + i * 8192, R, C); const int Rb = Epi::PERM ? ((R & ~31) + perm32(R & 31)) : R;
        voffA[i] = (unsigned)(R * K + C) * 2u; voffB[i] = (unsigned)(Rb * K + C) * 2u; }
    const size_t kstep = (size_t)(BK * 2);
    const size_t hstep = (size_t)HALF * K * 2;
    const size_t tstep = 2 * hstep;
    const unsigned ldsw = (unsigned)wid * 1024u;
    const int aoff = lds_byte(wr * 64 + fr, fq * 8), boff = lds_byte(wc * 32 + fr, fq * 8);
#define PG8_SA(b, h) (((b) * 2 + (h)) * HTB)
#define PG8_SB(b, h) ((4 + (b) * 2 + (h)) * HTB)
#define PG8_STAGE(bufoff, gbase, voff) do { _Pragma("unroll") for (int _i = 0; _i < 2; ++_i) \
        __builtin_amdgcn_global_load_lds((const unsigned*)((const char*)(gbase) + (voff)[_i]), (PG8_LAS unsigned*)(lds + (bufoff) + ldsw + _i * 8192), 16, 0, 0); } while (0)
#define PG8_LDA(dst, b, h) do { _Pragma("unroll") for (int m = 0; m < 4; ++m) _Pragma("unroll") for (int k = 0; k < 2; ++k) dst[m][k] = *(const PG8_LAS bf16x8*)(lds + PG8_SA(b, h) + aoff + m * 2048 + k * 1024); } while (0)
#define PG8_LDB(dst, b, h) do { _Pragma("unroll") for (int n = 0; n < 2; ++n) _Pragma("unroll") for (int k = 0; k < 2; ++k) dst[n][k] = *(const PG8_LAS bf16x8*)(lds + PG8_SB(b, h) + boff + n * 2048 + k * 1024); } while (0)
#define PG8_MMA(ai, bj, At, Bt) do { __builtin_amdgcn_s_setprio(1); _Pragma("unroll") for (int m = 0; m < 4; ++m) _Pragma("unroll") for (int n = 0; n < 2; ++n) _Pragma("unroll") for (int k = 0; k < 2; ++k) \
        acc[ai][bj][m][n] = __builtin_amdgcn_mfma_f32_16x16x32_bf16(Bt[n][k], At[m][k], acc[ai][bj][m][n], 0, 0, 0); __builtin_amdgcn_s_setprio(0); } while (0)
#define PG8_WAIT_V(n) asm volatile("s_waitcnt vmcnt(" #n ")" ::: "memory")
#define PG8_WAIT_L(n) asm volatile("s_waitcnt lgkmcnt(" #n ")" ::: "memory")
#define PG8_BAR __builtin_amdgcn_s_barrier()
#define PG8_SCHED __builtin_amdgcn_sched_barrier(0)
    Unit cur, nxt; int ui = 0;
    if (!S.next(0, cur)) return;
    f32x4 acc[2][2][4][2];
#pragma unroll
    for (int a = 0; a < 2; ++a)
#pragma unroll
        for (int b = 0; b < 2; ++b)
#pragma unroll
            for (int m = 0; m < 4; ++m)
#pragma unroll
                for (int n = 0; n < 2; ++n) acc[a][b][m][n] = (f32x4){0.f, 0.f, 0.f, 0.f};
    bf16x8 At[4][2], B0[2][2], B1[2][2];
    const char* cA = (const char*)g.A + (size_t)cur.pm * tstep; const char* cB = (const char*)g.Bt + (size_t)cur.pn * tstep;
    S.a_ready(cur);
    if constexpr (SP2) {
        PG8_STAGE(PG8_SB(0, 0), cB, voffB); PG8_STAGE(PG8_SB(0, 1), cB + hstep, voffB); PG8_STAGE(PG8_SA(0, 0), cA, voffA); PG8_STAGE(PG8_SA(0, 1), cA + hstep, voffA);
        if (wr == 1) PG8_BAR;
        PG8_WAIT_V(2); PG8_BAR;
        PG8_STAGE(PG8_SB(1, 0), cB + kstep, voffB); PG8_STAGE(PG8_SA(1, 0), cA + kstep, voffA); PG8_STAGE(PG8_SB(1, 1), cB + hstep + kstep, voffB);
        PG8_WAIT_V(6); PG8_BAR;
    } else {
        PG8_STAGE(PG8_SB(0, 0), cB, voffB); PG8_STAGE(PG8_SA(0, 0), cA, voffA); PG8_STAGE(PG8_SB(0, 1), cB + hstep, voffB); PG8_STAGE(PG8_SA(0, 1), cA + hstep, voffA);
        if (wr == 1) PG8_BAR;
        PG8_WAIT_V(4); PG8_BAR;
        PG8_STAGE(PG8_SB(1, 0), cB + kstep, voffB); PG8_STAGE(PG8_SA(1, 0), cA + kstep, voffA); PG8_STAGE(PG8_SB(1, 1), cB + hstep + kstep, voffB);
        PG8_WAIT_V(6); PG8_BAR;
    }
    for (;;) {
        const bool has_next = S.next(ui + 1, nxt);
        const char* nA = has_next ? (const char*)g.A + (size_t)nxt.pm * tstep : cA; const char* nB = has_next ? (const char*)g.Bt + (size_t)nxt.pn * tstep : cB;
        for (int t = 0; t < nt; t += 2) {
            const bool last = (t == nt - 2);
            const char* a1 = cA + (size_t)(t + 1) * kstep;
            const char* a2 = last ? nA : cA + (size_t)(t + 2) * kstep; const char* b2 = last ? nB : cB + (size_t)(t + 2) * kstep;
            const char* a3 = a2 + kstep; const char* b3 = b2 + kstep;
            if (last && has_next) S.a_ready(nxt);
            if constexpr (SP2) {
            PG8_LDB(B0, 0, 0); PG8_LDB(B1, 0, 1); PG8_SCHED; PG8_LDA(At, 0, 0); PG8_STAGE(PG8_SA(1, 1), a1 + hstep, voffA);
            PG8_WAIT_V(8); PG8_WAIT_L(0); PG8_BAR; PG8_MMA(0, 0, At, B0); PG8_MMA(0, 1, At, B1); PG8_BAR; PG8_SCHED;
            PG8_LDA(At, 0, 1); PG8_STAGE(PG8_SB(0, 0), b2, voffB); PG8_STAGE(PG8_SB(0, 1), b2 + hstep, voffB); PG8_STAGE(PG8_SA(0, 0), a2, voffA);
            PG8_WAIT_V(8); PG8_WAIT_L(0); PG8_BAR; PG8_MMA(1, 0, At, B0); PG8_MMA(1, 1, At, B1); PG8_BAR; PG8_SCHED;
            PG8_LDB(B0, 1, 0); PG8_LDB(B1, 1, 1); PG8_SCHED; PG8_LDA(At, 1, 0); PG8_STAGE(PG8_SA(0, 1), a2 + hstep, voffA);
            PG8_WAIT_V(8); PG8_WAIT_L(0); PG8_BAR; PG8_MMA(0, 0, At, B0); PG8_MMA(0, 1, At, B1); PG8_BAR; PG8_SCHED;
            PG8_LDA(At, 1, 1); PG8_STAGE(PG8_SB(1, 0), b3, voffB); PG8_STAGE(PG8_SB(1, 1), b3 + hstep, voffB); PG8_STAGE(PG8_SA(1, 0), a3, voffA);
            PG8_WAIT_V(8); PG8_WAIT_L(0); PG8_BAR; PG8_MMA(1, 0, At, B0); PG8_MMA(1, 1, At, B1); PG8_BAR; PG8_SCHED;
            } else {
            PG8_LDB(B0, 0, 0); PG8_SCHED; PG8_LDA(At, 0, 0); PG8_STAGE(PG8_SA(1, 1), a1 + hstep, voffA);
            PG8_WAIT_L(8); PG8_BAR; PG8_WAIT_L(0); PG8_MMA(0, 0, At, B0); PG8_BAR; PG8_SCHED;
            PG8_LDB(B1, 0, 1); PG8_STAGE(PG8_SB(0, 0), b2, voffB);
            PG8_BAR; PG8_WAIT_L(0); PG8_MMA(0, 1, At, B1); PG8_BAR;
            PG8_LDA(At, 0, 1); PG8_STAGE(PG8_SA(0, 0), a2, voffA);
            PG8_BAR; PG8_WAIT_L(0); PG8_MMA(1, 0, At, B0); PG8_BAR; PG8_SCHED;
            PG8_STAGE(PG8_SB(0, 1), b2 + hstep, voffB);
            PG8_WAIT_V(6); PG8_BAR; PG8_MMA(1, 1, At, B1); PG8_BAR;
            PG8_LDB(B0, 1, 0); PG8_SCHED; PG8_LDA(At, 1, 0); PG8_STAGE(PG8_SA(0, 1), a2 + hstep, voffA);
            PG8_WAIT_L(8); PG8_BAR; PG8_WAIT_L(0); PG8_MMA(0, 0, At, B0); PG8_BAR; PG8_SCHED;
            PG8_LDB(B1, 1, 1); PG8_STAGE(PG8_SB(1, 0), b3, voffB);
            PG8_BAR; PG8_WAIT_L(0); PG8_MMA(0, 1, At, B1); PG8_BAR;
            PG8_LDA(At, 1, 1); PG8_STAGE(PG8_SA(1, 0), a3, voffA);
            PG8_BAR; PG8_WAIT_L(0); PG8_MMA(1, 0, At, B0); PG8_BAR; PG8_SCHED;
            PG8_STAGE(PG8_SB(1, 1), b3 + hstep, voffB);
            PG8_WAIT_V(6); PG8_BAR; PG8_MMA(1, 1, At, B1); PG8_BAR;
            }
        }
        if constexpr (ALIGN_EPI) { if (wr == 0) PG8_BAR; }
        if constexpr (!Epi::AFTER_DRAIN) { int l2_; asm volatile("v_mbcnt_lo_u32_b32 %0, -1, 0\n\tv_mbcnt_hi_u32_b32 %0, -1, %0" : "=v"(l2_)); E(acc, cur, wr, wc, l2_ & 15, l2_ >> 4); S.done(cur); }
        if (!has_next) break;
#pragma unroll
        for (int a = 0; a < 2; ++a)
#pragma unroll
            for (int b = 0; b < 2; ++b)
#pragma unroll
                for (int m = 0; m < 4; ++m)
#pragma unroll
                    for (int n = 0; n < 2; ++n) acc[a][b][m][n] = (f32x4){0.f, 0.f, 0.f, 0.f};
        cur = nxt; cA = nA; cB = nB; ++ui;
        if constexpr (ALIGN_EPI) { if (wr == 1) PG8_BAR; }
    }
    PG8_WAIT_V(0);
    if constexpr (!ALIGN_EPI) { if (wr == 0) PG8_BAR; }
    PG8_BAR;
    if constexpr (Epi::AFTER_DRAIN) { E.fused(acc, cur, wr, wc, fr, fq, lds, wid, lane); S.done(cur); }
#undef PG8_SA
#undef PG8_SB
#undef PG8_STAGE
#undef PG8_LDA
#undef PG8_LDB
#undef PG8_MMA
#undef PG8_WAIT_V
#undef PG8_WAIT_L
#undef PG8_BAR
#undef PG8_SCHED
}
}
#ifndef REP_S5A
#define REP_S5A 1
#endif
#ifndef REP_GLAA
#define REP_GLAA 1
#endif
#ifndef REP_FOX
#define REP_FOX 1
#endif
#ifndef REP_S5C
#define REP_S5C 1
#endif
#ifndef REP_GLAC
#define REP_GLAC 1
#endif
#ifndef REP_MIXA
#define REP_MIXA 1
#endif
#ifndef REP_MIXC
#define REP_MIXC 1
#endif
#ifndef REP_XA
#define REP_XA 1
#endif
#ifndef REP_CONV
#define REP_CONV 1
#endif
#ifndef REP_ROW
#define REP_ROW 0
#endif
#ifndef EN_S5A
#define EN_S5A 1
#endif
#ifndef EN_GLAA
#define EN_GLAA 1
#endif
#ifndef EN_FOX
#define EN_FOX 1
#endif
#ifndef EN_S5C
#define EN_S5C 1
#endif
#ifndef EN_GLAC
#define EN_GLAC 1
#endif
#ifndef EN_XA
#define EN_XA 1
#endif
#ifndef EN_CONV
#define EN_CONV 1
#endif
typedef unsigned short bf16;
typedef unsigned v4u __attribute__((ext_vector_type(4)));
typedef unsigned v2u __attribute__((ext_vector_type(2)));
typedef float f32x4 __attribute__((ext_vector_type(4)));
typedef short bf16x8 __attribute__((ext_vector_type(8)));
#define LAS __attribute__((address_space(3)))

constexpr int MTOK = 16384, DM = 1024, SEQ = 2048, NB = 8, DFF = 2816, NMEM = 256, MMEM = NB * NMEM, DEPTH = 4;
constexpr int LDP = 5888, D_IN = 5656;
constexpr int PC_GQ = 0, PC_GK = 128, PC_GV = 256, PC_GR = 512, PC_SU = 768, PC_FQ = 1024, PC_FK = 1536, PC_FV = 2048, PC_GD = 2560, PC_FF = 2576, PC_GATE = 2816;
constexpr float EPS = 1e-6f;
constexpr int NTHR = 512, NWAVES = 8;
constexpr int LDS_BYTES = 147456;

constexpr size_t WO_GU1 = 0, WO_DOWN1 = WO_GU1 + (size_t)5632 * 1024, WO_IN = WO_DOWN1 + (size_t)1024 * 2816, WO_GLAUP = WO_IN + (size_t)5888 * 1024, WO_S5UP = WO_GLAUP + 1024 * 256,
                 WO_FOXUP = WO_S5UP + 1024 * 256, WO_GLU = WO_FOXUP + 1024 * 512, WO_MIXOUT = WO_GLU + 256 * 256, WO_Q = WO_MIXOUT + 1024 * 1024, WO_KV = WO_Q + 1024 * 1024,
                 WO_O = WO_KV + 2048 * 1024, WO_GU2 = WO_O + 1024 * 1024, WO_DOWN2 = WO_GU2 + (size_t)5632 * 1024, WO_END = WO_DOWN2 + (size_t)1024 * 2816;
constexpr size_t MiB = (size_t)1 << 20;
constexpr size_t WS_W = 1 * MiB, WS_P = 64 * MiB, WS_H = 248 * MiB, WS_Y = 280 * MiB, WS_BRG = 344 * MiB, WS_BRS = 352 * MiB, WS_BRF = 360 * MiB, WS_MIXB = 376 * MiB,
                 WS_Q = 344 * MiB, WS_XO = 376 * MiB, WS_KV = 408 * MiB, WS_MEMN = 416 * MiB, WS_DS = 420 * MiB, WS_DEC = 428 * MiB, WS_S5L = 429 * MiB, WS_S5P = 431 * MiB, WS_END = 432 * MiB;
static_assert(WS_W + WO_END * 2 <= WS_P, "weights fit");
static_assert(WS_P + (size_t)MTOK * LDP * 2 <= WS_H, "P fits");
constexpr size_t S5P_ABAR = 0, S5P_A64 = 8192, S5P_BBAR = 16384, S5P_CMAT = 16384 + 131072;

struct Params { const float* in[37]; float* out; unsigned char* ws; };

__device__ __forceinline__ unsigned f2bf(float f) { unsigned u = __builtin_bit_cast(unsigned, f); return (u + 0x7fffu + ((u >> 16) & 1u)) >> 16; }
__device__ __forceinline__ unsigned pk2(float lo, float hi) { return f2bf(lo) | (f2bf(hi) << 16); }
__device__ __forceinline__ float bf2f(unsigned h) { return __uint_as_float(h << 16); }
__device__ __forceinline__ float bflo(unsigned w) { return __uint_as_float(w << 16); }
__device__ __forceinline__ float bfhi(unsigned w) { return __uint_as_float(w & 0xffff0000u); }
#define LDS_WAIT() asm volatile("s_waitcnt lgkmcnt(0)" ::: "memory")
__device__ __forceinline__ float wave_sum(float v) {
#pragma unroll
    for (int o = 1; o < 64; o <<= 1) v += __shfl_xor(v, o);
    return v;
}
__device__ __forceinline__ float logsig(float z) { return fminf(z, 0.f) - logf(1.0f + expf(-fabsf(z))); }
__device__ __forceinline__ float sigmoidf_(float x) { return 1.0f / (1.0f + __expf(-x)); }
__device__ __forceinline__ float gelu_tanh(float x) { const float z = 0.7978845608028654f * (x + 0.044715f * x * x * x); const float t = 1.0f - 2.0f / (__expf(2.0f * z) + 1.0f); return 0.5f * x * (1.0f + t); }

__device__ __forceinline__ int srccol(int kind, int j) {
    if (kind == 0) return j;
    if (kind == 1) { const int pn = j >> 8, r = j & 255; return r < 128 ? 128 * pn + r : 2816 + 128 * pn + (r - 128); }
    if (j < 768) return j;
    if (j < 1024) return 784 + (j - 768);
    if (j < 2560) return 1040 + (j - 1024);
    if (j < 2576) return 768 + (j - 2560);
    if (j < 2584) return 2576 + (j - 2576);
    if (j < 2816) return -1;
    return 2584 + (j - 2816);
}
__device__ __forceinline__ void transpose_item(const float* W, int K, int Nsrc, int Ndst, int kind, bf16* WT, float* scr, int item, int lane) {
    const int nblk = Ndst / 32, kb = item / nblk, nb = item % nblk, k0 = 64 * kb, n0 = 32 * nb;
    const int sc = srccol(kind, n0 + (lane & 31));
#pragma unroll 8
    for (int i = 0; i < 32; ++i) { const int kk = 2 * i + (lane >> 5); scr[kk * 33 + (lane & 31)] = sc >= 0 ? W[(size_t)(k0 + kk) * Nsrc + sc] : 0.f; }
    LDS_WAIT();
    const int c = lane & 7;
#pragma unroll
    for (int j = 0; j < 4; ++j) { const int n = (lane >> 3) + 8 * j; const float* s = scr + (8 * c) * 33 + n;
        v4u o; o.x = pk2(s[0 * 33], s[1 * 33]); o.y = pk2(s[2 * 33], s[3 * 33]); o.z = pk2(s[4 * 33], s[5 * 33]); o.w = pk2(s[6 * 33], s[7 * 33]);
        *(v4u*)(WT + (size_t)(n0 + n) * K + k0 + 8 * c) = o; }
    LDS_WAIT();
}
struct ConvJob { int in_idx; int K, Nsrc, Ndst, kind; size_t wo; };
__device__ __forceinline__ void convert_weights(unsigned char* ws, const float* const* tab, int l, char* lds, int gw, int NGW, int wave, int lane) {
    float* scr = (float*)(lds + wave * 8448);
    bf16* Wb = (bf16*)(ws + WS_W);
    const int  jin[13]  = {3, 4, 7, 11, 22, 24, 20, 25, 29, 30, 31, 34, 35};
    const int  jK[13]   = {1024, 2816, 1024, 256, 256, 512, 256, 1024, 1024, 1024, 1024, 1024, 2816};
    const int  jNs[13]  = {5632, 1024, D_IN, 1024, 1024, 1024, 256, 1024, 1024, 2048, 1024, 5632, 1024};
    const int  jNd[13]  = {5632, 1024, 5888, 1024, 1024, 1024, 256, 1024, 1024, 2048, 1024, 5632, 1024};
    const int  jkind[13]= {1, 0, 2, 0, 0, 0, 0, 0, 0, 0, 0, 1, 0};
    const size_t jwo[13]= {WO_GU1, WO_DOWN1, WO_IN, WO_GLAUP, WO_S5UP, WO_FOXUP, WO_GLU, WO_MIXOUT, WO_Q, WO_KV, WO_O, WO_GU2, WO_DOWN2};
    int base = 0;
#pragma unroll
    for (int j = 0; j < 13; ++j) {
        const int K = jK[j], Ns = jNs[j], Nd = jNd[j];
        const int nitems = (K / 64) * (Nd / 32);
        const float* W = tab[jin[j]] + (size_t)l * K * Ns;
        int first = (gw - (base % NGW) + NGW) % NGW;
        for (int it = first; it < nitems; it += NGW) transpose_item(W, K, Ns, Nd, jkind[j], Wb + jwo[j], scr, it, lane);
        base += nitems;
    }
}
__device__ __forceinline__ void s5_prep(unsigned char* ws, const float* const* tab, int l, int gtid, int GT) {
    unsigned char* sp = ws + WS_S5P;
    float2* ABAR = (float2*)(sp + S5P_ABAR); float2* A64 = (float2*)(sp + S5P_A64); float2* BBAR = (float2*)(sp + S5P_BBAR); bf16* CMAT = (bf16*)(sp + S5P_CMAT);
    const float* a_re = tab[12] + l * 1024; const float* a_im = tab[13] + l * 1024; const float* log_dt = tab[14] + l * 16;
    const float* b_re = tab[15] + (size_t)l * 16384; const float* b_im = tab[16] + (size_t)l * 16384;
    const float* c_re = tab[17] + (size_t)l * 16384; const float* c_im = tab[18] + (size_t)l * 16384;
    for (int idx = gtid; idx < 1024; idx += GT) {
        const int g = idx >> 6;
        const float lre = fminf(a_re[idx], -1e-4f), lim = a_im[idx], dt = expf(log_dt[g]);
        const float mag = expf(lre * dt);
        float sn, cs; sincosf(lim * dt, &sn, &cs);
        const float abr = mag * cs, abi = mag * sn;
        const float den = lre * lre + lim * lim;
        const float zr = ((abr - 1.0f) * lre + abi * lim) / den, zi = (abi * lre - (abr - 1.0f) * lim) / den;
        ABAR[idx] = make_float2(abr, abi);
        float pr = abr, pi = abi;
#pragma unroll
        for (int s = 0; s < 6; ++s) { const float nr = pr * pr - pi * pi, ni = 2.0f * pr * pi; pr = nr; pi = ni; }
        A64[idx] = make_float2(pr, pi);
        for (int h = 0; h < 16; ++h) { const float br = b_re[idx * 16 + h], bi = b_im[idx * 16 + h]; BBAR[idx * 16 + h] = make_float2(zr * br - zi * bi, zr * bi + zi * br); }
    }
    for (int idx = gtid; idx < 32768; idx += GT) {
        const int j = idx & 7, ln = (idx >> 3) & 63, ks = (idx >> 9) & 3, g = idx >> 11;
        const int k = 32 * ks + 8 * (ln >> 4) + j, h = ln & 15;
        const float v = k < 64 ? c_re[(g * 16 + h) * 64 + k] : -c_im[(g * 16 + h) * 64 + (k - 64)];
        CMAT[idx] = (bf16)f2bf(v);
    }
}
template <bool HASY, bool HASX, bool HASH>
__device__ __forceinline__ void rowop(const float* xin, float* xout, const bf16* Y, const float* postg, float coef, const float* preg, bf16* H, int nrows, int gw, int NGW, int lane) {
    for (int m = gw; m < nrows; m += NGW) {
        const f32x4* xr = (const f32x4*)(xin + (size_t)m * DM) + lane;
        f32x4 v[4];
#pragma unroll
        for (int j = 0; j < 4; ++j) v[j] = xr[64 * j];
        if (HASY) {
            const v2u* yr = (const v2u*)(Y + (size_t)m * DM) + lane; f32x4 y[4]; float s = 0.f;
#pragma unroll
            for (int j = 0; j < 4; ++j) { const v2u w = yr[64 * j]; y[j] = (f32x4){bflo(w.x), bfhi(w.x), bflo(w.y), bfhi(w.y)}; s += (y[j].x * y[j].x + y[j].y * y[j].y) + (y[j].z * y[j].z + y[j].w * y[j].w); }
            const float r = coef / sqrtf(wave_sum(s) * (1.0f / DM) + EPS);
#pragma unroll
            for (int j = 0; j < 4; ++j) { const f32x4 g = ((const f32x4*)postg)[lane + 64 * j]; v[j] += y[j] * g * r; }
        }
        if (HASX) { f32x4* xo = (f32x4*)(xout + (size_t)m * DM) + lane;
#pragma unroll
            for (int j = 0; j < 4; ++j) xo[64 * j] = v[j]; }
        if (HASH) {
            float s2 = 0.f;
#pragma unroll
            for (int j = 0; j < 4; ++j) s2 += (v[j].x * v[j].x + v[j].y * v[j].y) + (v[j].z * v[j].z + v[j].w * v[j].w);
            const float r2 = 1.0f / sqrtf(wave_sum(s2) * (1.0f / DM) + EPS);
            v2u* ho = (v2u*)(H + (size_t)m * DM) + lane;
#pragma unroll
            for (int j = 0; j < 4; ++j) { const f32x4 g = ((const f32x4*)preg)[lane + 64 * j]; v2u w; w.x = pk2(v[j].x * r2 * g.x, v[j].y * r2 * g.y); w.y = pk2(v[j].z * r2 * g.z, v[j].w * r2 * g.w); ho[64 * j] = w; }
        }
    }
}
template <int DH, bool FOX>
__device__ __forceinline__ void attn_unit(char* lds, const bf16* Qp, int ldq, const bf16* Kp, int ldk, const bf16* Vp, int ldv, bf16* Op, int ldo,
                                          int qpos0, int nkt, const float* Fc, float scale, int tid) {
    constexpr int KS = DH + 8, VS = 72, NPASS = DH / 64, CPR = DH / 8;
    bf16* Ks = (bf16*)lds; bf16* Vt = Ks + 64 * KS;
    const int lane = tid & 63, wave = tid >> 6, li = lane & 15, qd = lane >> 4;
    bf16x8 qf[DH / 32];
    { const bf16* qrow = Qp + (size_t)(wave * 16 + li) * ldq;
#pragma unroll
      for (int ks = 0; ks < DH / 32; ++ks) qf[ks] = *(const bf16x8*)(qrow + 32 * ks + 8 * qd); }
    const int qpos = qpos0 + wave * 16 + li;
    float Fq = 0.f; if (FOX) Fq = Fc[qpos];
    f32x4 oacc[DH / 16];
#pragma unroll
    for (int i = 0; i < DH / 16; ++i) oacc[i] = (f32x4){0.f, 0.f, 0.f, 0.f};
    float mrun = -INFINITY, lsum = 0.f;
    v4u kreg[NPASS], vreg[NPASS];
#pragma unroll
    for (int ps = 0; ps < NPASS; ++ps) { const int c = tid + NTHR * ps, key = c / CPR, dc = c % CPR;
        kreg[ps] = *(const v4u*)(Kp + (size_t)key * ldk + dc * 8); vreg[ps] = *(const v4u*)(Vp + (size_t)key * ldv + dc * 8); }
    for (int kt = 0; kt < nkt; ++kt) {
        __syncthreads();
#pragma unroll
        for (int ps = 0; ps < NPASS; ++ps) { const int c = tid + NTHR * ps, key = c / CPR, dc = c % CPR;
            *(v4u*)(Ks + key * KS + dc * 8) = kreg[ps];
            const v4u vv = vreg[ps];
            bf16* vt = Vt + (dc * 8) * VS + key;
            vt[0 * VS] = (bf16)(vv.x & 0xffffu); vt[1 * VS] = (bf16)(vv.x >> 16); vt[2 * VS] = (bf16)(vv.y & 0xffffu); vt[3 * VS] = (bf16)(vv.y >> 16);
            vt[4 * VS] = (bf16)(vv.z & 0xffffu); vt[5 * VS] = (bf16)(vv.z >> 16); vt[6 * VS] = (bf16)(vv.w & 0xffffu); vt[7 * VS] = (bf16)(vv.w >> 16); }
        __syncthreads();
        if (kt + 1 < nkt) {
#pragma unroll
            for (int ps = 0; ps < NPASS; ++ps) { const int c = tid + NTHR * ps, key = (kt + 1) * 64 + c / CPR, dc = c % CPR;
                kreg[ps] = *(const v4u*)(Kp + (size_t)key * ldk + dc * 8); vreg[ps] = *(const v4u*)(Vp + (size_t)key * ldv + dc * 8); }
        }
        f32x4 s[4];
#pragma unroll
        for (int kb = 0; kb < 4; ++kb) { s[kb] = (f32x4){0.f, 0.f, 0.f, 0.f};
#pragma unroll
            for (int ks = 0; ks < DH / 32; ++ks) { const bf16x8 a = *(const bf16x8*)(Ks + (16 * kb + li) * KS + 32 * ks + 8 * qd); s[kb] = __builtin_amdgcn_mfma_f32_16x16x32_bf16(a, qf[ks], s[kb], 0, 0, 0); } }
        float tmax = -INFINITY;
#pragma unroll
        for (int kb = 0; kb < 4; ++kb)
#pragma unroll
            for (int i = 0; i < 4; ++i) { const int key = kt * 64 + 16 * kb + 4 * qd + i; float v = s[kb][i] * scale;
                if (FOX) { v += Fq - Fc[key]; if (key > qpos) v = -INFINITY; }
                s[kb][i] = v; tmax = fmaxf(tmax, v); }
        tmax = fmaxf(tmax, __shfl_xor(tmax, 16)); tmax = fmaxf(tmax, __shfl_xor(tmax, 32));
        const float mnew = fmaxf(mrun, tmax);
        const float alpha = __expf(mrun - mnew);
        mrun = mnew;
        float psum = 0.f;
#pragma unroll
        for (int kb = 0; kb < 4; ++kb)
#pragma unroll
            for (int i = 0; i < 4; ++i) { const float e = __expf(s[kb][i] - mnew); s[kb][i] = e; psum += e; }
        lsum = lsum * alpha + psum;
#pragma unroll
        for (int i = 0; i < DH / 16; ++i) oacc[i] *= alpha;
        bf16x8 pf[2];
#pragma unroll
        for (int kk = 0; kk < 2; ++kk) { v4u w; w.x = pk2(s[2 * kk][0], s[2 * kk][1]); w.y = pk2(s[2 * kk][2], s[2 * kk][3]); w.z = pk2(s[2 * kk + 1][0], s[2 * kk + 1][1]); w.w = pk2(s[2 * kk + 1][2], s[2 * kk + 1][3]);
            pf[kk] = __builtin_bit_cast(bf16x8, w); }
#pragma unroll
        for (int db = 0; db < DH / 16; ++db)
#pragma unroll
            for (int kk = 0; kk < 2; ++kk) { const bf16* vp = Vt + (16 * db + li) * VS + 32 * kk + 4 * qd;
                const v2u lo = *(const v2u*)vp, hi = *(const v2u*)(vp + 16);
                v4u w; w.x = lo.x; w.y = lo.y; w.z = hi.x; w.w = hi.y;
                oacc[db] = __builtin_amdgcn_mfma_f32_16x16x32_bf16(__builtin_bit_cast(bf16x8, w), pf[kk], oacc[db], 0, 0, 0); }
    }
    lsum += __shfl_xor(lsum, 16); lsum += __shfl_xor(lsum, 32);
    const float inv = 1.0f / lsum;
    bf16* orow = Op + (size_t)(wave * 16 + li) * ldo + 4 * qd;
#pragma unroll
    for (int db = 0; db < DH / 16; ++db) { v2u w; w.x = pk2(oacc[db][0] * inv, oacc[db][1] * inv); w.y = pk2(oacc[db][2] * inv, oacc[db][3] * inv); *(v2u*)(orow + 16 * db) = w; }
}
__device__ __forceinline__ void fox_cumsum(const bf16* P, int b, int h, float fb, float* Fc, float* red, int tid) {
    const int lane = tid & 63, wave = tid >> 6;
    float lf[4];
#pragma unroll
    for (int i = 0; i < 4; ++i) { const float z = bf2f(P[(size_t)(b * SEQ + 4 * tid + i) * LDP + PC_FF + h]) + fb; lf[i] = logsig(z); }
    const float loc = (lf[0] + lf[1]) + (lf[2] + lf[3]);
    float inc = loc;
#pragma unroll
    for (int o = 1; o < 64; o <<= 1) { const float t = __shfl_up(inc, o); if (lane >= o) inc += t; }
    __syncthreads();
    if (lane == 63) red[wave] = inc;
    __syncthreads();
    float off = inc - loc;
    for (int w = 0; w < wave; ++w) off += red[w];
    float run = off;
#pragma unroll
    for (int i = 0; i < 4; ++i) { run += lf[i]; Fc[4 * tid + i] = run; }
    __syncthreads();
}
__device__ __forceinline__ void s5_load_u(const bf16* P, int row0, int g, float* us, int lane) {
    const v4u* src = (const v4u*)(P + (size_t)(row0 + lane) * LDP + PC_SU + g * 16);
    const v4u a = src[0], c = src[1];
    f32x4* dst = (f32x4*)(us + lane * 16);
    dst[0] = (f32x4){bflo(a.x), bfhi(a.x), bflo(a.y), bfhi(a.y)}; dst[1] = (f32x4){bflo(a.z), bfhi(a.z), bflo(a.w), bfhi(a.w)};
    dst[2] = (f32x4){bflo(c.x), bfhi(c.x), bflo(c.y), bfhi(c.y)}; dst[3] = (f32x4){bflo(c.z), bfhi(c.z), bflo(c.w), bfhi(c.w)};
    LDS_WAIT();
}
__device__ __forceinline__ void s5_bu(const float* us, int t, const float (&bre)[16], const float (&bim)[16], float& bur, float& bui) {
    const f32x4* up = (const f32x4*)(us + t * 16);
    bur = 0.f; bui = 0.f;
#pragma unroll
    for (int q = 0; q < 4; ++q) { const f32x4 u4 = up[q];
#pragma unroll
        for (int j = 0; j < 4; ++j) { bur += bre[4 * q + j] * u4[j]; bui += bim[4 * q + j] * u4[j]; } }
}
__device__ __forceinline__ void s5_passA(unsigned char* ws, const float* const* tab, char* lds, int gw, int NGW, int wave, int lane) {
    const bf16* P = (const bf16*)(ws + WS_P);
    const float2* ABAR = (const float2*)(ws + WS_S5P + S5P_ABAR); const float2* BBAR = (const float2*)(ws + WS_S5P + S5P_BBAR);
    float* L = (float*)(ws + WS_S5L);
    float* us = (float*)(lds + wave * 4096);
    for (int u = gw; u < 4096; u += NGW) {
        const int n = u & 31, g = (u >> 5) & 15, b = u >> 9;
        LDS_WAIT();
        s5_load_u(P, b * SEQ + n * 64, g, us, lane);
        float bre[16], bim[16];
#pragma unroll
        for (int h = 0; h < 16; ++h) { const float2 v = BBAR[(g * 64 + lane) * 16 + h]; bre[h] = v.x; bim[h] = v.y; }
        const float2 ab = ABAR[g * 64 + lane];
        float xr = 0.f, xi = 0.f;
        for (int t = 0; t < 64; ++t) { float bur, bui; s5_bu(us, t, bre, bim, bur, bui);
            const float nr = ab.x * xr - ab.y * xi + bur, ni = ab.x * xi + ab.y * xr + bui; xr = nr; xi = ni; }
        L[(size_t)u * 128 + lane] = xr; L[(size_t)u * 128 + 64 + lane] = xi;
    }
}
__device__ __forceinline__ void s5_passC(unsigned char* ws, const float* const* tab, int l, char* lds, int unit, int tid) {
    const int lane = tid & 63, wave = tid >> 6, li = lane & 15, qd = lane >> 4;
    const int b = unit >> 5, n = unit & 31, row0 = b * SEQ + n * 64;
    const bf16* P = (const bf16*)(ws + WS_P);
    const float2* ABAR = (const float2*)(ws + WS_S5P + S5P_ABAR); const float2* A64 = (const float2*)(ws + WS_S5P + S5P_A64);
    const float2* BBAR = (const float2*)(ws + WS_S5P + S5P_BBAR); const bf16* CMAT = (const bf16*)(ws + WS_S5P + S5P_CMAT);
    const float* L = (const float*)(ws + WS_S5L);
    bf16* Xs = (bf16*)(lds + wave * 8704);
    float* us = (float*)(lds + 69632 + wave * 4096);
    bf16* Ys = (bf16*)(lds + 102400);
    __syncthreads();
    for (int gi = 0; gi < 2; ++gi) {
        const int g = 2 * wave + gi;
        LDS_WAIT();
        s5_load_u(P, row0, g, us, lane);
        float xr = 0.f, xi = 0.f;
        { const float2 a64 = A64[g * 64 + lane]; const float* Lb = L + (size_t)((b * 16 + g) * 32) * 128 + lane;
          for (int m0 = 0; m0 < n; m0 += 8) { float lr[8], lim[8];
#pragma unroll
              for (int j = 0; j < 8; ++j) { const bool ok = (m0 + j) < n; const int mi = ok ? (m0 + j) : 0; lr[j] = Lb[mi * 128]; lim[j] = Lb[mi * 128 + 64]; if (!ok) { lr[j] = __builtin_nanf(""); } }
#pragma unroll
              for (int j = 0; j < 8; ++j) { if (lr[j] == lr[j]) { const float nr = a64.x * xr - a64.y * xi + lr[j], ni = a64.x * xi + a64.y * xr + lim[j]; xr = nr; xi = ni; } } } }
        float bre[16], bim[16];
#pragma unroll
        for (int h = 0; h < 16; ++h) { const float2 v = BBAR[(g * 64 + lane) * 16 + h]; bre[h] = v.x; bim[h] = v.y; }
        const float2 ab = ABAR[g * 64 + lane];
        bf16x8 cfr[4];
#pragma unroll
        for (int ks = 0; ks < 4; ++ks) cfr[ks] = *(const bf16x8*)(CMAT + ((size_t)((g * 4 + ks) * 64 + lane)) * 8);
        const float dsk = tab[19][l * 256 + g * 16 + li];
        for (int half = 0; half < 2; ++half) {
            for (int tt = 0; tt < 32; ++tt) { const int t = half * 32 + tt; float bur, bui; s5_bu(us, t, bre, bim, bur, bui);
                const float nr = ab.x * xr - ab.y * xi + bur, ni = ab.x * xi + ab.y * xr + bui; xr = nr; xi = ni;
                Xs[tt * 136 + lane] = (bf16)f2bf(xr); Xs[tt * 136 + 64 + lane] = (bf16)f2bf(xi); }
            LDS_WAIT();
#pragma unroll
            for (int rb = 0; rb < 2; ++rb) { f32x4 acc = (f32x4){0.f, 0.f, 0.f, 0.f};
#pragma unroll
                for (int ks = 0; ks < 4; ++ks) { const bf16x8 a = *(const bf16x8*)(Xs + (16 * rb + li) * 136 + 32 * ks + 8 * qd); acc = __builtin_amdgcn_mfma_f32_16x16x32_bf16(a, cfr[ks], acc, 0, 0, 0); }
#pragma unroll
                for (int i = 0; i < 4; ++i) { const int t = half * 32 + 16 * rb + 4 * qd + i; const float yv = gelu_tanh(acc[i] + dsk * us[t * 16 + li]); Ys[t * 264 + g * 16 + li] = (bf16)f2bf(yv); } }
            LDS_WAIT();
        }
    }
    __syncthreads();
    { const bf16* Wg = (const bf16*)(ws + WS_W) + WO_GLU; const float* gb = tab[21] + l * 256; bf16* BRS = (bf16*)(ws + WS_BRS);
      f32x4 acc[4][2];
#pragma unroll
      for (int rb = 0; rb < 4; ++rb) { acc[rb][0] = (f32x4){0.f, 0.f, 0.f, 0.f}; acc[rb][1] = (f32x4){0.f, 0.f, 0.f, 0.f}; }
#pragma unroll
      for (int ks = 0; ks < 8; ++ks) { bf16x8 bfr[2];
#pragma unroll
          for (int cb = 0; cb < 2; ++cb) bfr[cb] = *(const bf16x8*)(Wg + (size_t)(32 * wave + 16 * cb + li) * 256 + 32 * ks + 8 * qd);
#pragma unroll
          for (int rb = 0; rb < 4; ++rb) { const bf16x8 a = *(const bf16x8*)(Ys + (16 * rb + li) * 264 + 32 * ks + 8 * qd);
#pragma unroll
              for (int cb = 0; cb < 2; ++cb) acc[rb][cb] = __builtin_amdgcn_mfma_f32_16x16x32_bf16(a, bfr[cb], acc[rb][cb], 0, 0, 0); } }
#pragma unroll
      for (int rb = 0; rb < 4; ++rb)
#pragma unroll
          for (int cb = 0; cb < 2; ++cb) { const int col = 32 * wave + 16 * cb + li; const float bias = gb[col];
#pragma unroll
              for (int i = 0; i < 4; ++i) { const int t = 16 * rb + 4 * qd + i; const float yv = bf2f(Ys[t * 264 + col]); const float o = yv * sigmoidf_(acc[rb][cb][i] + bias);
                  BRS[(size_t)(row0 + t) * 256 + col] = (bf16)f2bf(o); } } }
    __syncthreads();
}
struct GlaLds { float* QF; float* QI; float* KI; float* KE; float* G; float* V; float* AT; float* SP; float* GD; };
__device__ __forceinline__ GlaLds gla_lds(char* lds) { GlaLds s; float* f = (float*)lds; s.QF = f; s.QI = f + 2112; s.KI = f + 4224; s.KE = f + 6336; s.G = f + 8448; s.V = f + 10560; s.AT = f + 14656; s.SP = f + 18816; s.GD = f + 20864; return s; }
__device__ __forceinline__ void gla_load(unsigned char* ws, const float* const* tab, int l, const GlaLds& s, int row0, int h, int tid, bool need_q) {
    const bf16* P = (const bf16*)(ws + WS_P);
    const int t = tid >> 3, c8 = tid & 7;
    const bf16* prow = P + (size_t)(row0 + t) * LDP;
    if (need_q) { const v2u w = *(const v2u*)(prow + PC_GQ + h * 32 + 4 * c8); float* d = s.QF + t * 33 + 4 * c8; d[0] = bflo(w.x); d[1] = bfhi(w.x); d[2] = bflo(w.y); d[3] = bfhi(w.y); }
    { const v2u w = *(const v2u*)(prow + PC_GK + h * 32 + 4 * c8); float* d = s.KI + t * 33 + 4 * c8; d[0] = bflo(w.x); d[1] = bfhi(w.x); d[2] = bflo(w.y); d[3] = bfhi(w.y); }
    { const v4u w = *(const v4u*)(prow + PC_GV + h * 64 + 8 * c8); f32x4* d = (f32x4*)(s.V + t * 64 + 8 * c8); d[0] = (f32x4){bflo(w.x), bfhi(w.x), bflo(w.y), bfhi(w.y)}; d[1] = (f32x4){bflo(w.z), bfhi(w.z), bflo(w.w), bfhi(w.w)}; }
    if (tid < 128) { const int tt = tid >> 1, hf = tid & 1; const v4u w = *(const v4u*)(P + (size_t)(row0 + tt) * LDP + PC_GD + 8 * hf); float* d = s.GD + tt * 16 + 8 * hf;
        d[0] = bflo(w.x); d[1] = bfhi(w.x); d[2] = bflo(w.y); d[3] = bfhi(w.y); d[4] = bflo(w.z); d[5] = bfhi(w.z); d[6] = bflo(w.w); d[7] = bfhi(w.w); }
    __syncthreads();
    const float* gw = tab[8] + l * 2048; const float* gbias = tab[9] + l * 128;
#pragma unroll
    for (int i = 0; i < 4; ++i) { const int d = 4 * c8 + i; float z = gbias[h * 32 + d];
#pragma unroll
        for (int r = 0; r < 16; ++r) z += s.GD[t * 16 + r] * gw[r * 128 + h * 32 + d];
        s.G[t * 33 + d] = logsig(z) * (1.0f / 16.0f); }
    __syncthreads();
    if (tid < 32) { float v[64];
#pragma unroll
        for (int tt = 0; tt < 64; ++tt) v[tt] = s.G[tt * 33 + tid];
#pragma unroll
        for (int tt = 1; tt < 64; ++tt) v[tt] += v[tt - 1];
#pragma unroll
        for (int tt = 0; tt < 64; ++tt) s.G[tt * 33 + tid] = v[tt]; }
    __syncthreads();
}
__device__ __forceinline__ void gla_passA(unsigned char* ws, const float* const* tab, int l, char* lds, int unit, int tid) {
    const GlaLds s = gla_lds(lds);
    const int b = unit >> 5, n = unit & 31, row0 = b * SEQ + n * 64;
    float* DS = (float*)(ws + WS_DS); float* DEC = (float*)(ws + WS_DEC);
    __syncthreads();
    for (int h = 0; h < 4; ++h) {
        gla_load(ws, tab, l, s, row0, h, tid, false);
        { const int t = tid >> 3, c8 = tid & 7;
#pragma unroll
          for (int i = 0; i < 4; ++i) { const int d = 4 * c8 + i; s.KI[t * 33 + d] *= expf(s.G[63 * 33 + d] - s.G[t * 33 + d]); } }
        __syncthreads();
        { const int d = tid >> 4, e0 = 4 * (tid & 15); f32x4 acc = (f32x4){0.f, 0.f, 0.f, 0.f};
          for (int c = 0; c < 64; ++c) acc += s.KI[c * 33 + d] * *(const f32x4*)(s.V + c * 64 + e0);
          const size_t ub = (size_t)((b * 4 + h) * 32 + n);
          *(f32x4*)(DS + ub * 2048 + d * 64 + e0) = acc;
          if ((tid & 15) == 0) DEC[ub * 32 + d] = expf(s.G[63 * 33 + d]); }
        __syncthreads();
    }
}
__device__ __forceinline__ void gla_passC(unsigned char* ws, const float* const* tab, int l, char* lds, int unit, int tid) {
    const GlaLds s = gla_lds(lds);
    const int b = unit >> 5, n = unit & 31, row0 = b * SEQ + n * 64;
    const float* DS = (const float*)(ws + WS_DS); const float* DEC = (const float*)(ws + WS_DEC);
    const bf16* P = (const bf16*)(ws + WS_P); bf16* BRG = (bf16*)(ws + WS_BRG);
    const float* gn = tab[10] + l * 256;
    __syncthreads();
    for (int h = 0; h < 4; ++h) {
        gla_load(ws, tab, l, s, row0, h, tid, true);
        { const int t = tid >> 3, c8 = tid & 7;
#pragma unroll
          for (int i = 0; i < 4; ++i) { const int d = 4 * c8 + i; const float g = s.G[t * 33 + d]; const float eg = expf(g), ieg = expf(-g);
              const float q = s.QF[t * 33 + d] * 0.17677669529663687f, k = s.KI[t * 33 + d];
              s.QF[t * 33 + d] = q * eg; s.QI[t * 33 + d] = q * ieg; s.KI[t * 33 + d] = k * ieg; s.KE[t * 33 + d] = k * eg; } }
        __syncthreads();
        { const int i = tid >> 3, jb = tid & 7;
#pragma unroll
          for (int jj = 0; jj < 8; ++jj) { const int j = jb + 8 * jj; const float* qa = (j <= i) ? s.QF : s.QI; const float* kb = (j <= i) ? s.KI : s.KE; float dot = 0.f;
#pragma unroll
              for (int d = 0; d < 32; ++d) dot += qa[i * 33 + d] * kb[j * 33 + d];
              s.AT[i * 65 + j] = dot; } }
        { const int idx4 = tid * 4, d = idx4 >> 6; f32x4 S = (f32x4){0.f, 0.f, 0.f, 0.f};
          const float* base = DS + (size_t)((b * 4 + h) * 32) * 2048 + idx4; const float* decb = DEC + (size_t)((b * 4 + h) * 32) * 32 + d;
          for (int m0 = 0; m0 < n; m0 += 8) { f32x4 v[8]; float dd[8];
#pragma unroll
              for (int j = 0; j < 8; ++j) { const bool ok = (m0 + j) < n; const int mi = ok ? (m0 + j) : 0; v[j] = *(const f32x4*)(base + (size_t)mi * 2048); dd[j] = decb[mi * 32];
                  if (!ok) { v[j] = (f32x4){0.f, 0.f, 0.f, 0.f}; dd[j] = 1.0f; } }
#pragma unroll
              for (int j = 0; j < 8; ++j) S = S * dd[j] + v[j]; }
          *(f32x4*)(s.SP + idx4) = S; }
        __syncthreads();
        { const int i = tid >> 3, e0 = 8 * (tid & 7); f32x4 a0 = (f32x4){0.f, 0.f, 0.f, 0.f}, a1 = a0;
          for (int j = 0; j < 64; ++j) { const float a = s.AT[i * 65 + j]; a0 += a * *(const f32x4*)(s.V + j * 64 + e0); a1 += a * *(const f32x4*)(s.V + j * 64 + e0 + 4); }
          for (int d = 0; d < 32; ++d) { const float a = s.QF[i * 33 + d]; a0 += a * *(const f32x4*)(s.SP + d * 64 + e0); a1 += a * *(const f32x4*)(s.SP + d * 64 + e0 + 4); }
          float ss = (a0[0] * a0[0] + a0[1] * a0[1]) + (a0[2] * a0[2] + a0[3] * a0[3]) + (a1[0] * a1[0] + a1[1] * a1[1]) + (a1[2] * a1[2] + a1[3] * a1[3]);
          ss += __shfl_xor(ss, 1); ss += __shfl_xor(ss, 2); ss += __shfl_xor(ss, 4);
          const float r = 1.0f / sqrtf(ss * (1.0f / 64.0f) + EPS);
          const v4u gr = *(const v4u*)(P + (size_t)(row0 + i) * LDP + PC_GR + h * 64 + e0);
          const float grv[8] = {bflo(gr.x), bfhi(gr.x), bflo(gr.y), bfhi(gr.y), bflo(gr.z), bfhi(gr.z), bflo(gr.w), bfhi(gr.w)};
          float o[8];
#pragma unroll
          for (int k = 0; k < 8; ++k) { const float v = (k < 4 ? a0[k & 3] : a1[k & 3]) * r * gn[h * 64 + e0 + k]; const float gg = grv[k]; o[k] = v * gg * sigmoidf_(gg); }
          v4u w; w.x = pk2(o[0], o[1]); w.y = pk2(o[2], o[3]); w.z = pk2(o[4], o[5]); w.w = pk2(o[6], o[7]);
          *(v4u*)(BRG + (size_t)(row0 + i) * 256 + h * 64 + e0) = w; }
        __syncthreads();
    }
}

__device__ __forceinline__ void gla_passC_mfma(unsigned char* ws, const float* const* tab, int l, char* lds, int unit, int tid) {
    const int b = unit >> 5, n = unit & 31, row0 = b * SEQ + n * 64;
    const float* DS = (const float*)(ws + WS_DS); const float* DEC = (const float*)(ws + WS_DEC);
    const bf16* P = (const bf16*)(ws + WS_P); bf16* BRG = (bf16*)(ws + WS_BRG);
    const float* gn = tab[10] + l * 256; const float* gw = tab[8] + l * 2048; const float* gbias = tab[9] + l * 128;
    const int lane = tid & 63, wave = tid >> 6, li = lane & 15, qd = lane >> 4;
    const int slot = tid >> 8, st = tid & 255, t = st >> 2, c4 = st & 3, wr = wave & 3;
    char* sb = lds + slot * 52480;
    bf16* QFb = (bf16*)sb; bf16* QIb = QFb + 2560; bf16* KIb = QIb + 2560; bf16* KEb = KIb + 2560;
    bf16* Vt = (bf16*)(sb + 20480); bf16* ATb = (bf16*)(sb + 29696); bf16* SPt = (bf16*)(sb + 38912); float* Gs = (float*)(sb + 44032);
    float* GD = (float*)(lds + 104960);
    __syncthreads();
    if (tid < 128) { const int tt = tid >> 1, hf = tid & 1; const v4u w = *(const v4u*)(P + (size_t)(row0 + tt) * LDP + PC_GD + 8 * hf); float* d = GD + tt * 16 + 8 * hf;
        d[0] = bflo(w.x); d[1] = bfhi(w.x); d[2] = bflo(w.y); d[3] = bfhi(w.y); d[4] = bflo(w.z); d[5] = bfhi(w.z); d[6] = bflo(w.w); d[7] = bfhi(w.w); }
    for (int hp = 0; hp < 2; ++hp) {
        const int h = 2 * hp + slot;
        const bf16* prow = P + (size_t)(row0 + t) * LDP;
        const v4u qw = *(const v4u*)(prow + PC_GQ + h * 32 + 8 * c4);
        const v4u kw = *(const v4u*)(prow + PC_GK + h * 32 + 8 * c4);
        { const v4u v0 = *(const v4u*)(prow + PC_GV + h * 64 + 16 * c4), v1 = *(const v4u*)(prow + PC_GV + h * 64 + 16 * c4 + 8);
          bf16* vt = Vt + (16 * c4) * 72 + t;
          vt[0 * 72] = (bf16)(v0.x & 0xffffu); vt[1 * 72] = (bf16)(v0.x >> 16); vt[2 * 72] = (bf16)(v0.y & 0xffffu); vt[3 * 72] = (bf16)(v0.y >> 16);
          vt[4 * 72] = (bf16)(v0.z & 0xffffu); vt[5 * 72] = (bf16)(v0.z >> 16); vt[6 * 72] = (bf16)(v0.w & 0xffffu); vt[7 * 72] = (bf16)(v0.w >> 16);
          vt[8 * 72] = (bf16)(v1.x & 0xffffu); vt[9 * 72] = (bf16)(v1.x >> 16); vt[10 * 72] = (bf16)(v1.y & 0xffffu); vt[11 * 72] = (bf16)(v1.y >> 16);
          vt[12 * 72] = (bf16)(v1.z & 0xffffu); vt[13 * 72] = (bf16)(v1.z >> 16); vt[14 * 72] = (bf16)(v1.w & 0xffffu); vt[15 * 72] = (bf16)(v1.w >> 16); }
        __syncthreads();
#pragma unroll
        for (int i = 0; i < 8; ++i) { const int d = 8 * c4 + i; float z = gbias[h * 32 + d];
#pragma unroll
            for (int r = 0; r < 16; ++r) z += GD[t * 16 + r] * gw[r * 128 + h * 32 + d];
            Gs[t * 33 + d] = logsig(z) * (1.0f / 16.0f); }
        __syncthreads();
        if (st < 32) { float v[64];
#pragma unroll
            for (int tt = 0; tt < 64; ++tt) v[tt] = Gs[tt * 33 + st];
#pragma unroll
            for (int tt = 1; tt < 64; ++tt) v[tt] += v[tt - 1];
#pragma unroll
            for (int tt = 0; tt < 64; ++tt) Gs[tt * 33 + st] = v[tt]; }
        __syncthreads();
        { const float qv[8] = {bflo(qw.x), bfhi(qw.x), bflo(qw.y), bfhi(qw.y), bflo(qw.z), bfhi(qw.z), bflo(qw.w), bfhi(qw.w)};
          const float kv[8] = {bflo(kw.x), bfhi(kw.x), bflo(kw.y), bfhi(kw.y), bflo(kw.z), bfhi(kw.z), bflo(kw.w), bfhi(kw.w)};
          float qf[8], qi[8], ki[8], ke[8];
#pragma unroll
          for (int i = 0; i < 8; ++i) { const float g = Gs[t * 33 + 8 * c4 + i]; const float eg = expf(g), ieg = expf(-g); const float q = qv[i] * 0.17677669529663687f;
              qf[i] = q * eg; qi[i] = q * ieg; ki[i] = kv[i] * ieg; ke[i] = kv[i] * eg; }
          v4u w;
          w.x = pk2(qf[0], qf[1]); w.y = pk2(qf[2], qf[3]); w.z = pk2(qf[4], qf[5]); w.w = pk2(qf[6], qf[7]); *(v4u*)(QFb + t * 40 + 8 * c4) = w;
          w.x = pk2(qi[0], qi[1]); w.y = pk2(qi[2], qi[3]); w.z = pk2(qi[4], qi[5]); w.w = pk2(qi[6], qi[7]); *(v4u*)(QIb + t * 40 + 8 * c4) = w;
          w.x = pk2(ki[0], ki[1]); w.y = pk2(ki[2], ki[3]); w.z = pk2(ki[4], ki[5]); w.w = pk2(ki[6], ki[7]); *(v4u*)(KIb + t * 40 + 8 * c4) = w;
          w.x = pk2(ke[0], ke[1]); w.y = pk2(ke[2], ke[3]); w.z = pk2(ke[4], ke[5]); w.w = pk2(ke[6], ke[7]); *(v4u*)(KEb + t * 40 + 8 * c4) = w; }
        { const int idx8 = st * 8, d = idx8 >> 6, e0 = idx8 & 63; f32x4 S0 = (f32x4){0.f, 0.f, 0.f, 0.f}, S1 = S0;
          const float* base = DS + (size_t)((b * 4 + h) * 32) * 2048 + idx8; const float* decb = DEC + (size_t)((b * 4 + h) * 32) * 32 + d;
          for (int m0 = 0; m0 < n; m0 += 4) { f32x4 va[4], vb[4]; float dd[4];
#pragma unroll
              for (int j = 0; j < 4; ++j) { const bool ok = (m0 + j) < n; const int mi = ok ? (m0 + j) : 0; va[j] = *(const f32x4*)(base + (size_t)mi * 2048); vb[j] = *(const f32x4*)(base + (size_t)mi * 2048 + 4); dd[j] = decb[mi * 32];
                  if (!ok) { va[j] = (f32x4){0.f, 0.f, 0.f, 0.f}; vb[j] = va[j]; dd[j] = 1.0f; } }
#pragma unroll
              for (int j = 0; j < 4; ++j) { S0 = S0 * dd[j] + va[j]; S1 = S1 * dd[j] + vb[j]; } }
#pragma unroll
          for (int i = 0; i < 4; ++i) { SPt[(e0 + i) * 40 + d] = (bf16)f2bf(S0[i]); SPt[(e0 + 4 + i) * 40 + d] = (bf16)f2bf(S1[i]); } }
        __syncthreads();
        { const bf16x8 aqf = *(const bf16x8*)(QFb + (16 * wr + li) * 40 + 8 * qd), aqi = *(const bf16x8*)(QIb + (16 * wr + li) * 40 + 8 * qd);
#pragma unroll
          for (int cb = 0; cb < 4; ++cb) { const bf16x8 bki = *(const bf16x8*)(KIb + (16 * cb + li) * 40 + 8 * qd), bke = *(const bf16x8*)(KEb + (16 * cb + li) * 40 + 8 * qd);
              const f32x4 z4 = (f32x4){0.f, 0.f, 0.f, 0.f};
              const f32x4 af = __builtin_amdgcn_mfma_f32_16x16x32_bf16(aqf, bki, z4, 0, 0, 0), ab = __builtin_amdgcn_mfma_f32_16x16x32_bf16(aqi, bke, z4, 0, 0, 0);
#pragma unroll
              for (int r = 0; r < 4; ++r) { const int i = 16 * wr + 4 * qd + r, j = 16 * cb + li; ATb[i * 72 + j] = (bf16)f2bf(j <= i ? af[r] : ab[r]); } }
          LDS_WAIT();
          f32x4 oa[4];
#pragma unroll
          for (int cb = 0; cb < 4; ++cb) { oa[cb] = (f32x4){0.f, 0.f, 0.f, 0.f};
#pragma unroll
              for (int ks = 0; ks < 2; ++ks) { const bf16x8 a = *(const bf16x8*)(ATb + (16 * wr + li) * 72 + 32 * ks + 8 * qd), bv = *(const bf16x8*)(Vt + (16 * cb + li) * 72 + 32 * ks + 8 * qd);
                  oa[cb] = __builtin_amdgcn_mfma_f32_16x16x32_bf16(a, bv, oa[cb], 0, 0, 0); }
              const bf16x8 bs = *(const bf16x8*)(SPt + (16 * cb + li) * 40 + 8 * qd);
              oa[cb] = __builtin_amdgcn_mfma_f32_16x16x32_bf16(aqf, bs, oa[cb], 0, 0, 0); }
#pragma unroll
          for (int r = 0; r < 4; ++r) { float ss = (oa[0][r] * oa[0][r] + oa[1][r] * oa[1][r]) + (oa[2][r] * oa[2][r] + oa[3][r] * oa[3][r]);
              ss += __shfl_xor(ss, 1); ss += __shfl_xor(ss, 2); ss += __shfl_xor(ss, 4); ss += __shfl_xor(ss, 8);
              const float rs = 1.0f / sqrtf(ss * (1.0f / 64.0f) + EPS);
              const int i = 16 * wr + 4 * qd + r;
#pragma unroll
              for (int cb = 0; cb < 4; ++cb) { const int e = 16 * cb + li; const float gg = bf2f(P[(size_t)(row0 + i) * LDP + PC_GR + h * 64 + e]);
                  const float o = oa[cb][r] * rs * gn[h * 64 + e] * gg * sigmoidf_(gg);
                  BRG[(size_t)(row0 + i) * 256 + h * 64 + e] = (bf16)f2bf(o); } } }
        __syncthreads();
    }
}
__device__ __forceinline__ void gsync(unsigned char* wsb, unsigned G, int wave_s) {
    unsigned char* wl_ = wsb; asm volatile("" : "+s"(wl_)); unsigned* ctr = (unsigned*)(wl_ + 1024);
    int ln_; asm volatile("v_mbcnt_lo_u32_b32 %0, -1, 0\n\tv_mbcnt_hi_u32_b32 %0, -1, %0" : "=v"(ln_));
    const bool leader = (wave_s == 0) && (ln_ == 0);
    asm volatile("s_waitcnt vmcnt(0)" ::: "memory");
    __syncthreads();
    if (leader) {
        __builtin_amdgcn_fence(__ATOMIC_RELEASE, "agent");
        asm volatile("s_waitcnt vmcnt(0)" ::: "memory");
        const unsigned old = __hip_atomic_fetch_add(ctr, 1u, __ATOMIC_RELAXED, __HIP_MEMORY_SCOPE_AGENT);
        const unsigned want = (old | (G - 1u)) + 1u;
        while (__hip_atomic_load(ctr, __ATOMIC_RELAXED, __HIP_MEMORY_SCOPE_AGENT) < want) __builtin_amdgcn_s_sleep(2);
        __builtin_amdgcn_fence(__ATOMIC_ACQUIRE, "agent");
        asm volatile("s_waitcnt vmcnt(0)" ::: "memory");
    }
    __syncthreads();
}
__global__ void __launch_bounds__(NTHR, 2) fwd_mega(Params p) {
    extern __shared__ __attribute__((aligned(16))) unsigned char lds_raw[];
    char* lds = (char*)lds_raw;
    PG8_LAS unsigned char* ldsg = (PG8_LAS unsigned char*)lds_raw;
    cg::grid_group grid = cg::this_grid();
    constexpr int G = 256; const int bid = blockIdx.x;
    const int wave_s = __builtin_amdgcn_readfirstlane(threadIdx.x >> 6);
    const int NGW = G * NWAVES;
#define TIDS() int tid; { int ln_; asm volatile("v_mbcnt_lo_u32_b32 %0, -1, 0\n\tv_mbcnt_hi_u32_b32 %0, -1, %0" : "=v"(ln_)); tid = wave_s * 64 + ln_; } const int lane = tid & 63, wave = __builtin_amdgcn_readfirstlane(tid >> 6), gw = bid * NWAVES + wave; (void)lane; (void)gw
    if (threadIdx.x < 38) ((const float**)p.ws)[threadIdx.x] = threadIdx.x < 37 ? p.in[threadIdx.x] : (const float*)p.out;
    if (bid == 0 && threadIdx.x >= 64 && threadIdx.x < 128) ((unsigned*)(p.ws + 1024))[threadIdx.x - 64] = 0u;
    grid.sync();
#define PTRS() unsigned char* ws = p.ws; asm volatile("" : "+s"(ws)); const float* const* tab = (const float* const*)ws; (void)tab
#define GSYNC() gsync(p.ws, 256u, wave_s)
#define Wb ((bf16*)(ws + WS_W))
#define P ((bf16*)(ws + WS_P))
#define ACT ((bf16*)(ws + WS_P))
#define H ((bf16*)(ws + WS_H))
#define Y ((float*)(ws + WS_Y))
#define YB ((bf16*)(ws + WS_Y))
#define BRG ((bf16*)(ws + WS_BRG))
#define BRS ((bf16*)(ws + WS_BRS))
#define BRF ((bf16*)(ws + WS_BRF))
#define MIXB ((bf16*)(ws + WS_MIXB))
#define Qb ((bf16*)(ws + WS_Q))
#define XO ((bf16*)(ws + WS_XO))
#define KV ((bf16*)(ws + WS_KV))
#define MEMN ((bf16*)(ws + WS_MEMN))
#define X ((float*)tab[37])

#define GEMM(EpiT, epi, Ap, Bp, Mv, Nv, Kv) do { pg8::Gemm g_{(const pg8::bf16_t*)(Ap), (const pg8::bf16_t*)(Bp), (Mv), (Nv), (Kv)}; int bid_ = bid; const int G_ = G; asm volatile("" : "+s"(bid_)); pg8::StaticOrder S_; S_.init((Mv), (Nv), G_, bid_); \
        TIDS(); pg8::gemm_phase<EpiT, pg8::StaticOrder, true, true>(ldsg, g_, S_, epi, tid); __syncthreads(); } while (0)

    { PTRS(); TIDS();
#if EN_CONV
      convert_weights(ws, tab, 0, lds, gw, NGW, wave, lane);
      s5_prep(ws, tab, 0, bid * NTHR + tid, G * NTHR);
#if REP_CONV > 1
      convert_weights(ws, tab, 0, lds, gw, NGW, wave, lane);
#endif
#endif
      rowop<false, false, true>(tab[1], nullptr, nullptr, nullptr, 0.f, tab[28], MEMN, MMEM, gw, NGW, lane);
      rowop<false, true, true>(tab[0], X, nullptr, nullptr, 0.f, tab[2], H, MTOK, gw, NGW, lane); }
    GSYNC();

    for (int l = 0; l < DEPTH; ++l) {
        { PTRS(); pg8::EpiSwiGLU e{ACT, DFF}; GEMM(pg8::EpiSwiGLU, e, H, Wb + WO_GU1, MTOK, 5632, 1024); }
        GSYNC();
        { PTRS(); pg8::EpiBf16 e{YB, DM}; GEMM(pg8::EpiBf16, e, ACT, Wb + WO_DOWN1, MTOK, 1024, DFF); }
        GSYNC();
        { PTRS(); TIDS(); rowop<true, true, true>(X, X, YB, tab[5] + l * DM, 0.5f, tab[6] + l * DM, H, MTOK, gw, NGW, lane); }
#if REP_ROW
        { PTRS(); TIDS(); rowop<true, true, true>(X, (float*)(ws + WS_P), YB, tab[5] + l * DM, 0.5f, tab[6] + l * DM, (bf16*)(ws + WS_P + 64 * MiB), MTOK, gw, NGW, lane); }
#endif
        GSYNC();
        { PTRS(); pg8::EpiBf16 e{P, LDP}; GEMM(pg8::EpiBf16, e, H, Wb + WO_IN, MTOK, LDP, 1024); }
        { PTRS(); pg8::EpiBf16 e{KV, 2048}; GEMM(pg8::EpiBf16, e, MEMN, Wb + WO_KV, MMEM, 2048, 1024); }
        GSYNC();
        for (int rep_ = 0; rep_ < REP_MIXA; ++rep_) {
#if EN_S5A
        for (int r2_ = 0; r2_ < REP_S5A; ++r2_) { PTRS(); TIDS(); s5_passA(ws, tab, lds, gw, NGW, wave, lane); }
#endif
#if EN_GLAA
        for (int r2_ = 0; r2_ < REP_GLAA; ++r2_) { PTRS(); TIDS(); for (int u = bid; u < 256; u += G) gla_passA(ws, tab, l, lds, u, tid); }
#endif
#if EN_FOX
        for (int r2_ = 0; r2_ < REP_FOX; ++r2_) { PTRS(); TIDS();
          for (int pr = bid; pr < 512; pr += G) {
            const int bh = pr >> 3, pp = pr & 7, b = bh >> 3, h = bh & 7;
            float* Fc = (float*)(lds + 24576); float* red = (float*)(lds + 24576 + 8192);
            __syncthreads();
            fox_cumsum(P, b, h, tab[23][l * 8 + h], Fc, red, tid);
            for (int hf = 0; hf < 2; ++hf) { const int qb = hf ? 15 - pp : pp;
                const size_t rq = (size_t)(b * SEQ + qb * 128);
                attn_unit<64, true>(lds, P + rq * LDP + PC_FQ + h * 64, LDP, P + (size_t)(b * SEQ) * LDP + PC_FK + h * 64, LDP, P + (size_t)(b * SEQ) * LDP + PC_FV + h * 64, LDP,
                                    BRF + rq * 512 + h * 64, 512, qb * 128, 2 * qb + 2, Fc, 0.125f, tid); }
          } }
#endif
        }
        GSYNC();
        for (int rep_ = 0; rep_ < REP_MIXC; ++rep_) {
#if EN_S5C
        for (int r2_ = 0; r2_ < REP_S5C; ++r2_) { PTRS(); TIDS(); for (int u = bid; u < 256; u += G) s5_passC(ws, tab, l, lds, u, tid); }
#endif
#if EN_GLAC
        for (int r2_ = 0; r2_ < REP_GLAC; ++r2_) { PTRS(); TIDS(); for (int u = bid; u < 256; u += G) gla_passC_mfma(ws, tab, l, lds, u, tid); }
#endif
        }
        GSYNC();
        { PTRS(); pg8::EpiMerge<0> e{Y, MIXB, P + PC_GATE, LDP}; GEMM(pg8::EpiMerge<0>, e, BRG, Wb + WO_GLAUP, MTOK, 1024, 256); }
        { PTRS(); pg8::EpiMerge<1> e{Y, MIXB, P + PC_GATE + 1024, LDP}; GEMM(pg8::EpiMerge<1>, e, BRS, Wb + WO_S5UP, MTOK, 1024, 256); }
        { PTRS(); pg8::EpiMerge<2> e{Y, MIXB, P + PC_GATE + 2048, LDP}; GEMM(pg8::EpiMerge<2>, e, BRF, Wb + WO_FOXUP, MTOK, 1024, 512); }
        GSYNC();
        { PTRS(); pg8::EpiBf16 e{YB, DM}; GEMM(pg8::EpiBf16, e, MIXB, Wb + WO_MIXOUT, MTOK, 1024, 1024); }
        GSYNC();
        { PTRS(); TIDS(); rowop<true, true, true>(X, X, YB, tab[26] + l * DM, 1.0f, tab[27] + l * DM, H, MTOK, gw, NGW, lane); }
#if REP_ROW
        { PTRS(); TIDS(); rowop<true, true, true>(X, (float*)(ws + WS_P), YB, tab[26] + l * DM, 1.0f, tab[27] + l * DM, (bf16*)(ws + WS_P + 64 * MiB), MTOK, gw, NGW, lane); }
#endif
        GSYNC();
        { PTRS(); pg8::EpiBf16 e{Qb, DM}; GEMM(pg8::EpiBf16, e, H, Wb + WO_Q, MTOK, 1024, 1024); }
        GSYNC();
#if EN_XA
        for (int rep_ = 0; rep_ < REP_XA; ++rep_)
        { PTRS(); TIDS();
          for (int u = bid; u < 512; u += G) { const int qb = u & 15, hd = (u >> 4) & 3, b = u >> 6;
            const size_t rq = (size_t)(b * SEQ + qb * 128);
            attn_unit<256, false>(lds, Qb + rq * DM + hd * 256, DM, KV + (size_t)(b * NMEM) * 2048 + hd * 256, 2048, KV + (size_t)(b * NMEM) * 2048 + 1024 + hd * 256, 2048,
                                  XO + rq * DM + hd * 256, DM, 0, 4, nullptr, 0.0625f, tid); } }
#endif
        GSYNC();
        { PTRS(); pg8::EpiBf16 e{YB, DM}; GEMM(pg8::EpiBf16, e, XO, Wb + WO_O, MTOK, 1024, 1024); }
        GSYNC();
        { PTRS(); TIDS(); rowop<true, true, true>(X, X, YB, tab[32] + l * DM, 1.0f, tab[33] + l * DM, H, MTOK, gw, NGW, lane); }
#if REP_ROW
        { PTRS(); TIDS(); rowop<true, true, true>(X, (float*)(ws + WS_P), YB, tab[32] + l * DM, 1.0f, tab[33] + l * DM, (bf16*)(ws + WS_P + 64 * MiB), MTOK, gw, NGW, lane); }
#endif
        GSYNC();
        { PTRS(); pg8::EpiSwiGLU e{ACT, DFF}; GEMM(pg8::EpiSwiGLU, e, H, Wb + WO_GU2, MTOK, 5632, 1024); }
        GSYNC();
        { PTRS(); pg8::EpiBf16 e{YB, DM}; GEMM(pg8::EpiBf16, e, ACT, Wb + WO_DOWN2, MTOK, 1024, DFF); }
        GSYNC();
        if (l + 1 < DEPTH) {
            { PTRS(); TIDS(); rowop<true, true, true>(X, X, YB, tab[36] + l * DM, 0.5f, tab[2] + (l + 1) * DM, H, MTOK, gw, NGW, lane); }
#if REP_ROW
            { PTRS(); TIDS(); rowop<true, true, true>(X, (float*)(ws + WS_P), YB, tab[36] + l * DM, 0.5f, tab[2] + (l + 1) * DM, (bf16*)(ws + WS_P + 64 * MiB), MTOK, gw, NGW, lane); }
#endif
            __syncthreads();
            { PTRS(); TIDS();
#if EN_CONV
              convert_weights(ws, tab, l + 1, lds, gw, NGW, wave, lane);
              s5_prep(ws, tab, l + 1, bid * NTHR + tid, G * NTHR);
#if REP_CONV > 1
              convert_weights(ws, tab, l + 1, lds, gw, NGW, wave, lane);
#endif
#endif
              rowop<false, false, true>(tab[1], nullptr, nullptr, nullptr, 0.f, tab[28] + (l + 1) * DM, MEMN, MMEM, gw, NGW, lane); }
            GSYNC();
        } else {
            { PTRS(); TIDS(); rowop<true, true, false>(X, X, YB, tab[36] + l * DM, 0.5f, nullptr, nullptr, MTOK, gw, NGW, lane); }
        }
    }
}

extern "C" void kernel_launch(void* const* d_in, const int* in_sizes, int n_in, void* d_out, int out_size, void* d_ws, size_t ws_size, hipStream_t stream) {
    static int grid = 0;
    if (grid == 0) {
        if (n_in != 37 || out_size != MTOK * DM || ws_size < WS_END) { fprintf(stderr, "kernel_launch: unexpected shapes (n_in %d out %d ws %zu need %zu)\n", n_in, out_size, ws_size, (size_t)WS_END); grid = -1; return; }
        int dev = 0, cus = 0, per_cu = 0;
        hipGetDevice(&dev); hipDeviceGetAttribute(&cus, hipDeviceAttributeMultiprocessorCount, dev);
        if (hipFuncSetAttribute((const void*)fwd_mega, hipFuncAttributeMaxDynamicSharedMemorySize, LDS_BYTES) != hipSuccess) { fprintf(stderr, "kernel_launch: hipFuncSetAttribute failed\n"); grid = -1; return; }
        hipOccupancyMaxActiveBlocksPerMultiprocessor(&per_cu, (const void*)fwd_mega, NTHR, LDS_BYTES);
        (void)hipGetLastError();
        if (per_cu < 1) { fprintf(stderr, "kernel_launch: occupancy query says %d blocks/CU\n", per_cu); }
        if (cus < 256) { fprintf(stderr, "kernel_launch: needs 256 CUs, device has %d\n", cus); grid = -1; return; }
        grid = 256;
    }
    if (grid < 0) return;
    Params p{};
    for (int i = 0; i < 37; ++i) p.in[i] = (const float*)d_in[i];
    p.out = (float*)d_out; p.ws = (unsigned char*)d_ws;
    void* args[] = {&p};
    hipError_t e = hipLaunchCooperativeKernel((const void*)fwd_mega, dim3(grid), dim3(NTHR), args, LDS_BYTES, stream);
    if (e != hipSuccess) fprintf(stderr, "cooperative launch failed: %s (grid %d)\n", hipGetErrorString(e), grid);
}
```

```cpp
#include <hip/hip_runtime.h>
#include <hip/hip_cooperative_groups.h>
#include <cstdio>
#include <cstdint>
namespace cg = cooperative_groups;
namespace pg8 {
#define PG8_LAS __attribute__((address_space(3)))
typedef unsigned short bf16_t;
typedef short bf16x8 __attribute__((ext_vector_type(8)));
typedef float f32x4 __attribute__((ext_vector_type(4)));
typedef unsigned u32x4 __attribute__((ext_vector_type(4)));
constexpr int BM = 256, BK = 64, HALF = 128, HTB = HALF * BK * 2  , STAGE_BYTES = 8 * HTB, NXCD = 8, WGM = 8;

__host__ __device__ __forceinline__ int lds_byte(int r, int c) { const int st = (r >> 4) * 2 + (c >> 5), rr = r & 15, cc = c & 31, ob = rr * 64 + cc * 2; return st * 1024 + (ob ^ (((ob >> 9) & 1) << 5)); }
__host__ __device__ __forceinline__ void stage_rc(int b, int& R, int& C) { const int st = b / 1024, sb = b % 1024, swz = sb ^ (((sb >> 9) & 1) << 5); R = (st >> 1) * 16 + swz / 64; C = (st & 1) * 32 + (swz % 64) / 2; }
__host__ __device__ __forceinline__ int perm32(int rho) { const int n = rho >> 4, i = rho & 15; return 8 * (i >> 2) + 4 * n + (i & 3); }

struct Unit { int pm, pn; };
struct Gemm { const bf16_t* A; const bf16_t* Bt; int M, N, K; };

struct StaticOrder {
    int nM, nN, nwg, G, c;
    __host__ __device__ void init(int M, int N, int G_, int c_) { nM = M / BM; nN = N / BM; nwg = nM * nN; G = G_; c = c_; }
    __host__ __device__ bool next(int i, Unit& u) const {
        const long L = (long)i * G + c; if (L >= nwg) return false;
        int wgid = (int)L; { const int q = nwg / NXCD, r = nwg % NXCD, xcd = wgid % NXCD, off = wgid / NXCD; wgid = (xcd < r ? xcd * (q + 1) : r * (q + 1) + (xcd - r) * q) + off; }
        const int nig = WGM * nN, gid = wgid / nig, fm = gid * WGM, gsz = (nM - fm) < WGM ? (nM - fm) : WGM;
        u.pm = fm + ((wgid % nig) % gsz); u.pn = (wgid % nig) / gsz; return true;
    }
    __device__ __forceinline__ void a_ready(const Unit&) const {}
    __device__ __forceinline__ void done(const Unit&) const {}
};

__device__ __forceinline__ unsigned cvt_pk_bf16(float lo, float hi) { unsigned r; asm volatile("v_cvt_pk_bf16_f32 %0, %1, %2" : "=v"(r) : "v"(lo), "v"(hi)); return r; }
typedef float f32x2 __attribute__((ext_vector_type(2)));
typedef unsigned u32x2 __attribute__((ext_vector_type(2)));
__device__ __forceinline__ float fast_sigmoid(float x) { return __builtin_amdgcn_rcpf(1.0f + __expf(-x)); }
__device__ __forceinline__ float bf_lo(unsigned w) { return __uint_as_float(w << 16); }
__device__ __forceinline__ float bf_hi(unsigned w) { return __uint_as_float(w & 0xffff0000u); }
struct EpiBf16 {
    static constexpr bool PERM = true, AFTER_DRAIN = false;
    bf16_t* O; int ldc;
    __device__ __forceinline__ void operator()(const f32x4 (&acc)[2][2][4][2], const Unit& u, int wr, int wc, int fr, int fq) const {
        const int row0 = u.pm * BM + wr * 64 + fr; const int col0 = u.pn * BM + wc * 32 + 8 * fq;
#pragma unroll
        for (int ai = 0; ai < 2; ++ai)
#pragma unroll
            for (int m = 0; m < 4; ++m) { bf16_t* rowp = O + (size_t)(row0 + ai * HALF + m * 16) * ldc + col0;
#pragma unroll
                for (int bj = 0; bj < 2; ++bj) { const f32x4 v0 = acc[ai][bj][m][0], v1 = acc[ai][bj][m][1];
                    u32x4 w; w.x = cvt_pk_bf16(v0[0], v0[1]); w.y = cvt_pk_bf16(v0[2], v0[3]); w.z = cvt_pk_bf16(v1[0], v1[1]); w.w = cvt_pk_bf16(v1[2], v1[3]);
                    *(u32x4*)(rowp + bj * HALF) = w; } }
    }
};
struct EpiSwiGLU {
    static constexpr bool PERM = true, AFTER_DRAIN = false;
    bf16_t* O; int ldc;
    __device__ __forceinline__ void operator()(const f32x4 (&acc)[2][2][4][2], const Unit& u, int wr, int wc, int fr, int fq) const {
        const int row0 = u.pm * BM + wr * 64 + fr; const int col0 = u.pn * HALF + wc * 32 + 8 * fq;
#pragma unroll
        for (int ai = 0; ai < 2; ++ai)
#pragma unroll
            for (int m = 0; m < 4; ++m) { bf16_t* rowp = O + (size_t)(row0 + ai * HALF + m * 16) * ldc + col0;
                float r[8];
#pragma unroll
                for (int n = 0; n < 2; ++n)
#pragma unroll
                    for (int j = 0; j < 4; ++j) { const float g = acc[ai][0][m][n][j], up = acc[ai][1][m][n][j]; r[n * 4 + j] = g * fast_sigmoid(g) * up; }
                u32x4 w; w.x = cvt_pk_bf16(r[0], r[1]); w.y = cvt_pk_bf16(r[2], r[3]); w.z = cvt_pk_bf16(r[4], r[5]); w.w = cvt_pk_bf16(r[6], r[7]);
                *(u32x4*)rowp = w; }
    }
};
struct EpiF32 {
    static constexpr bool PERM = false, AFTER_DRAIN = false;
    float* O; int ldc;
    __device__ __forceinline__ void operator()(const f32x4 (&acc)[2][2][4][2], const Unit& u, int wr, int wc, int fr, int fq) const {
        const int row0 = u.pm * BM + wr * 64 + fr; const int col0 = u.pn * BM + wc * 32 + 4 * fq;
#pragma unroll
        for (int ai = 0; ai < 2; ++ai)
#pragma unroll
            for (int m = 0; m < 4; ++m) { float* rowp = O + (size_t)(row0 + ai * HALF + m * 16) * ldc + col0;
#pragma unroll
                for (int bj = 0; bj < 2; ++bj)
#pragma unroll
                    for (int n = 0; n < 2; ++n) *(f32x4*)(rowp + bj * HALF + n * 16) = acc[ai][bj][m][n]; }
    }
};
template <int MODE> struct EpiMerge {
    static constexpr bool PERM = false, AFTER_DRAIN = false;
    float* F; bf16_t* B; const bf16_t* G; int ldg;
    __device__ __forceinline__ void operator()(const f32x4 (&acc)[2][2][4][2], const Unit& u, int wr, int wc, int fr, int fq) const {
        const int row0 = u.pm * BM + wr * 64 + fr; const int col0 = u.pn * BM + wc * 32 + 4 * fq;
#pragma unroll
        for (int ai = 0; ai < 2; ++ai)
#pragma unroll
            for (int m = 0; m < 4; ++m) { const size_t row = (size_t)(row0 + ai * HALF + m * 16);
#pragma unroll
                for (int bj = 0; bj < 2; ++bj)
#pragma unroll
                    for (int n = 0; n < 2; ++n) { const int c = col0 + bj * HALF + n * 16;
                        const u32x2 gw = *(const u32x2*)(G + row * ldg + c);
                        f32x4 s; s[0] = fast_sigmoid(bf_lo(gw.x)); s[1] = fast_sigmoid(bf_hi(gw.x)); s[2] = fast_sigmoid(bf_lo(gw.y)); s[3] = fast_sigmoid(bf_hi(gw.y));
                        f32x4 v = s * acc[ai][bj][m][n];
                        float* fp = F + row * 1024 + c;
                        if (MODE >= 1) v += *(const f32x4*)fp;
                        if (MODE <= 1) *(f32x4*)fp = v;
                        else { u32x2 w; w.x = cvt_pk_bf16(v[0], v[1]); w.y = cvt_pk_bf16(v[2], v[3]); *(u32x2*)(B + row * 1024 + c) = w; } } }
    }
};
template <class Epi, class Sched, bool ALIGN_EPI = false, bool SP2 = false>
__device__ __forceinline__ void gemm_phase(PG8_LAS unsigned char* lds, const Gemm g, const Sched& S, const Epi& E, const int tid) {
    const int wid = __builtin_amdgcn_readfirstlane(tid >> 6), lane = tid & 63, wr = wid >> 2, wc = wid & 3, fr = lane & 15, fq = lane >> 4;
    const int K = g.K, nt = K / BK;
    unsigned voffA[2], voffB[2];
#pragma unroll
    for (int i = 0; i < 2; ++i) { int R, C; stage_rc(tid * 16 + i * 8192, R, C); const int Rb = Epi::PERM ? ((R & ~31) + perm32(R & 31)) : R;
        voffA[i] = (unsigned)(R * K + C) * 2u; voffB[i] = (unsigned)(Rb * K + C) * 2u; }
    const size_t kstep = (size_t)(BK * 2);
    const size_t hstep = (size_t)HALF * K * 2;
    const size_t tstep = 2 * hstep;
    const unsigned ldsw = (unsigned)wid * 1024u;
    const int aoff = lds_byte(wr * 64 + fr, fq * 8), boff = lds_byte(wc * 32 + fr, fq * 8);
#define PG8_SA(b, h) (((b) * 2 + (h)) * HTB)
#define PG8_SB(b, h) ((4 + (b) * 2 + (h)) * HTB)
#define PG8_STAGE(bufoff, gbase, voff) do { _Pragma("unroll") for (int _i = 0; _i < 2; ++_i) \
        __builtin_amdgcn_global_load_lds((const unsigned*)((const char*)(gbase) + (voff)[_i]), (PG8_LAS unsigned*)(lds + (bufoff) + ldsw + _i * 8192), 16, 0, 0); } while (0)
#define PG8_LDA(dst, b, h) do { _Pragma("unroll") for (int m = 0; m < 4; ++m) _Pragma("unroll") for (int k = 0; k < 2; ++k) dst[m][k] = *(const PG8_LAS bf16x8*)(lds + PG8_SA(b, h) + aoff + m * 2048 + k * 1024); } while (0)
#define PG8_LDB(dst, b, h) do { _Pragma("unroll") for (int n = 0; n < 2; ++n) _Pragma("unroll") for (int k = 0; k < 2; ++k) dst[n][k] = *(const PG8_LAS bf16x8*)(lds + PG8_SB(b, h) + boff + n * 2048 + k * 1024); } while (0)
#define PG8_MMA(ai, bj, At, Bt) do { __builtin_amdgcn_s_setprio(1); _Pragma("unroll") for (int m = 0; m < 4; ++m) _Pragma("unroll") for (int n = 0; n < 2; ++n) _Pragma("unroll") for (int k = 0; k < 2; ++k) \
        acc[ai][bj][m][n] = __builtin_amdgcn_mfma_f32_16x16x32_bf16(Bt[n][k], At[m][k], acc[ai][bj][m][n], 0, 0, 0); __builtin_amdgcn_s_setprio(0); } while (0)
#define PG8_WAIT_V(n) asm volatile("s_waitcnt vmcnt(" #n ")" ::: "memory")
#define PG8_WAIT_L(n) asm volatile("s_waitcnt lgkmcnt(" #n ")" ::: "memory")
#define PG8_BAR __builtin_amdgcn_s_barrier()
#define PG8_SCHED __builtin_amdgcn_sched_barrier(0)
    Unit cur, nxt; int ui = 0;
    if (!S.next(0, cur)) return;
    f32x4 acc[2][2][4][2];
#pragma unroll
    for (int a = 0; a < 2; ++a)
#pragma unroll
        for (int b = 0; b < 2; ++b)
#pragma unroll
            for (int m = 0; m < 4; ++m)
#pragma unroll
                for (int n = 0; n < 2; ++n) acc[a][b][m][n] = (f32x4){0.f, 0.f, 0.f, 0.f};
    bf16x8 At[4][2], B0[2][2], B1[2][2];
    const char* cA = (const char*)g.A + (size_t)cur.pm * tstep; const char* cB = (const char*)g.Bt + (size_t)cur.pn * tstep;
    S.a_ready(cur);
    if constexpr (SP2) {
        PG8_STAGE(PG8_SB(0, 0), cB, voffB); PG8_STAGE(PG8_SB(0, 1), cB + hstep, voffB); PG8_STAGE(PG8_SA(0, 0), cA, voffA); PG8_STAGE(PG8_SA(0, 1), cA + hstep, voffA);
        if (wr == 1) PG8_BAR;
        PG8_WAIT_V(2); PG8_BAR;
        PG8_STAGE(PG8_SB(1, 0), cB + kstep, voffB); PG8_STAGE(PG8_SA(1, 0), cA + kstep, voffA); PG8_STAGE(PG8_SB(1, 1), cB + hstep + kstep, voffB);
        PG8_WAIT_V(6); PG8_BAR;
    } else {
        PG8_STAGE(PG8_SB(0, 0), cB, voffB); PG8_STAGE(PG8_SA(0, 0), cA, voffA); PG8_STAGE(PG8_SB(0, 1), cB + hstep, voffB); PG8_STAGE(PG8_SA(0, 1), cA + hstep, voffA);
        if (wr == 1) PG8_BAR;
        PG8_WAIT_V(4); PG8_BAR;
        PG8_STAGE(PG8_SB(1, 0), cB + kstep, voffB); PG8_STAGE(PG8_SA(1, 0), cA + kstep, voffA); PG8_STAGE(PG8_SB(1, 1), cB + hstep + kstep, voffB);
        PG8_WAIT_V(6); PG8_BAR;
    }
    for (;;) {
        const bool has_next = S.next(ui + 1, nxt);
        const char* nA = has_next ? (const char*)g.A + (size_t)nxt.pm * tstep : cA; const char* nB = has_next ? (const char*)g.Bt + (size_t)nxt.pn * tstep : cB;
        for (int t = 0; t < nt; t += 2) {
            const bool last = (t == nt - 2);
            const char* a1 = cA + (size_t)(t + 1) * kstep;
            const char* a2 = last ? nA : cA + (size_t)(t + 2) * kstep; const char* b2 = last ? nB : cB + (size_t)(t + 2) * kstep;
            const char* a3 = a2 + kstep; const char* b3 = b2 + kstep;
            if (last && has_next) S.a_ready(nxt);
            if constexpr (SP2) {
            PG8_LDB(B0, 0, 0); PG8_LDB(B1, 0, 1); PG8_SCHED; PG8_LDA(At, 0, 0); PG8_STAGE(PG8_SA(1, 1), a1 + hstep, voffA);
            PG8_WAIT_V(8); PG8_WAIT_L(0); PG8_BAR; PG8_MMA(0, 0, At, B0); PG8_MMA(0, 1, At, B1); PG8_BAR; PG8_SCHED;
            PG8_LDA(At, 0, 1); PG8_STAGE(PG8_SB(0, 0), b2, voffB); PG8_STAGE(PG8_SB(0, 1), b2 + hstep, voffB); PG8_STAGE(PG8_SA(0, 0), a2, voffA);
            PG8_WAIT_V(8); PG8_WAIT_L(0); PG8_BAR; PG8_MMA(1, 0, At, B0); PG8_MMA(1, 1, At, B1); PG8_BAR; PG8_SCHED;
            PG8_LDB(B0, 1, 0); PG8_LDB(B1, 1, 1); PG8_SCHED; PG8_LDA(At, 1, 0); PG8_STAGE(PG8_SA(0, 1), a2 + hstep, voffA);
            PG8_WAIT_V(8); PG8_WAIT_L(0); PG8_BAR; PG8_MMA(0, 0, At, B0); PG8_MMA(0, 1, At, B1); PG8_BAR; PG8_SCHED;
            PG8_LDA(At, 1, 1); PG8_STAGE(PG8_SB(1, 0), b3, voffB); PG8_STAGE(PG8_SB(1, 1), b3 + hstep, voffB); PG8_STAGE(PG8_SA(1, 0), a3, voffA);
            PG8_WAIT_V(8); PG8_WAIT_L(0); PG8_BAR; PG8_MMA(1, 0, At, B0); PG8_MMA(1, 1, At, B1); PG8_BAR; PG8_SCHED;
            } else {
            PG8_LDB(B0, 0, 0); PG8_SCHED; PG8_LDA(At, 0, 0); PG8_STAGE(PG8_SA(1, 1), a1 + hstep, voffA);
            PG8_WAIT_L(8); PG8_BAR; PG8_WAIT_L(0); PG8_MMA(0, 0, At, B0); PG8_BAR; PG8_SCHED;
            PG8_LDB(B1, 0, 1); PG8_STAGE(PG8_SB(0, 0), b2, voffB);
            PG8_BAR; PG8_WAIT_L(0); PG8_MMA(0, 1, At, B1); PG8_BAR;
            PG8_LDA(At, 0, 1); PG8_STAGE(PG8_SA(0, 0), a2, voffA);
            PG8_BAR; PG8_WAIT_L(0); PG8_MMA(1, 0, At, B0); PG8_BAR; PG8_SCHED;
            PG8_STAGE(PG8_SB(0, 1), b2 + hstep, voffB);
            PG8_WAIT_V(6); PG8_BAR; PG8_MMA(1, 1, At, B1); PG8_BAR;
            PG8_LDB(B0, 1, 0); PG8_SCHED; PG8_LDA(At, 1, 0); PG8_STAGE(PG8_SA(0, 1), a2 + hstep, voffA);
            PG8_WAIT_L(8); PG8_BAR; PG8_WAIT_L(0); PG8_MMA(0, 0, At, B0); PG8_BAR; PG8_SCHED;
            PG8_LDB(B1, 1, 1); PG8_STAGE(PG8_SB(1, 0), b3, voffB);
            PG8_BAR; PG8_WAIT_L(0); PG8_MMA(0, 1, At, B1); PG8_BAR;
            PG8_LDA(At, 1, 1); PG8_STAGE(PG8_SA(1, 0), a3, voffA);
            PG8_BAR; PG8_WAIT_L(0); PG8_MMA(1, 0, At, B0); PG8_BAR; PG8_SCHED;
            PG8_STAGE(PG8_SB(1, 1), b3 + hstep, voffB);
            PG8_WAIT_V(6); PG8_BAR; PG8_MMA(1, 1, At, B1); PG8_BAR;
            }
        }
        if constexpr (ALIGN_EPI) { if (wr == 0) PG8_BAR; }
        if constexpr (!Epi::AFTER_DRAIN) { int l2_; asm volatile("v_mbcnt_lo_u32_b32 %0, -1, 0\n\tv_mbcnt_hi_u32_b32 %0, -1, %0" : "=v"(l2_)); E(acc, cur, wr, wc, l2_ & 15, l2_ >> 4); S.done(cur); }
        if (!has_next) break;
#pragma unroll
        for (int a = 0; a < 2; ++a)
#pragma unroll
            for (int b = 0; b < 2; ++b)
#pragma unroll
                for (int m = 0; m < 4; ++m)
#pragma unroll
                    for (int n = 0; n < 2; ++n) acc[a][b][m][n] = (f32x4){0.f, 0.f, 0.f, 0.f};
        cur = nxt; cA = nA; cB = nB; ++ui;
        if constexpr (ALIGN_EPI) { if (wr == 1) PG8_BAR; }
    }
    PG8_WAIT_V(0);
    if constexpr (!ALIGN_EPI) { if (wr == 0) PG8_BAR; }
    PG8_BAR;
    if constexpr (Epi::AFTER_DRAIN) { E.fused(acc, cur, wr, wc, fr, fq, lds, wid, lane); S.done(cur); }
#undef PG8_SA
#undef PG8_SB
#undef PG8_STAGE
#undef PG8_LDA
#undef PG8_LDB
#undef PG8_MMA
#undef PG8_WAIT_V
#undef PG8_WAIT_L
#undef PG8_BAR
#undef PG8_SCHED
}
}
#ifndef REP_GU
#define REP_GU 1
#endif
#ifndef REP_DOWN
#define REP_DOWN 1
#endif
#ifndef REP_IN
#define REP_IN 1
#endif
#ifndef REP_MERGE
#define REP_MERGE 1
#endif
#ifndef REP_SQ
#define REP_SQ 1
#endif
#ifndef REP_S5A
#define REP_S5A 1
#endif
#ifndef REP_GLAA
#define REP_GLAA 1
#endif
#ifndef REP_FOX
#define REP_FOX 1
#endif
#ifndef REP_S5C
#define REP_S5C 1
#endif
#ifndef REP_GLAC
#define REP_GLAC 1
#endif
#ifndef REP_MIXA
#define REP_MIXA 1
#endif
#ifndef REP_MIXC
#define REP_MIXC 1
#endif
#ifndef REP_XA
#define REP_XA 1
#endif
#ifndef REP_CONV
#define REP_CONV 1
#endif
#ifndef REP_ROW
#define REP_ROW 0
#endif
#ifndef EN_S5A
#define EN_S5A 1
#endif
#ifndef EN_GLAA
#define EN_GLAA 1
#endif
#ifndef EN_FOX
#define EN_FOX 1
#endif
#ifndef EN_S5C
#define EN_S5C 1
#endif
#ifndef EN_GLAC
#define EN_GLAC 1
#endif
#ifndef EN_XA
#define EN_XA 1
#endif
#ifndef EN_CONV
#define EN_CONV 1
#endif
typedef unsigned short bf16;
typedef unsigned v4u __attribute__((ext_vector_type(4)));
typedef unsigned v2u __attribute__((ext_vector_type(2)));
typedef float f32x4 __attribute__((ext_vector_type(4)));
typedef short bf16x8 __attribute__((ext_vector_type(8)));
#define LAS __attribute__((address_space(3)))

constexpr int MTOK = 16384, DM = 1024, SEQ = 2048, NB = 8, DFF = 2816, NMEM = 256, MMEM = NB * NMEM, DEPTH = 4;
constexpr int LDP = 5888, D_IN = 5656;
constexpr int PC_GQ = 0, PC_GK = 128, PC_GV = 256, PC_GR = 512, PC_SU = 768, PC_FQ = 1024, PC_FK = 1536, PC_FV = 2048, PC_GD = 2560, PC_FF = 2576, PC_GATE = 2816;
constexpr float EPS = 1e-6f;
constexpr int NTHR = 512, NWAVES = 8;
constexpr int LDS_BYTES = 147456;

constexpr size_t WO_GU1 = 0, WO_DOWN1 = WO_GU1 + (size_t)5632 * 1024, WO_IN = WO_DOWN1 + (size_t)1024 * 2816, WO_GLAUP = WO_IN + (size_t)5888 * 1024, WO_S5UP = WO_GLAUP + 1024 * 256,
                 WO_FOXUP = WO_S5UP + 1024 * 256, WO_GLU = WO_FOXUP + 1024 * 512, WO_MIXOUT = WO_GLU + 256 * 256, WO_Q = WO_MIXOUT + 1024 * 1024, WO_KV = WO_Q + 1024 * 1024,
                 WO_O = WO_KV + 2048 * 1024, WO_GU2 = WO_O + 1024 * 1024, WO_DOWN2 = WO_GU2 + (size_t)5632 * 1024, WO_END = WO_DOWN2 + (size_t)1024 * 2816;
constexpr size_t MiB = (size_t)1 << 20;
constexpr size_t WS_W = 1 * MiB, WS_P = 64 * MiB, WS_H = 248 * MiB, WS_Y = 280 * MiB, WS_BRG = 344 * MiB, WS_BRS = 352 * MiB, WS_BRF = 360 * MiB, WS_MIXB = 376 * MiB,
                 WS_Q = 344 * MiB, WS_XO = 376 * MiB, WS_KV = 408 * MiB, WS_MEMN = 416 * MiB, WS_DS = 420 * MiB, WS_DEC = 428 * MiB, WS_S5L = 429 * MiB, WS_S5P = 431 * MiB, WS_END = 432 * MiB;
static_assert(WS_W + WO_END * 2 <= WS_P, "weights fit");
static_assert(WS_P + (size_t)MTOK * LDP * 2 <= WS_H, "P fits");
constexpr size_t S5P_ABAR = 0, S5P_A64 = 8192, S5P_BBAR = 16384, S5P_CMAT = 16384 + 131072;

struct Params { const float* in[37]; float* out; unsigned char* ws; };

__device__ __forceinline__ unsigned f2bf(float f) { unsigned u = __builtin_bit_cast(unsigned, f); return (u + 0x7fffu + ((u >> 16) & 1u)) >> 16; }
__device__ __forceinline__ unsigned pk2(float lo, float hi) { return f2bf(lo) | (f2bf(hi) << 16); }
__device__ __forceinline__ float bf2f(unsigned h) { return __uint_as_float(h << 16); }
__device__ __forceinline__ float bflo(unsigned w) { return __uint_as_float(w << 16); }
__device__ __forceinline__ float bfhi(unsigned w) { return __uint_as_float(w & 0xffff0000u); }
#define LDS_WAIT() asm volatile("s_waitcnt lgkmcnt(0)" ::: "memory")
__device__ __forceinline__ float wave_sum(float v) {
#pragma unroll
    for (int o = 1; o < 64; o <<= 1) v += __shfl_xor(v, o);
    return v;
}
__device__ __forceinline__ float logsig(float z) { return fminf(z, 0.f) - logf(1.0f + expf(-fabsf(z))); }
__device__ __forceinline__ float sigmoidf_(float x) { return 1.0f / (1.0f + __expf(-x)); }
__device__ __forceinline__ float gelu_tanh(float x) { const float z = 0.7978845608028654f * (x + 0.044715f * x * x * x); const float t = 1.0f - 2.0f / (__expf(2.0f * z) + 1.0f); return 0.5f * x * (1.0f + t); }

__device__ __forceinline__ int srccol(int kind, int j) {
    if (kind == 0) return j;
    if (kind == 1) { const int pn = j >> 8, r = j & 255; return r < 128 ? 128 * pn + r : 2816 + 128 * pn + (r - 128); }
    if (j < 768) return j;
    if (j < 1024) return 784 + (j - 768);
    if (j < 2560) return 1040 + (j - 1024);
    if (j < 2576) return 768 + (j - 2560);
    if (j < 2584) return 2576 + (j - 2576);
    if (j < 2816) return -1;
    return 2584 + (j - 2816);
}
__device__ __forceinline__ void transpose_item(const float* W, int K, int Nsrc, int Ndst, int kind, bf16* WT, float* scr, int item, int lane) {
    const int nblk = Ndst / 32, kb = item / nblk, nb = item % nblk, k0 = 64 * kb, n0 = 32 * nb;
    const int nn = 4 * (lane & 7), sc = srccol(kind, n0 + nn);
    f32x4 v[8];
#pragma unroll
    for (int i = 0; i < 8; ++i) { const int kk = 8 * i + (lane >> 3); v[i] = sc >= 0 ? *(const f32x4*)(W + (size_t)(k0 + kk) * Nsrc + sc) : (f32x4){0.f, 0.f, 0.f, 0.f}; }
#pragma unroll
    for (int i = 0; i < 8; ++i) { const int kk = 8 * i + (lane >> 3); float* d = scr + kk * 33 + nn; d[0] = v[i][0]; d[1] = v[i][1]; d[2] = v[i][2]; d[3] = v[i][3]; }
    LDS_WAIT();
    const int c = lane & 7;
#pragma unroll
    for (int j = 0; j < 4; ++j) { const int n = (lane >> 3) + 8 * j; const float* s = scr + (8 * c) * 33 + n;
        v4u o; o.x = pk2(s[0 * 33], s[1 * 33]); o.y = pk2(s[2 * 33], s[3 * 33]); o.z = pk2(s[4 * 33], s[5 * 33]); o.w = pk2(s[6 * 33], s[7 * 33]);
        *(v4u*)(WT + (size_t)(n0 + n) * K + k0 + 8 * c) = o; }
    LDS_WAIT();
}
struct ConvJob { int in_idx; int K, Nsrc, Ndst, kind; size_t wo; };
__device__ __forceinline__ void convert_weights(unsigned char* ws, const float* const* tab, int l, char* lds, int gw, int NGW, int wave, int lane) {
    float* scr = (float*)(lds + wave * 8448);
    bf16* Wb = (bf16*)(ws + WS_W);
    const int  jin[13]  = {3, 4, 7, 11, 22, 24, 20, 25, 29, 30, 31, 34, 35};
    const int  jK[13]   = {1024, 2816, 1024, 256, 256, 512, 256, 1024, 1024, 1024, 1024, 1024, 2816};
    const int  jNs[13]  = {5632, 1024, D_IN, 1024, 1024, 1024, 256, 1024, 1024, 2048, 1024, 5632, 1024};
    const int  jNd[13]  = {5632, 1024, 5888, 1024, 1024, 1024, 256, 1024, 1024, 2048, 1024, 5632, 1024};
    const int  jkind[13]= {1, 0, 2, 0, 0, 0, 0, 0, 0, 0, 0, 1, 0};
    const size_t jwo[13]= {WO_GU1, WO_DOWN1, WO_IN, WO_GLAUP, WO_S5UP, WO_FOXUP, WO_GLU, WO_MIXOUT, WO_Q, WO_KV, WO_O, WO_GU2, WO_DOWN2};
    int base = 0;
#pragma unroll
    for (int j = 0; j < 13; ++j) {
        const int K = jK[j], Ns = jNs[j], Nd = jNd[j];
        const int nitems = (K / 64) * (Nd / 32);
        const float* W = tab[jin[j]] + (size_t)l * K * Ns;
        int first = (gw - (base % NGW) + NGW) % NGW;
        for (int it = first; it < nitems; it += NGW) transpose_item(W, K, Ns, Nd, jkind[j], Wb + jwo[j], scr, it, lane);
        base += nitems;
    }
}
__device__ __forceinline__ void s5_prep(unsigned char* ws, const float* const* tab, int l, int gtid, int GT) {
    unsigned char* sp = ws + WS_S5P;
    float2* ABAR = (float2*)(sp + S5P_ABAR); float2* A64 = (float2*)(sp + S5P_A64); float2* BBAR = (float2*)(sp + S5P_BBAR); bf16* CMAT = (bf16*)(sp + S5P_CMAT);
    const float* a_re = tab[12] + l * 1024; const float* a_im = tab[13] + l * 1024; const float* log_dt = tab[14] + l * 16;
    const float* b_re = tab[15] + (size_t)l * 16384; const float* b_im = tab[16] + (size_t)l * 16384;
    const float* c_re = tab[17] + (size_t)l * 16384; const float* c_im = tab[18] + (size_t)l * 16384;
    for (int idx = gtid; idx < 1024; idx += GT) {
        const int g = idx >> 6;
        const float lre = fminf(a_re[idx], -1e-4f), lim = a_im[idx], dt = expf(log_dt[g]);
        const float mag = expf(lre * dt);
        float sn, cs; sincosf(lim * dt, &sn, &cs);
        const float abr = mag * cs, abi = mag * sn;
        const float den = lre * lre + lim * lim;
        const float zr = ((abr - 1.0f) * lre + abi * lim) / den, zi = (abi * lre - (abr - 1.0f) * lim) / den;
        ABAR[idx] = make_float2(abr, abi);
        float pr = abr, pi = abi;
#pragma unroll
        for (int s = 0; s < 6; ++s) { const float nr = pr * pr - pi * pi, ni = 2.0f * pr * pi; pr = nr; pi = ni; }
        A64[idx] = make_float2(pr, pi);
        for (int h = 0; h < 16; ++h) { const float br = b_re[idx * 16 + h], bi = b_im[idx * 16 + h]; BBAR[idx * 16 + h] = make_float2(zr * br - zi * bi, zr * bi + zi * br); }
    }
    for (int idx = gtid; idx < 32768; idx += GT) {
        const int j = idx & 7, ln = (idx >> 3) & 63, ks = (idx >> 9) & 3, g = idx >> 11;
        const int k = 32 * ks + 8 * (ln >> 4) + j, h = ln & 15;
        const float v = k < 64 ? c_re[(g * 16 + h) * 64 + k] : -c_im[(g * 16 + h) * 64 + (k - 64)];
        CMAT[idx] = (bf16)f2bf(v);
    }
}
template <bool HASY, bool HASX, bool HASH>
__device__ __forceinline__ void rowop(const float* xin, float* xout, const bf16* Y, const float* postg, float coef, const float* preg, bf16* H, int nrows, int gw, int NGW, int lane) {
    for (int m = gw; m < nrows; m += NGW) {
        const f32x4* xr = (const f32x4*)(xin + (size_t)m * DM) + lane;
        f32x4 v[4];
#pragma unroll
        for (int j = 0; j < 4; ++j) v[j] = xr[64 * j];
        if (HASY) {
            const v2u* yr = (const v2u*)(Y + (size_t)m * DM) + lane; f32x4 y[4]; float s = 0.f;
#pragma unroll
            for (int j = 0; j < 4; ++j) { const v2u w = yr[64 * j]; y[j] = (f32x4){bflo(w.x), bfhi(w.x), bflo(w.y), bfhi(w.y)}; s += (y[j].x * y[j].x + y[j].y * y[j].y) + (y[j].z * y[j].z + y[j].w * y[j].w); }
            const float r = coef / sqrtf(wave_sum(s) * (1.0f / DM) + EPS);
#pragma unroll
            for (int j = 0; j < 4; ++j) { const f32x4 g = ((const f32x4*)postg)[lane + 64 * j]; v[j] += y[j] * g * r; }
        }
        if (HASX) { f32x4* xo = (f32x4*)(xout + (size_t)m * DM) + lane;
#pragma unroll
            for (int j = 0; j < 4; ++j) xo[64 * j] = v[j]; }
        if (HASH) {
            float s2 = 0.f;
#pragma unroll
            for (int j = 0; j < 4; ++j) s2 += (v[j].x * v[j].x + v[j].y * v[j].y) + (v[j].z * v[j].z + v[j].w * v[j].w);
            const float r2 = 1.0f / sqrtf(wave_sum(s2) * (1.0f / DM) + EPS);
            v2u* ho = (v2u*)(H + (size_t)m * DM) + lane;
#pragma unroll
            for (int j = 0; j < 4; ++j) { const f32x4 g = ((const f32x4*)preg)[lane + 64 * j]; v2u w; w.x = pk2(v[j].x * r2 * g.x, v[j].y * r2 * g.y); w.y = pk2(v[j].z * r2 * g.z, v[j].w * r2 * g.w); ho[64 * j] = w; }
        }
    }
}
template <int DH, bool FOX>
__device__ __forceinline__ void attn_unit(char* lds, const bf16* Qp, int ldq, const bf16* Kp, int ldk, const bf16* Vp, int ldv, bf16* Op, int ldo,
                                          int qpos0, int nkt, int mask_from, const float* Fc, float scale, int tid) {
    constexpr int KS = DH + 8, VS = 72, NPASS = DH / 64, CPR = DH / 8;
    bf16* Ks = (bf16*)lds; bf16* Vt = Ks + 64 * KS;
    const int lane = tid & 63, wave = tid >> 6, li = lane & 15, qd = lane >> 4;
    bf16x8 qf[DH / 32];
    { const bf16* qrow = Qp + (size_t)(wave * 16 + li) * ldq;
#pragma unroll
      for (int ks = 0; ks < DH / 32; ++ks) { const v4u w = *(const v4u*)(qrow + 32 * ks + 8 * qd); const float qs = scale * 1.4426950408889634f;
          v4u o; o.x = pk2(bflo(w.x) * qs, bfhi(w.x) * qs); o.y = pk2(bflo(w.y) * qs, bfhi(w.y) * qs); o.z = pk2(bflo(w.z) * qs, bfhi(w.z) * qs); o.w = pk2(bflo(w.w) * qs, bfhi(w.w) * qs);
          qf[ks] = __builtin_bit_cast(bf16x8, o); } }
    const int qpos = qpos0 + wave * 16 + li;
    f32x4 oacc[DH / 16];
#pragma unroll
    for (int i = 0; i < DH / 16; ++i) oacc[i] = (f32x4){0.f, 0.f, 0.f, 0.f};
    float mrun = -INFINITY, lsum = 0.f;
    v4u kregA[NPASS], vregA[NPASS], kregB[NPASS], vregB[NPASS];
#define ATTN_PREFETCH(KR, VR, T) do { if ((T) < nkt) { _Pragma("unroll") for (int ps = 0; ps < NPASS; ++ps) { const int c = tid + NTHR * ps, key = (T) * 64 + c / CPR, dc = c % CPR; \
        KR[ps] = *(const v4u*)(Kp + (size_t)key * ldk + dc * 8); VR[ps] = *(const v4u*)(Vp + (size_t)key * ldv + dc * 8); } } } while (0)
    constexpr int PD = (DH == 64) ? 2 : 1;
    auto& kreg2 = *(PD == 2 ? &kregB : &kregA); auto& vreg2 = *(PD == 2 ? &vregB : &vregA);
    ATTN_PREFETCH(kregA, vregA, 0);
    if (PD == 2) ATTN_PREFETCH(kregB, vregB, 1);
    for (int kt2 = 0; kt2 < nkt; kt2 += 2) {
#define KR kregA
#define VR vregA
      { const int kt = kt2;
        __syncthreads();
#pragma unroll
        for (int ps = 0; ps < NPASS; ++ps) { const int c = tid + NTHR * ps, key = c / CPR, dc = c % CPR;
            *(v4u*)(Ks + key * KS + dc * 8) = KR[ps];
            const v4u vv = VR[ps];
            bf16* vt = Vt + (dc * 8) * VS + key;
            vt[0 * VS] = (bf16)(vv.x & 0xffffu); vt[1 * VS] = (bf16)(vv.x >> 16); vt[2 * VS] = (bf16)(vv.y & 0xffffu); vt[3 * VS] = (bf16)(vv.y >> 16);
            vt[4 * VS] = (bf16)(vv.z & 0xffffu); vt[5 * VS] = (bf16)(vv.z >> 16); vt[6 * VS] = (bf16)(vv.w & 0xffffu); vt[7 * VS] = (bf16)(vv.w >> 16); }
        __syncthreads();
        ATTN_PREFETCH(KR, VR, kt + PD);
        f32x4 s[4];
#pragma unroll
        for (int kb = 0; kb < 4; ++kb) { s[kb] = FOX ? *(const f32x4*)(Fc + kt * 64 + 16 * kb + 4 * qd) : (f32x4){0.f, 0.f, 0.f, 0.f};
#pragma unroll
            for (int ks = 0; ks < DH / 32; ++ks) { const bf16x8 a = *(const bf16x8*)(Ks + (16 * kb + li) * KS + 32 * ks + 8 * qd); s[kb] = __builtin_amdgcn_mfma_f32_16x16x32_bf16(a, qf[ks], s[kb], 0, 0, 0); } }
        float tmax = -INFINITY;
#pragma unroll
        for (int kb = 0; kb < 4; ++kb)
#pragma unroll
            for (int i = 0; i < 4; ++i) { float v = s[kb][i];
                if (FOX && kt >= mask_from) { const int key = kt * 64 + 16 * kb + 4 * qd + i; if (key > qpos) v = -INFINITY; s[kb][i] = v; }
                tmax = fmaxf(tmax, v); }
        tmax = fmaxf(tmax, __shfl_xor(tmax, 16)); tmax = fmaxf(tmax, __shfl_xor(tmax, 32));
        const float mnew = fmaxf(mrun, tmax);
        const float alpha = __builtin_amdgcn_exp2f(mrun - mnew);
        mrun = mnew;
        float psum = 0.f;
#pragma unroll
        for (int kb = 0; kb < 4; ++kb)
#pragma unroll
            for (int i = 0; i < 4; ++i) { const float e = __builtin_amdgcn_exp2f(s[kb][i] - mnew); s[kb][i] = e; psum += e; }
        lsum = lsum * alpha + psum;
#pragma unroll
        for (int i = 0; i < DH / 16; ++i) oacc[i] *= alpha;
        bf16x8 pf[2];
#pragma unroll
        for (int kk = 0; kk < 2; ++kk) { v4u w; w.x = pk2(s[2 * kk][0], s[2 * kk][1]); w.y = pk2(s[2 * kk][2], s[2 * kk][3]); w.z = pk2(s[2 * kk + 1][0], s[2 * kk + 1][1]); w.w = pk2(s[2 * kk + 1][2], s[2 * kk + 1][3]);
            pf[kk] = __builtin_bit_cast(bf16x8, w); }
#pragma unroll
        for (int db = 0; db < DH / 16; ++db)
#pragma unroll
            for (int kk = 0; kk < 2; ++kk) { const bf16* vp = Vt + (16 * db + li) * VS + 32 * kk + 4 * qd;
                const v2u lo = *(const v2u*)vp, hi = *(const v2u*)(vp + 16);
                v4u w; w.x = lo.x; w.y = lo.y; w.z = hi.x; w.w = hi.y;
                oacc[db] = __builtin_amdgcn_mfma_f32_16x16x32_bf16(__builtin_bit_cast(bf16x8, w), pf[kk], oacc[db], 0, 0, 0); }
      }
#undef KR
#undef VR
#define KR kreg2
#define VR vreg2
      { const int kt = kt2 + 1;
        __syncthreads();
#pragma unroll
        for (int ps = 0; ps < NPASS; ++ps) { const int c = tid + NTHR * ps, key = c / CPR, dc = c % CPR;
            *(v4u*)(Ks + key * KS + dc * 8) = KR[ps];
            const v4u vv = VR[ps];
            bf16* vt = Vt + (dc * 8) * VS + key;
            vt[0 * VS] = (bf16)(vv.x & 0xffffu); vt[1 * VS] = (bf16)(vv.x >> 16); vt[2 * VS] = (bf16)(vv.y & 0xffffu); vt[3 * VS] = (bf16)(vv.y >> 16);
            vt[4 * VS] = (bf16)(vv.z & 0xffffu); vt[5 * VS] = (bf16)(vv.z >> 16); vt[6 * VS] = (bf16)(vv.w & 0xffffu); vt[7 * VS] = (bf16)(vv.w >> 16); }
        __syncthreads();
        ATTN_PREFETCH(KR, VR, kt + PD);
        f32x4 s[4];
#pragma unroll
        for (int kb = 0; kb < 4; ++kb) { s[kb] = FOX ? *(const f32x4*)(Fc + kt * 64 + 16 * kb + 4 * qd) : (f32x4){0.f, 0.f, 0.f, 0.f};
#pragma unroll
            for (int ks = 0; ks < DH / 32; ++ks) { const bf16x8 a = *(const bf16x8*)(Ks + (16 * kb + li) * KS + 32 * ks + 8 * qd); s[kb] = __builtin_amdgcn_mfma_f32_16x16x32_bf16(a, qf[ks], s[kb], 0, 0, 0); } }
        float tmax = -INFINITY;
#pragma unroll
        for (int kb = 0; kb < 4; ++kb)
#pragma unroll
            for (int i = 0; i < 4; ++i) { float v = s[kb][i];
                if (FOX && kt >= mask_from) { const int key = kt * 64 + 16 * kb + 4 * qd + i; if (key > qpos) v = -INFINITY; s[kb][i] = v; }
                tmax = fmaxf(tmax, v); }
        tmax = fmaxf(tmax, __shfl_xor(tmax, 16)); tmax = fmaxf(tmax, __shfl_xor(tmax, 32));
        const float mnew = fmaxf(mrun, tmax);
        const float alpha = __builtin_amdgcn_exp2f(mrun - mnew);
        mrun = mnew;
        float psum = 0.f;
#pragma unroll
        for (int kb = 0; kb < 4; ++kb)
#pragma unroll
            for (int i = 0; i < 4; ++i) { const float e = __builtin_amdgcn_exp2f(s[kb][i] - mnew); s[kb][i] = e; psum += e; }
        lsum = lsum * alpha + psum;
#pragma unroll
        for (int i = 0; i < DH / 16; ++i) oacc[i] *= alpha;
        bf16x8 pf[2];
#pragma unroll
        for (int kk = 0; kk < 2; ++kk) { v4u w; w.x = pk2(s[2 * kk][0], s[2 * kk][1]); w.y = pk2(s[2 * kk][2], s[2 * kk][3]); w.z = pk2(s[2 * kk + 1][0], s[2 * kk + 1][1]); w.w = pk2(s[2 * kk + 1][2], s[2 * kk + 1][3]);
            pf[kk] = __builtin_bit_cast(bf16x8, w); }
#pragma unroll
        for (int db = 0; db < DH / 16; ++db)
#pragma unroll
            for (int kk = 0; kk < 2; ++kk) { const bf16* vp = Vt + (16 * db + li) * VS + 32 * kk + 4 * qd;
                const v2u lo = *(const v2u*)vp, hi = *(const v2u*)(vp + 16);
                v4u w; w.x = lo.x; w.y = lo.y; w.z = hi.x; w.w = hi.y;
                oacc[db] = __builtin_amdgcn_mfma_f32_16x16x32_bf16(__builtin_bit_cast(bf16x8, w), pf[kk], oacc[db], 0, 0, 0); }
      }
#undef KR
#undef VR
    }
#undef ATTN_PREFETCH
    lsum += __shfl_xor(lsum, 16); lsum += __shfl_xor(lsum, 32);
    const float inv = 1.0f / lsum;
    bf16* orow = Op + (size_t)(wave * 16 + li) * ldo + 4 * qd;
#pragma unroll
    for (int db = 0; db < DH / 16; ++db) { v2u w; w.x = pk2(oacc[db][0] * inv, oacc[db][1] * inv); w.y = pk2(oacc[db][2] * inv, oacc[db][3] * inv); *(v2u*)(orow + 16 * db) = w; }
}
__device__ __forceinline__ void fox_cumsum(const bf16* P, int b, int h, float fb, float* Fc, float* red, int tid) {
    const int lane = tid & 63, wave = tid >> 6;
    float lf[4];
#pragma unroll
    for (int i = 0; i < 4; ++i) { const float z = bf2f(P[(size_t)(b * SEQ + 4 * tid + i) * LDP + PC_FF + h]) + fb; lf[i] = logsig(z); }
    const float loc = (lf[0] + lf[1]) + (lf[2] + lf[3]);
    float inc = loc;
#pragma unroll
    for (int o = 1; o < 64; o <<= 1) { const float t = __shfl_up(inc, o); if (lane >= o) inc += t; }
    __syncthreads();
    if (lane == 63) red[wave] = inc;
    __syncthreads();
    float off = inc - loc;
    for (int w = 0; w < wave; ++w) off += red[w];
    float run = off;
#pragma unroll
    for (int i = 0; i < 4; ++i) { run += lf[i]; Fc[4 * tid + i] = -run * 1.4426950408889634f; }
    __syncthreads();
}
__device__ __forceinline__ void s5_load_u(const bf16* P, int row0, int g, float* us, int lane) {
    const v4u* src = (const v4u*)(P + (size_t)(row0 + lane) * LDP + PC_SU + g * 16);
    const v4u a = src[0], c = src[1];
    f32x4* dst = (f32x4*)(us + lane * 16);
    dst[0] = (f32x4){bflo(a.x), bfhi(a.x), bflo(a.y), bfhi(a.y)}; dst[1] = (f32x4){bflo(a.z), bfhi(a.z), bflo(a.w), bfhi(a.w)};
    dst[2] = (f32x4){bflo(c.x), bfhi(c.x), bflo(c.y), bfhi(c.y)}; dst[3] = (f32x4){bflo(c.z), bfhi(c.z), bflo(c.w), bfhi(c.w)};
    LDS_WAIT();
}
__device__ __forceinline__ void s5_bu(const float* us, int t, const float (&bre)[16], const float (&bim)[16], float& bur, float& bui) {
    const f32x4* up = (const f32x4*)(us + t * 16);
    bur = 0.f; bui = 0.f;
#pragma unroll
    for (int q = 0; q < 4; ++q) { const f32x4 u4 = up[q];
#pragma unroll
        for (int j = 0; j < 4; ++j) { bur += bre[4 * q + j] * u4[j]; bui += bim[4 * q + j] * u4[j]; } }
}
__device__ __forceinline__ void s5_passA(unsigned char* ws, const float* const* tab, char* lds, int gw, int NGW, int wave, int lane) {
    const bf16* P = (const bf16*)(ws + WS_P);
    const float2* ABAR = (const float2*)(ws + WS_S5P + S5P_ABAR); const float2* BBAR = (const float2*)(ws + WS_S5P + S5P_BBAR);
    float* L = (float*)(ws + WS_S5L);
    float* us = (float*)(lds + wave * 4096);
    for (int u = gw; u < 4096; u += NGW) {
        const int n = u & 31, g = (u >> 5) & 15, b = u >> 9;
        LDS_WAIT();
        s5_load_u(P, b * SEQ + n * 64, g, us, lane);
        float bre[16], bim[16];
#pragma unroll
        for (int h = 0; h < 16; ++h) { const float2 v = BBAR[(g * 64 + lane) * 16 + h]; bre[h] = v.x; bim[h] = v.y; }
        const float2 ab = ABAR[g * 64 + lane];
        float xr = 0.f, xi = 0.f;
        for (int t = 0; t < 64; ++t) { float bur, bui; s5_bu(us, t, bre, bim, bur, bui);
            const float nr = ab.x * xr - ab.y * xi + bur, ni = ab.x * xi + ab.y * xr + bui; xr = nr; xi = ni; }
        L[(size_t)u * 128 + lane] = xr; L[(size_t)u * 128 + 64 + lane] = xi;
    }
}
__device__ __forceinline__ void s5_passC(unsigned char* ws, const float* const* tab, int l, char* lds, int unit, int tid) {
    const int lane = tid & 63, wave = tid >> 6, li = lane & 15, qd = lane >> 4;
    const int b = unit >> 5, n = unit & 31, row0 = b * SEQ + n * 64;
    const bf16* P = (const bf16*)(ws + WS_P);
    const float2* ABAR = (const float2*)(ws + WS_S5P + S5P_ABAR); const float2* A64 = (const float2*)(ws + WS_S5P + S5P_A64);
    const float2* BBAR = (const float2*)(ws + WS_S5P + S5P_BBAR); const bf16* CMAT = (const bf16*)(ws + WS_S5P + S5P_CMAT);
    const float* L = (const float*)(ws + WS_S5L);
    bf16* Xs = (bf16*)(lds + wave * 8704);
    float* us = (float*)(lds + 69632 + wave * 4096);
    bf16* Ys = (bf16*)(lds + 102400);
    __syncthreads();
    for (int gi = 0; gi < 2; ++gi) {
        const int g = 2 * wave + gi;
        LDS_WAIT();
        s5_load_u(P, row0, g, us, lane);
        float xr = 0.f, xi = 0.f;
        { const float2 a64 = A64[g * 64 + lane]; const float* Lb = L + (size_t)((b * 16 + g) * 32) * 128 + lane;
          for (int m0 = 0; m0 < n; m0 += 8) { float lr[8], lim[8];
#pragma unroll
              for (int j = 0; j < 8; ++j) { const bool ok = (m0 + j) < n; const int mi = ok ? (m0 + j) : 0; lr[j] = Lb[mi * 128]; lim[j] = Lb[mi * 128 + 64]; if (!ok) { lr[j] = __builtin_nanf(""); } }
#pragma unroll
              for (int j = 0; j < 8; ++j) { if (lr[j] == lr[j]) { const float nr = a64.x * xr - a64.y * xi + lr[j], ni = a64.x * xi + a64.y * xr + lim[j]; xr = nr; xi = ni; } } } }
        float bre[16], bim[16];
#pragma unroll
        for (int h = 0; h < 16; ++h) { const float2 v = BBAR[(g * 64 + lane) * 16 + h]; bre[h] = v.x; bim[h] = v.y; }
        const float2 ab = ABAR[g * 64 + lane];
        bf16x8 cfr[4];
#pragma unroll
        for (int ks = 0; ks < 4; ++ks) cfr[ks] = *(const bf16x8*)(CMAT + ((size_t)((g * 4 + ks) * 64 + lane)) * 8);
        const float dsk = tab[19][l * 256 + g * 16 + li];
        for (int half = 0; half < 2; ++half) {
            for (int tt = 0; tt < 32; ++tt) { const int t = half * 32 + tt; float bur, bui; s5_bu(us, t, bre, bim, bur, bui);
                const float nr = ab.x * xr - ab.y * xi + bur, ni = ab.x * xi + ab.y * xr + bui; xr = nr; xi = ni;
                Xs[tt * 136 + lane] = (bf16)f2bf(xr); Xs[tt * 136 + 64 + lane] = (bf16)f2bf(xi); }
            LDS_WAIT();
#pragma unroll
            for (int rb = 0; rb < 2; ++rb) { f32x4 acc = (f32x4){0.f, 0.f, 0.f, 0.f};
#pragma unroll
                for (int ks = 0; ks < 4; ++ks) { const bf16x8 a = *(const bf16x8*)(Xs + (16 * rb + li) * 136 + 32 * ks + 8 * qd); acc = __builtin_amdgcn_mfma_f32_16x16x32_bf16(a, cfr[ks], acc, 0, 0, 0); }
#pragma unroll
                for (int i = 0; i < 4; ++i) { const int t = half * 32 + 16 * rb + 4 * qd + i; const float yv = gelu_tanh(acc[i] + dsk * us[t * 16 + li]); Ys[t * 264 + g * 16 + li] = (bf16)f2bf(yv); } }
            LDS_WAIT();
        }
    }
    __syncthreads();
    { const bf16* Wg = (const bf16*)(ws + WS_W) + WO_GLU; const float* gb = tab[21] + l * 256; bf16* BRS = (bf16*)(ws + WS_BRS);
      f32x4 acc[4][2];
#pragma unroll
      for (int rb = 0; rb < 4; ++rb) { acc[rb][0] = (f32x4){0.f, 0.f, 0.f, 0.f}; acc[rb][1] = (f32x4){0.f, 0.f, 0.f, 0.f}; }
#pragma unroll
      for (int ks = 0; ks < 8; ++ks) { bf16x8 bfr[2];
#pragma unroll
          for (int cb = 0; cb < 2; ++cb) bfr[cb] = *(const bf16x8*)(Wg + (size_t)(32 * wave + 16 * cb + li) * 256 + 32 * ks + 8 * qd);
#pragma unroll
          for (int rb = 0; rb < 4; ++rb) { const bf16x8 a = *(const bf16x8*)(Ys + (16 * rb + li) * 264 + 32 * ks + 8 * qd);
#pragma unroll
              for (int cb = 0; cb < 2; ++cb) acc[rb][cb] = __builtin_amdgcn_mfma_f32_16x16x32_bf16(a, bfr[cb], acc[rb][cb], 0, 0, 0); } }
#pragma unroll
      for (int rb = 0; rb < 4; ++rb)
#pragma unroll
          for (int cb = 0; cb < 2; ++cb) { const int col = 32 * wave + 16 * cb + li; const float bias = gb[col];
#pragma unroll
              for (int i = 0; i < 4; ++i) { const int t = 16 * rb + 4 * qd + i; const float yv = bf2f(Ys[t * 264 + col]); const float o = yv * sigmoidf_(acc[rb][cb][i] + bias);
                  BRS[(size_t)(row0 + t) * 256 + col] = (bf16)f2bf(o); } } }
    __syncthreads();
}
struct GlaLds { float* QF; float* QI; float* KI; float* KE; float* G; float* V; float* AT; float* SP; float* GD; };
__device__ __forceinline__ GlaLds gla_lds(char* lds) { GlaLds s; float* f = (float*)lds; s.QF = f; s.QI = f + 2112; s.KI = f + 4224; s.KE = f + 6336; s.G = f + 8448; s.V = f + 10560; s.AT = f + 14656; s.SP = f + 18816; s.GD = f + 20864; return s; }
__device__ __forceinline__ void gla_load(unsigned char* ws, const float* const* tab, int l, const GlaLds& s, int row0, int h, int tid, bool need_q) {
    const bf16* P = (const bf16*)(ws + WS_P);
    const int t = tid >> 3, c8 = tid & 7;
    const bf16* prow = P + (size_t)(row0 + t) * LDP;
    if (need_q) { const v2u w = *(const v2u*)(prow + PC_GQ + h * 32 + 4 * c8); float* d = s.QF + t * 33 + 4 * c8; d[0] = bflo(w.x); d[1] = bfhi(w.x); d[2] = bflo(w.y); d[3] = bfhi(w.y); }
    { const v2u w = *(const v2u*)(prow + PC_GK + h * 32 + 4 * c8); float* d = s.KI + t * 33 + 4 * c8; d[0] = bflo(w.x); d[1] = bfhi(w.x); d[2] = bflo(w.y); d[3] = bfhi(w.y); }
    { const v4u w = *(const v4u*)(prow + PC_GV + h * 64 + 8 * c8); f32x4* d = (f32x4*)(s.V + t * 64 + 8 * c8); d[0] = (f32x4){bflo(w.x), bfhi(w.x), bflo(w.y), bfhi(w.y)}; d[1] = (f32x4){bflo(w.z), bfhi(w.z), bflo(w.w), bfhi(w.w)}; }
    if (tid < 128) { const int tt = tid >> 1, hf = tid & 1; const v4u w = *(const v4u*)(P + (size_t)(row0 + tt) * LDP + PC_GD + 8 * hf); float* d = s.GD + tt * 16 + 8 * hf;
        d[0] = bflo(w.x); d[1] = bfhi(w.x); d[2] = bflo(w.y); d[3] = bfhi(w.y); d[4] = bflo(w.z); d[5] = bfhi(w.z); d[6] = bflo(w.w); d[7] = bfhi(w.w); }
    __syncthreads();
    const float* gw = tab[8] + l * 2048; const float* gbias = tab[9] + l * 128;
#pragma unroll
    for (int i = 0; i < 4; ++i) { const int d = 4 * c8 + i; float z = gbias[h * 32 + d];
#pragma unroll
        for (int r = 0; r < 16; ++r) z += s.GD[t * 16 + r] * gw[r * 128 + h * 32 + d];
        s.G[t * 33 + d] = logsig(z) * (1.0f / 16.0f); }
    __syncthreads();
    if (tid < 32) { float v[64];
#pragma unroll
        for (int tt = 0; tt < 64; ++tt) v[tt] = s.G[tt * 33 + tid];
#pragma unroll
        for (int tt = 1; tt < 64; ++tt) v[tt] += v[tt - 1];
#pragma unroll
        for (int tt = 0; tt < 64; ++tt) s.G[tt * 33 + tid] = v[tt]; }
    __syncthreads();
}
__device__ __forceinline__ void gla_passA(unsigned char* ws, const float* const* tab, int l, char* lds, int unit, int tid) {
    const GlaLds s = gla_lds(lds);
    const int b = unit >> 5, n = unit & 31, row0 = b * SEQ + n * 64;
    float* DS = (float*)(ws + WS_DS); float* DEC = (float*)(ws + WS_DEC);
    __syncthreads();
    for (int h = 0; h < 4; ++h) {
        gla_load(ws, tab, l, s, row0, h, tid, false);
        { const int t = tid >> 3, c8 = tid & 7;
#pragma unroll
          for (int i = 0; i < 4; ++i) { const int d = 4 * c8 + i; s.KI[t * 33 + d] *= expf(s.G[63 * 33 + d] - s.G[t * 33 + d]); } }
        __syncthreads();
        { const int d = tid >> 4, e0 = 4 * (tid & 15); f32x4 acc = (f32x4){0.f, 0.f, 0.f, 0.f};
          for (int c = 0; c < 64; ++c) acc += s.KI[c * 33 + d] * *(const f32x4*)(s.V + c * 64 + e0);
          const size_t ub = (size_t)((b * 4 + h) * 32 + n);
          *(f32x4*)(DS + ub * 2048 + d * 64 + e0) = acc;
          if ((tid & 15) == 0) DEC[ub * 32 + d] = expf(s.G[63 * 33 + d]); }
        __syncthreads();
    }
}
__device__ __forceinline__ void gla_passC(unsigned char* ws, const float* const* tab, int l, char* lds, int unit, int tid) {
    const GlaLds s = gla_lds(lds);
    const int b = unit >> 5, n = unit & 31, row0 = b * SEQ + n * 64;
    const float* DS = (const float*)(ws + WS_DS); const float* DEC = (const float*)(ws + WS_DEC);
    const bf16* P = (const bf16*)(ws + WS_P); bf16* BRG = (bf16*)(ws + WS_BRG);
    const float* gn = tab[10] + l * 256;
    __syncthreads();
    for (int h = 0; h < 4; ++h) {
        gla_load(ws, tab, l, s, row0, h, tid, true);
        { const int t = tid >> 3, c8 = tid & 7;
#pragma unroll
          for (int i = 0; i < 4; ++i) { const int d = 4 * c8 + i; const float g = s.G[t * 33 + d]; const float eg = expf(g), ieg = expf(-g);
              const float q = s.QF[t * 33 + d] * 0.17677669529663687f, k = s.KI[t * 33 + d];
              s.QF[t * 33 + d] = q * eg; s.QI[t * 33 + d] = q * ieg; s.KI[t * 33 + d] = k * ieg; s.KE[t * 33 + d] = k * eg; } }
        __syncthreads();
        { const int i = tid >> 3, jb = tid & 7;
#pragma unroll
          for (int jj = 0; jj < 8; ++jj) { const int j = jb + 8 * jj; const float* qa = (j <= i) ? s.QF : s.QI; const float* kb = (j <= i) ? s.KI : s.KE; float dot = 0.f;
#pragma unroll
              for (int d = 0; d < 32; ++d) dot += qa[i * 33 + d] * kb[j * 33 + d];
              s.AT[i * 65 + j] = dot; } }
        { const int idx4 = tid * 4, d = idx4 >> 6; f32x4 S = (f32x4){0.f, 0.f, 0.f, 0.f};
          const float* base = DS + (size_t)((b * 4 + h) * 32) * 2048 + idx4; const float* decb = DEC + (size_t)((b * 4 + h) * 32) * 32 + d;
          for (int m0 = 0; m0 < n; m0 += 8) { f32x4 v[8]; float dd[8];
#pragma unroll
              for (int j = 0; j < 8; ++j) { const bool ok = (m0 + j) < n; const int mi = ok ? (m0 + j) : 0; v[j] = *(const f32x4*)(base + (size_t)mi * 2048); dd[j] = decb[mi * 32];
                  if (!ok) { v[j] = (f32x4){0.f, 0.f, 0.f, 0.f}; dd[j] = 1.0f; } }
#pragma unroll
              for (int j = 0; j < 8; ++j) S = S * dd[j] + v[j]; }
          *(f32x4*)(s.SP + idx4) = S; }
        __syncthreads();
        { const int i = tid >> 3, e0 = 8 * (tid & 7); f32x4 a0 = (f32x4){0.f, 0.f, 0.f, 0.f}, a1 = a0;
          for (int j = 0; j < 64; ++j) { const float a = s.AT[i * 65 + j]; a0 += a * *(const f32x4*)(s.V + j * 64 + e0); a1 += a * *(const f32x4*)(s.V + j * 64 + e0 + 4); }
          for (int d = 0; d < 32; ++d) { const float a = s.QF[i * 33 + d]; a0 += a * *(const f32x4*)(s.SP + d * 64 + e0); a1 += a * *(const f32x4*)(s.SP + d * 64 + e0 + 4); }
          float ss = (a0[0] * a0[0] + a0[1] * a0[1]) + (a0[2] * a0[2] + a0[3] * a0[3]) + (a1[0] * a1[0] + a1[1] * a1[1]) + (a1[2] * a1[2] + a1[3] * a1[3]);
          ss += __shfl_xor(ss, 1); ss += __shfl_xor(ss, 2); ss += __shfl_xor(ss, 4);
          const float r = 1.0f / sqrtf(ss * (1.0f / 64.0f) + EPS);
          const v4u gr = *(const v4u*)(P + (size_t)(row0 + i) * LDP + PC_GR + h * 64 + e0);
          const float grv[8] = {bflo(gr.x), bfhi(gr.x), bflo(gr.y), bfhi(gr.y), bflo(gr.z), bfhi(gr.z), bflo(gr.w), bfhi(gr.w)};
          float o[8];
#pragma unroll
          for (int k = 0; k < 8; ++k) { const float v = (k < 4 ? a0[k & 3] : a1[k & 3]) * r * gn[h * 64 + e0 + k]; const float gg = grv[k]; o[k] = v * gg * sigmoidf_(gg); }
          v4u w; w.x = pk2(o[0], o[1]); w.y = pk2(o[2], o[3]); w.z = pk2(o[4], o[5]); w.w = pk2(o[6], o[7]);
          *(v4u*)(BRG + (size_t)(row0 + i) * 256 + h * 64 + e0) = w; }
        __syncthreads();
    }
}

__device__ __forceinline__ void gla_passC_mfma(unsigned char* ws, const float* const* tab, int l, char* lds, int unit, int tid) {
    const int b = unit >> 5, n = unit & 31, row0 = b * SEQ + n * 64;
    const float* DS = (const float*)(ws + WS_DS); const float* DEC = (const float*)(ws + WS_DEC);
    const bf16* P = (const bf16*)(ws + WS_P); bf16* BRG = (bf16*)(ws + WS_BRG);
    const float* gn = tab[10] + l * 256; const float* gw = tab[8] + l * 2048; const float* gbias = tab[9] + l * 128;
    const int lane = tid & 63, wave = tid >> 6, li = lane & 15, qd = lane >> 4;
    const int slot = tid >> 8, st = tid & 255, t = st >> 2, c4 = st & 3, wr = wave & 3;
    char* sb = lds + slot * 52480;
    bf16* QFb = (bf16*)sb; bf16* QIb = QFb + 2560; bf16* KIb = QIb + 2560; bf16* KEb = KIb + 2560;
    bf16* Vt = (bf16*)(sb + 20480); bf16* ATb = (bf16*)(sb + 29696); bf16* SPt = (bf16*)(sb + 38912); float* Gs = (float*)(sb + 44032);
    float* GD = (float*)(lds + 104960);
    __syncthreads();
    if (tid < 128) { const int tt = tid >> 1, hf = tid & 1; const v4u w = *(const v4u*)(P + (size_t)(row0 + tt) * LDP + PC_GD + 8 * hf); float* d = GD + tt * 16 + 8 * hf;
        d[0] = bflo(w.x); d[1] = bfhi(w.x); d[2] = bflo(w.y); d[3] = bfhi(w.y); d[4] = bflo(w.z); d[5] = bfhi(w.z); d[6] = bflo(w.w); d[7] = bfhi(w.w); }
    for (int hp = 0; hp < 2; ++hp) {
        const int h = 2 * hp + slot;
        const bf16* prow = P + (size_t)(row0 + t) * LDP;
        const v4u qw = *(const v4u*)(prow + PC_GQ + h * 32 + 8 * c4);
        const v4u kw = *(const v4u*)(prow + PC_GK + h * 32 + 8 * c4);
        { const v4u v0 = *(const v4u*)(prow + PC_GV + h * 64 + 16 * c4), v1 = *(const v4u*)(prow + PC_GV + h * 64 + 16 * c4 + 8);
          bf16* vt = Vt + (16 * c4) * 72 + t;
          vt[0 * 72] = (bf16)(v0.x & 0xffffu); vt[1 * 72] = (bf16)(v0.x >> 16); vt[2 * 72] = (bf16)(v0.y & 0xffffu); vt[3 * 72] = (bf16)(v0.y >> 16);
          vt[4 * 72] = (bf16)(v0.z & 0xffffu); vt[5 * 72] = (bf16)(v0.z >> 16); vt[6 * 72] = (bf16)(v0.w & 0xffffu); vt[7 * 72] = (bf16)(v0.w >> 16);
          vt[8 * 72] = (bf16)(v1.x & 0xffffu); vt[9 * 72] = (bf16)(v1.x >> 16); vt[10 * 72] = (bf16)(v1.y & 0xffffu); vt[11 * 72] = (bf16)(v1.y >> 16);
          vt[12 * 72] = (bf16)(v1.z & 0xffffu); vt[13 * 72] = (bf16)(v1.z >> 16); vt[14 * 72] = (bf16)(v1.w & 0xffffu); vt[15 * 72] = (bf16)(v1.w >> 16); }
        __syncthreads();
#pragma unroll
        for (int i = 0; i < 8; ++i) { const int d = 8 * c4 + i; float z = gbias[h * 32 + d];
#pragma unroll
            for (int r = 0; r < 16; ++r) z += GD[t * 16 + r] * gw[r * 128 + h * 32 + d];
            Gs[t * 33 + d] = logsig(z) * (1.0f / 16.0f); }
        __syncthreads();
        if (st < 32) { float v[64];
#pragma unroll
            for (int tt = 0; tt < 64; ++tt) v[tt] = Gs[tt * 33 + st];
#pragma unroll
            for (int tt = 1; tt < 64; ++tt) v[tt] += v[tt - 1];
#pragma unroll
            for (int tt = 0; tt < 64; ++tt) Gs[tt * 33 + st] = v[tt]; }
        __syncthreads();
        { const float qv[8] = {bflo(qw.x), bfhi(qw.x), bflo(qw.y), bfhi(qw.y), bflo(qw.z), bfhi(qw.z), bflo(qw.w), bfhi(qw.w)};
          const float kv[8] = {bflo(kw.x), bfhi(kw.x), bflo(kw.y), bfhi(kw.y), bflo(kw.z), bfhi(kw.z), bflo(kw.w), bfhi(kw.w)};
          float qf[8], qi[8], ki[8], ke[8];
#pragma unroll
          for (int i = 0; i < 8; ++i) { const float g = Gs[t * 33 + 8 * c4 + i]; const float eg = expf(g), ieg = expf(-g); const float q = qv[i] * 0.17677669529663687f;
              qf[i] = q * eg; qi[i] = q * ieg; ki[i] = kv[i] * ieg; ke[i] = kv[i] * eg; }
          v4u w;
          w.x = pk2(qf[0], qf[1]); w.y = pk2(qf[2], qf[3]); w.z = pk2(qf[4], qf[5]); w.w = pk2(qf[6], qf[7]); *(v4u*)(QFb + t * 40 + 8 * c4) = w;
          w.x = pk2(qi[0], qi[1]); w.y = pk2(qi[2], qi[3]); w.z = pk2(qi[4], qi[5]); w.w = pk2(qi[6], qi[7]); *(v4u*)(QIb + t * 40 + 8 * c4) = w;
          w.x = pk2(ki[0], ki[1]); w.y = pk2(ki[2], ki[3]); w.z = pk2(ki[4], ki[5]); w.w = pk2(ki[6], ki[7]); *(v4u*)(KIb + t * 40 + 8 * c4) = w;
          w.x = pk2(ke[0], ke[1]); w.y = pk2(ke[2], ke[3]); w.z = pk2(ke[4], ke[5]); w.w = pk2(ke[6], ke[7]); *(v4u*)(KEb + t * 40 + 8 * c4) = w; }
        { const int idx8 = st * 8, d = idx8 >> 6, e0 = idx8 & 63; f32x4 S0 = (f32x4){0.f, 0.f, 0.f, 0.f}, S1 = S0;
          const float* base = DS + (size_t)((b * 4 + h) * 32) * 2048 + idx8; const float* decb = DEC + (size_t)((b * 4 + h) * 32) * 32 + d;
          for (int m0 = 0; m0 < n; m0 += 4) { f32x4 va[4], vb[4]; float dd[4];
#pragma unroll
              for (int j = 0; j < 4; ++j) { const bool ok = (m0 + j) < n; const int mi = ok ? (m0 + j) : 0; va[j] = *(const f32x4*)(base + (size_t)mi * 2048); vb[j] = *(const f32x4*)(base + (size_t)mi * 2048 + 4); dd[j] = decb[mi * 32];
                  if (!ok) { va[j] = (f32x4){0.f, 0.f, 0.f, 0.f}; vb[j] = va[j]; dd[j] = 1.0f; } }
#pragma unroll
              for (int j = 0; j < 4; ++j) { S0 = S0 * dd[j] + va[j]; S1 = S1 * dd[j] + vb[j]; } }
#pragma unroll
          for (int i = 0; i < 4; ++i) { SPt[(e0 + i) * 40 + d] = (bf16)f2bf(S0[i]); SPt[(e0 + 4 + i) * 40 + d] = (bf16)f2bf(S1[i]); } }
        __syncthreads();
        { const bf16x8 aqf = *(const bf16x8*)(QFb + (16 * wr + li) * 40 + 8 * qd), aqi = *(const bf16x8*)(QIb + (16 * wr + li) * 40 + 8 * qd);
#pragma unroll
          for (int cb = 0; cb < 4; ++cb) { const bf16x8 bki = *(const bf16x8*)(KIb + (16 * cb + li) * 40 + 8 * qd), bke = *(const bf16x8*)(KEb + (16 * cb + li) * 40 + 8 * qd);
              const f32x4 z4 = (f32x4){0.f, 0.f, 0.f, 0.f};
              const f32x4 af = __builtin_amdgcn_mfma_f32_16x16x32_bf16(aqf, bki, z4, 0, 0, 0), ab = __builtin_amdgcn_mfma_f32_16x16x32_bf16(aqi, bke, z4, 0, 0, 0);
#pragma unroll
              for (int r = 0; r < 4; ++r) { const int i = 16 * wr + 4 * qd + r, j = 16 * cb + li; ATb[i * 72 + j] = (bf16)f2bf(j <= i ? af[r] : ab[r]); } }
          LDS_WAIT();
          f32x4 oa[4];
#pragma unroll
          for (int cb = 0; cb < 4; ++cb) { oa[cb] = (f32x4){0.f, 0.f, 0.f, 0.f};
#pragma unroll
              for (int ks = 0; ks < 2; ++ks) { const bf16x8 a = *(const bf16x8*)(ATb + (16 * wr + li) * 72 + 32 * ks + 8 * qd), bv = *(const bf16x8*)(Vt + (16 * cb + li) * 72 + 32 * ks + 8 * qd);
                  oa[cb] = __builtin_amdgcn_mfma_f32_16x16x32_bf16(a, bv, oa[cb], 0, 0, 0); }
              const bf16x8 bs = *(const bf16x8*)(SPt + (16 * cb + li) * 40 + 8 * qd);
              oa[cb] = __builtin_amdgcn_mfma_f32_16x16x32_bf16(aqf, bs, oa[cb], 0, 0, 0); }
#pragma unroll
          for (int r = 0; r < 4; ++r) { float ss = (oa[0][r] * oa[0][r] + oa[1][r] * oa[1][r]) + (oa[2][r] * oa[2][r] + oa[3][r] * oa[3][r]);
              ss += __shfl_xor(ss, 1); ss += __shfl_xor(ss, 2); ss += __shfl_xor(ss, 4); ss += __shfl_xor(ss, 8);
              const float rs = 1.0f / sqrtf(ss * (1.0f / 64.0f) + EPS);
              const int i = 16 * wr + 4 * qd + r;
#pragma unroll
              for (int cb = 0; cb < 4; ++cb) { const int e = 16 * cb + li; const float gg = bf2f(P[(size_t)(row0 + i) * LDP + PC_GR + h * 64 + e]);
                  const float o = oa[cb][r] * rs * gn[h * 64 + e] * gg * sigmoidf_(gg);
                  BRG[(size_t)(row0 + i) * 256 + h * 64 + e] = (bf16)f2bf(o); } } }
        __syncthreads();
    }
}
__device__ __forceinline__ void gsync(unsigned char* wsb, unsigned G, int wave_s) {
    unsigned char* wl_ = wsb; asm volatile("" : "+s"(wl_)); unsigned* ctr = (unsigned*)(wl_ + 1024);
    int ln_; asm volatile("v_mbcnt_lo_u32_b32 %0, -1, 0\n\tv_mbcnt_hi_u32_b32 %0, -1, %0" : "=v"(ln_));
    const bool leader = (wave_s == 0) && (ln_ == 0);
    asm volatile("s_waitcnt vmcnt(0)" ::: "memory");
    __syncthreads();
    if (leader) {
        __builtin_amdgcn_fence(__ATOMIC_RELEASE, "agent");
        asm volatile("s_waitcnt vmcnt(0)" ::: "memory");
        const unsigned old = __hip_atomic_fetch_add(ctr, 1u, __ATOMIC_RELAXED, __HIP_MEMORY_SCOPE_AGENT);
        const unsigned want = (old | (G - 1u)) + 1u;
        while (__hip_atomic_load(ctr, __ATOMIC_RELAXED, __HIP_MEMORY_SCOPE_AGENT) < want) __builtin_amdgcn_s_sleep(2);
        __builtin_amdgcn_fence(__ATOMIC_ACQUIRE, "agent");
        asm volatile("s_waitcnt vmcnt(0)" ::: "memory");
    }
    __syncthreads();
}
__global__ void __launch_bounds__(NTHR, 2) fwd_mega(Params p) {
    extern __shared__ __attribute__((aligned(16))) unsigned char lds_raw[];
    char* lds = (char*)lds_raw;
    PG8_LAS unsigned char* ldsg = (PG8_LAS unsigned char*)lds_raw;
    cg::grid_group grid = cg::this_grid();
    constexpr int G = 256; const int bid = blockIdx.x;
    const int wave_s = __builtin_amdgcn_readfirstlane(threadIdx.x >> 6);
    const int NGW = G * NWAVES;
#define TIDS() int tid; { int ln_; asm volatile("v_mbcnt_lo_u32_b32 %0, -1, 0\n\tv_mbcnt_hi_u32_b32 %0, -1, %0" : "=v"(ln_)); tid = wave_s * 64 + ln_; } const int lane = tid & 63, wave = __builtin_amdgcn_readfirstlane(tid >> 6), gw = bid * NWAVES + wave; (void)lane; (void)gw
    if (threadIdx.x < 38) ((const float**)p.ws)[threadIdx.x] = threadIdx.x < 37 ? p.in[threadIdx.x] : (const float*)p.out;
    if (bid == 0 && threadIdx.x >= 64 && threadIdx.x < 128) ((unsigned*)(p.ws + 1024))[threadIdx.x - 64] = 0u;
    grid.sync();
#define PTRS() unsigned char* ws = p.ws; asm volatile("" : "+s"(ws)); const float* const* tab = (const float* const*)ws; (void)tab
#define GSYNC() gsync(p.ws, 256u, wave_s)
#define Wb ((bf16*)(ws + WS_W))
#define P ((bf16*)(ws + WS_P))
#define ACT ((bf16*)(ws + WS_P))
#define H ((bf16*)(ws + WS_H))
#define Y ((float*)(ws + WS_Y))
#define YB ((bf16*)(ws + WS_Y))
#define BRG ((bf16*)(ws + WS_BRG))
#define BRS ((bf16*)(ws + WS_BRS))
#define BRF ((bf16*)(ws + WS_BRF))
#define MIXB ((bf16*)(ws + WS_MIXB))
#define Qb ((bf16*)(ws + WS_Q))
#define XO ((bf16*)(ws + WS_XO))
#define KV ((bf16*)(ws + WS_KV))
#define MEMN ((bf16*)(ws + WS_MEMN))
#define X ((float*)tab[37])

#define GEMM(EpiT, epi, Ap, Bp, Mv, Nv, Kv) do { pg8::Gemm g_{(const pg8::bf16_t*)(Ap), (const pg8::bf16_t*)(Bp), (Mv), (Nv), (Kv)}; int bid_ = bid; const int G_ = G; asm volatile("" : "+s"(bid_)); pg8::StaticOrder S_; S_.init((Mv), (Nv), G_, bid_); \
        TIDS(); pg8::gemm_phase<EpiT, pg8::StaticOrder, true, true>(ldsg, g_, S_, epi, tid); __syncthreads(); } while (0)

    { PTRS(); TIDS();
#if EN_CONV
      convert_weights(ws, tab, 0, lds, gw, NGW, wave, lane);
      s5_prep(ws, tab, 0, bid * NTHR + tid, G * NTHR);
#if REP_CONV > 1
      convert_weights(ws, tab, 0, lds, gw, NGW, wave, lane);
#endif
#endif
      rowop<false, false, true>(tab[1], nullptr, nullptr, nullptr, 0.f, tab[28], MEMN, MMEM, gw, NGW, lane);
      rowop<false, true, true>(tab[0], X, nullptr, nullptr, 0.f, tab[2], H, MTOK, gw, NGW, lane); }
    GSYNC();

    for (int l = 0; l < DEPTH; ++l) {
        { PTRS(); pg8::EpiSwiGLU e{ACT, DFF}; GEMM(pg8::EpiSwiGLU, e, H, Wb + WO_GU1, MTOK, 5632, 1024); }
#if REP_GU > 1
        { PTRS(); pg8::EpiSwiGLU e{ACT, DFF}; GEMM(pg8::EpiSwiGLU, e, H, Wb + WO_GU1, MTOK, 5632, 1024); }
#endif
        GSYNC();
        { PTRS(); pg8::EpiBf16 e{YB, DM}; GEMM(pg8::EpiBf16, e, ACT, Wb + WO_DOWN1, MTOK, 1024, DFF); }
#if REP_DOWN > 1
        { PTRS(); pg8::EpiBf16 e{YB, DM}; GEMM(pg8::EpiBf16, e, ACT, Wb + WO_DOWN1, MTOK, 1024, DFF); }
#endif
        GSYNC();
        { PTRS(); TIDS(); rowop<true, true, true>(X, X, YB, tab[5] + l * DM, 0.5f, tab[6] + l * DM, H, MTOK, gw, NGW, lane); }
#if REP_ROW
        { PTRS(); TIDS(); rowop<true, true, true>(X, (float*)(ws + WS_P), YB, tab[5] + l * DM, 0.5f, tab[6] + l * DM, (bf16*)(ws + WS_P + 64 * MiB), MTOK, gw, NGW, lane); }
#endif
        GSYNC();
        { PTRS(); pg8::EpiBf16 e{P, LDP}; GEMM(pg8::EpiBf16, e, H, Wb + WO_IN, MTOK, LDP, 1024); }
#if REP_IN > 1
        { PTRS(); pg8::EpiBf16 e{P, LDP}; GEMM(pg8::EpiBf16, e, H, Wb + WO_IN, MTOK, LDP, 1024); }
#endif
        { PTRS(); pg8::EpiBf16 e{KV, 2048}; GEMM(pg8::EpiBf16, e, MEMN, Wb + WO_KV, MMEM, 2048, 1024); }
#if REP_IN > 1
        { PTRS(); pg8::EpiBf16 e{KV, 2048}; GEMM(pg8::EpiBf16, e, MEMN, Wb + WO_KV, MMEM, 2048, 1024); }
#endif
        GSYNC();
        for (int rep_ = 0; rep_ < REP_MIXA; ++rep_) {
#if EN_S5A
        for (int r2_ = 0; r2_ < REP_S5A; ++r2_) { PTRS(); TIDS(); s5_passA(ws, tab, lds, gw, NGW, wave, lane); }
#endif
#if EN_GLAA
        for (int r2_ = 0; r2_ < REP_GLAA; ++r2_) { PTRS(); TIDS(); for (int u = bid; u < 256; u += G) gla_passA(ws, tab, l, lds, u, tid); }
#endif
#if EN_FOX
        for (int r2_ = 0; r2_ < REP_FOX; ++r2_) { PTRS(); TIDS();
          for (int pr = bid; pr < 512; pr += G) {
            const int bh = pr >> 3, pp = pr & 7, b = bh >> 3, h = bh & 7;
            float* Fc = (float*)(lds + 24576); float* red = (float*)(lds + 24576 + 8192);
            __syncthreads();
            fox_cumsum(P, b, h, tab[23][l * 8 + h], Fc, red, tid);
            for (int hf = 0; hf < 2; ++hf) { const int qb = hf ? 15 - pp : pp;
                const size_t rq = (size_t)(b * SEQ + qb * 128);
                attn_unit<64, true>(lds, P + rq * LDP + PC_FQ + h * 64, LDP, P + (size_t)(b * SEQ) * LDP + PC_FK + h * 64, LDP, P + (size_t)(b * SEQ) * LDP + PC_FV + h * 64, LDP,
                                    BRF + rq * 512 + h * 64, 512, qb * 128, 2 * qb + 2, 2 * qb, Fc, 0.125f, tid); }
          } }
#endif
        }
        GSYNC();
        for (int rep_ = 0; rep_ < REP_MIXC; ++rep_) {
#if EN_S5C
        for (int r2_ = 0; r2_ < REP_S5C; ++r2_) { PTRS(); TIDS(); for (int u = bid; u < 256; u += G) s5_passC(ws, tab, l, lds, u, tid); }
#endif
#if EN_GLAC
        for (int r2_ = 0; r2_ < REP_GLAC; ++r2_) { PTRS(); TIDS(); for (int u = bid; u < 256; u += G) gla_passC_mfma(ws, tab, l, lds, u, tid); }
#endif
        }
        GSYNC();
        { PTRS(); pg8::EpiMerge<0> e{Y, MIXB, P + PC_GATE, LDP}; GEMM(pg8::EpiMerge<0>, e, BRG, Wb + WO_GLAUP, MTOK, 1024, 256); }
        { PTRS(); pg8::EpiMerge<1> e{Y, MIXB, P + PC_GATE + 1024, LDP}; GEMM(pg8::EpiMerge<1>, e, BRS, Wb + WO_S5UP, MTOK, 1024, 256); }
        { PTRS(); pg8::EpiMerge<2> e{Y, MIXB, P + PC_GATE + 2048, LDP}; GEMM(pg8::EpiMerge<2>, e, BRF, Wb + WO_FOXUP, MTOK, 1024, 512); }
#if REP_MERGE > 1
        { PTRS(); pg8::EpiMerge<0> e{Y, MIXB, P + PC_GATE, LDP}; GEMM(pg8::EpiMerge<0>, e, BRG, Wb + WO_GLAUP, MTOK, 1024, 256); }
        { PTRS(); pg8::EpiMerge<1> e{Y, MIXB, P + PC_GATE + 1024, LDP}; GEMM(pg8::EpiMerge<1>, e, BRS, Wb + WO_S5UP, MTOK, 1024, 256); }
        { PTRS(); pg8::EpiMerge<2> e{Y, MIXB, P + PC_GATE + 2048, LDP}; GEMM(pg8::EpiMerge<2>, e, BRF, Wb + WO_FOXUP, MTOK, 1024, 512); }
#endif
        GSYNC();
        { PTRS(); pg8::EpiBf16 e{YB, DM}; GEMM(pg8::EpiBf16, e, MIXB, Wb + WO_MIXOUT, MTOK, 1024, 1024); }
#if REP_SQ > 1
        { PTRS(); pg8::EpiBf16 e{YB, DM}; GEMM(pg8::EpiBf16, e, MIXB, Wb + WO_MIXOUT, MTOK, 1024, 1024); }
#endif
        GSYNC();
        { PTRS(); TIDS(); rowop<true, true, true>(X, X, YB, tab[26] + l * DM, 1.0f, tab[27] + l * DM, H, MTOK, gw, NGW, lane); }
#if REP_ROW
        { PTRS(); TIDS(); rowop<true, true, true>(X, (float*)(ws + WS_P), YB, tab[26] + l * DM, 1.0f, tab[27] + l * DM, (bf16*)(ws + WS_P + 64 * MiB), MTOK, gw, NGW, lane); }
#endif
        GSYNC();
        { PTRS(); pg8::EpiBf16 e{Qb, DM}; GEMM(pg8::EpiBf16, e, H, Wb + WO_Q, MTOK, 1024, 1024); }
#if REP_SQ > 1
        { PTRS(); pg8::EpiBf16 e{Qb, DM}; GEMM(pg8::EpiBf16, e, H, Wb + WO_Q, MTOK, 1024, 1024); }
#endif
        GSYNC();
#if EN_XA
        for (int rep_ = 0; rep_ < REP_XA; ++rep_)
        { PTRS(); TIDS();
          for (int u = bid; u < 512; u += G) { const int qb = u & 15, hd = (u >> 4) & 3, b = u >> 6;
            const size_t rq = (size_t)(b * SEQ + qb * 128);
            attn_unit<256, false>(lds, Qb + rq * DM + hd * 256, DM, KV + (size_t)(b * NMEM) * 2048 + hd * 256, 2048, KV + (size_t)(b * NMEM) * 2048 + 1024 + hd * 256, 2048,
                                  XO + rq * DM + hd * 256, DM, 0, 4, 0, nullptr, 0.0625f, tid); } }
#endif
        GSYNC();
        { PTRS(); pg8::EpiBf16 e{YB, DM}; GEMM(pg8::EpiBf16, e, XO, Wb + WO_O, MTOK, 1024, 1024); }
#if REP_SQ > 1
        { PTRS(); pg8::EpiBf16 e{YB, DM}; GEMM(pg8::EpiBf16, e, XO, Wb + WO_O, MTOK, 1024, 1024); }
#endif
        GSYNC();
        { PTRS(); TIDS(); rowop<true, true, true>(X, X, YB, tab[32] + l * DM, 1.0f, tab[33] + l * DM, H, MTOK, gw, NGW, lane); }
#if REP_ROW
        { PTRS(); TIDS(); rowop<true, true, true>(X, (float*)(ws + WS_P), YB, tab[32] + l * DM, 1.0f, tab[33] + l * DM, (bf16*)(ws + WS_P + 64 * MiB), MTOK, gw, NGW, lane); }
#endif
        GSYNC();
        { PTRS(); pg8::EpiSwiGLU e{ACT, DFF}; GEMM(pg8::EpiSwiGLU, e, H, Wb + WO_GU2, MTOK, 5632, 1024); }
#if REP_GU > 1
        { PTRS(); pg8::EpiSwiGLU e{ACT, DFF}; GEMM(pg8::EpiSwiGLU, e, H, Wb + WO_GU2, MTOK, 5632, 1024); }
#endif
        GSYNC();
        { PTRS(); pg8::EpiBf16 e{YB, DM}; GEMM(pg8::EpiBf16, e, ACT, Wb + WO_DOWN2, MTOK, 1024, DFF); }
#if REP_DOWN > 1
        { PTRS(); pg8::EpiBf16 e{YB, DM}; GEMM(pg8::EpiBf16, e, ACT, Wb + WO_DOWN2, MTOK, 1024, DFF); }
#endif
        GSYNC();
        if (l + 1 < DEPTH) {
            { PTRS(); TIDS(); rowop<true, true, true>(X, X, YB, tab[36] + l * DM, 0.5f, tab[2] + (l + 1) * DM, H, MTOK, gw, NGW, lane); }
#if REP_ROW
            { PTRS(); TIDS(); rowop<true, true, true>(X, (float*)(ws + WS_P), YB, tab[36] + l * DM, 0.5f, tab[2] + (l + 1) * DM, (bf16*)(ws + WS_P + 64 * MiB), MTOK, gw, NGW, lane); }
#endif
            __syncthreads();
            { PTRS(); TIDS();
#if EN_CONV
              convert_weights(ws, tab, l + 1, lds, gw, NGW, wave, lane);
              s5_prep(ws, tab, l + 1, bid * NTHR + tid, G * NTHR);
#if REP_CONV > 1
              convert_weights(ws, tab, l + 1, lds, gw, NGW, wave, lane);
#endif
#endif
              rowop<false, false, true>(tab[1], nullptr, nullptr, nullptr, 0.f, tab[28] + (l + 1) * DM, MEMN, MMEM, gw, NGW, lane); }
            GSYNC();
        } else {
            { PTRS(); TIDS(); rowop<true, true, false>(X, X, YB, tab[36] + l * DM, 0.5f, nullptr, nullptr, MTOK, gw, NGW, lane); }
        }
    }
}

extern "C" void kernel_launch(void* const* d_in, const int* in_sizes, int n_in, void* d_out, int out_size, void* d_ws, size_t ws_size, hipStream_t stream) {
    static int grid = 0;
    if (grid == 0) {
        if (n_in != 37 || out_size != MTOK * DM || ws_size < WS_END) { fprintf(stderr, "kernel_launch: unexpected shapes (n_in %d out %d ws %zu need %zu)\n", n_in, out_size, ws_size, (size_t)WS_END); grid = -1; return; }
        int dev = 0, cus = 0, per_cu = 0;
        hipGetDevice(&dev); hipDeviceGetAttribute(&cus, hipDeviceAttributeMultiprocessorCount, dev);
        if (hipFuncSetAttribute((const void*)fwd_mega, hipFuncAttributeMaxDynamicSharedMemorySize, LDS_BYTES) != hipSuccess) { fprintf(stderr, "kernel_launch: hipFuncSetAttribute failed\n"); grid = -1; return; }
        hipOccupancyMaxActiveBlocksPerMultiprocessor(&per_cu, (const void*)fwd_mega, NTHR, LDS_BYTES);
        (void)hipGetLastError();
        if (per_cu < 1) { fprintf(stderr, "kernel_launch: occupancy query says %d blocks/CU\n", per_cu); }
        if (cus < 256) { fprintf(stderr, "kernel_launch: needs 256 CUs, device has %d\n", cus); grid = -1; return; }
        grid = 256;
    }
    if (grid < 0) return;
    Params p{};
    for (int i = 0; i < 37; ++i) p.in[i] = (const float*)d_in[i];
    p.out = (float*)d_out; p.ws = (unsigned char*)d_ws;
    void* args[] = {&p};
    hipError_t e = hipLaunchCooperativeKernel((const void*)fwd_mega, dim3(grid), dim3(NTHR), args, LDS_BYTES, stream);
    if (e != hipSuccess) fprintf(stderr, "cooperative launch failed: %s (grid %d)\n", hipGetErrorString(e), grid);
}
```

```cpp
#include <hip/hip_runtime.h>
#include <hip/hip_cooperative_groups.h>
#include <cstdio>
#include <cstdint>
namespace cg = cooperative_groups;
namespace pg8 {
#define PG8_LAS __attribute__((address_space(3)))
typedef unsigned short bf16_t;
typedef short bf16x8 __attribute__((ext_vector_type(8)));
typedef float f32x4 __attribute__((ext_vector_type(4)));
typedef unsigned u32x4 __attribute__((ext_vector_type(4)));
constexpr int BM = 256, BK = 64, HALF = 128, HTB = HALF * BK * 2  , STAGE_BYTES = 8 * HTB, NXCD = 8, WGM = 8;

__host__ __device__ __forceinline__ int lds_byte(int r, int c) { const int st = (r >> 4) * 2 + (c >> 5), rr = r & 15, cc = c & 31, ob = rr * 64 + cc * 2; return st * 1024 + (ob ^ (((ob >> 9) & 1) << 5)); }
__host__ __device__ __forceinline__ void stage_rc(int b, int& R, int& C) { const int st = b / 1024, sb = b % 1024, swz = sb ^ (((sb >> 9) & 1) << 5); R = (st >> 1) * 16 + swz / 64; C = (st & 1) * 32 + (swz % 64) / 2; }
__host__ __device__ __forceinline__ int perm32(int rho) { const int n = rho >> 4, i = rho & 15; return 8 * (i >> 2) + 4 * n + (i & 3); }

struct Unit { int pm, pn; };
struct Gemm { const bf16_t* A; const bf16_t* Bt; int M, N, K; };

struct StaticOrder {
    int nM, nN, nwg, G, c;
    __host__ __device__ void init(int M, int N, int G_, int c_) { nM = M / BM; nN = N / BM; nwg = nM * nN; G = G_; c = c_; }
    __host__ __device__ bool next(int i, Unit& u) const {
        const long L = (long)i * G + c; if (L >= nwg) return false;
        int wgid = (int)L; { const int q = nwg / NXCD, r = nwg % NXCD, xcd = wgid % NXCD, off = wgid / NXCD; wgid = (xcd < r ? xcd * (q + 1) : r * (q + 1) + (xcd - r) * q) + off; }
        const int nig = WGM * nN, gid = wgid / nig, fm = gid * WGM, gsz = (nM - fm) < WGM ? (nM - fm) : WGM;
        u.pm = fm + ((wgid % nig) % gsz); u.pn = (wgid % nig) / gsz; return true;
    }
    __device__ __forceinline__ void a_ready(const Unit&) const {}
    __device__ __forceinline__ void done(const Unit&) const {}
};

__device__ __forceinline__ unsigned cvt_pk_bf16(float lo, float hi) { unsigned r; asm volatile("v_cvt_pk_bf16_f32 %0, %1, %2" : "=v"(r) : "v"(lo), "v"(hi)); return r; }
typedef float f32x2 __attribute__((ext_vector_type(2)));
typedef unsigned u32x2 __attribute__((ext_vector_type(2)));
__device__ __forceinline__ float fast_sigmoid(float x) { return __builtin_amdgcn_rcpf(1.0f + __expf(-x)); }
__device__ __forceinline__ float bf_lo(unsigned w) { return __uint_as_float(w << 16); }
__device__ __forceinline__ float bf_hi(unsigned w) { return __uint_as_float(w & 0xffff0000u); }
struct EpiBf16 {
    static constexpr bool PERM = true, AFTER_DRAIN = false;
    bf16_t* O; int ldc;
    __device__ __forceinline__ void operator()(const f32x4 (&acc)[2][2][4][2], const Unit& u, int wr, int wc, int fr, int fq) const {
        const int row0 = u.pm * BM + wr * 64 + fr; const int col0 = u.pn * BM + wc * 32 + 8 * fq;
#pragma unroll
        for (int ai = 0; ai < 2; ++ai)
#pragma unroll
            for (int m = 0; m < 4; ++m) { bf16_t* rowp = O + (size_t)(row0 + ai * HALF + m * 16) * ldc + col0;
#pragma unroll
                for (int bj = 0; bj < 2; ++bj) { const f32x4 v0 = acc[ai][bj][m][0], v1 = acc[ai][bj][m][1];
                    u32x4 w; w.x = cvt_pk_bf16(v0[0], v0[1]); w.y = cvt_pk_bf16(v0[2], v0[3]); w.z = cvt_pk_bf16(v1[0], v1[1]); w.w = cvt_pk_bf16(v1[2], v1[3]);
                    *(u32x4*)(rowp + bj * HALF) = w; } }
    }
};
struct EpiSwiGLU {
    static constexpr bool PERM = true, AFTER_DRAIN = false;
    bf16_t* O; int ldc;
    __device__ __forceinline__ void operator()(const f32x4 (&acc)[2][2][4][2], const Unit& u, int wr, int wc, int fr, int fq) const {
        const int row0 = u.pm * BM + wr * 64 + fr; const int col0 = u.pn * HALF + wc * 32 + 8 * fq;
#pragma unroll
        for (int ai = 0; ai < 2; ++ai)
#pragma unroll
            for (int m = 0; m < 4; ++m) { bf16_t* rowp = O + (size_t)(row0 + ai * HALF + m * 16) * ldc + col0;
                float r[8];
#pragma unroll
                for (int n = 0; n < 2; ++n)
#pragma unroll
                    for (int j = 0; j < 4; ++j) { const float g = acc[ai][0][m][n][j], up = acc[ai][1][m][n][j]; r[n * 4 + j] = g * fast_sigmoid(g) * up; }
                u32x4 w; w.x = cvt_pk_bf16(r[0], r[1]); w.y = cvt_pk_bf16(r[2], r[3]); w.z = cvt_pk_bf16(r[4], r[5]); w.w = cvt_pk_bf16(r[6], r[7]);
                *(u32x4*)rowp = w; }
    }
};
struct EpiF32 {
    static constexpr bool PERM = false, AFTER_DRAIN = false;
    float* O; int ldc;
    __device__ __forceinline__ void operator()(const f32x4 (&acc)[2][2][4][2], const Unit& u, int wr, int wc, int fr, int fq) const {
        const int row0 = u.pm * BM + wr * 64 + fr; const int col0 = u.pn * BM + wc * 32 + 4 * fq;
#pragma unroll
        for (int ai = 0; ai < 2; ++ai)
#pragma unroll
            for (int m = 0; m < 4; ++m) { float* rowp = O + (size_t)(row0 + ai * HALF + m * 16) * ldc + col0;
#pragma unroll
                for (int bj = 0; bj < 2; ++bj)
#pragma unroll
                    for (int n = 0; n < 2; ++n) *(f32x4*)(rowp + bj * HALF + n * 16) = acc[ai][bj][m][n]; }
    }
};
template <int MODE> struct EpiMerge {
    static constexpr bool PERM = false, AFTER_DRAIN = false;
    float* F; bf16_t* B; const bf16_t* G; int ldg;
    __device__ __forceinline__ void operator()(const f32x4 (&acc)[2][2][4][2], const Unit& u, int wr, int wc, int fr, int fq) const {
        const int row0 = u.pm * BM + wr * 64 + fr; const int col0 = u.pn * BM + wc * 32 + 4 * fq;
#pragma unroll
        for (int ai = 0; ai < 2; ++ai)
#pragma unroll
            for (int m = 0; m < 4; ++m) { const size_t row = (size_t)(row0 + ai * HALF + m * 16);
#pragma unroll
                for (int bj = 0; bj < 2; ++bj)
#pragma unroll
                    for (int n = 0; n < 2; ++n) { const int c = col0 + bj * HALF + n * 16;
                        const u32x2 gw = *(const u32x2*)(G + row * ldg + c);
                        f32x4 s; s[0] = fast_sigmoid(bf_lo(gw.x)); s[1] = fast_sigmoid(bf_hi(gw.x)); s[2] = fast_sigmoid(bf_lo(gw.y)); s[3] = fast_sigmoid(bf_hi(gw.y));
                        f32x4 v = s * acc[ai][bj][m][n];
                        float* fp = F + row * 1024 + c;
                        if (MODE >= 1) v += *(const f32x4*)fp;
                        if (MODE <= 1) *(f32x4*)fp = v;
                        else { u32x2 w; w.x = cvt_pk_bf16(v[0], v[1]); w.y = cvt_pk_bf16(v[2], v[3]); *(u32x2*)(B + row * 1024 + c) = w; } } }
    }
};

template <int MODE> struct EpiBf16VT {
    static constexpr bool PERM = true, AFTER_DRAIN = false;
    bf16_t* O; int ldc; bf16_t* VT;
    __device__ __forceinline__ void operator()(const f32x4 (&acc)[2][2][4][2], const Unit& u, int wr, int wc, int fr, int fq) const {
        const int row0 = u.pm * BM + wr * 64 + fr; const int col0 = u.pn * BM + wc * 32 + 8 * fq;
        const bool tr = MODE == 0 ? (u.pn == 8 || u.pn == 9) : (u.pn >= 4);
        if (!tr) {
#pragma unroll
            for (int ai = 0; ai < 2; ++ai)
#pragma unroll
                for (int m = 0; m < 4; ++m) { bf16_t* rowp = O + (size_t)(row0 + ai * HALF + m * 16) * ldc + col0;
#pragma unroll
                    for (int bj = 0; bj < 2; ++bj) { const f32x4 v0 = acc[ai][bj][m][0], v1 = acc[ai][bj][m][1];
                        u32x4 w; w.x = cvt_pk_bf16(v0[0], v0[1]); w.y = cvt_pk_bf16(v0[2], v0[3]); w.z = cvt_pk_bf16(v1[0], v1[1]); w.w = cvt_pk_bf16(v1[2], v1[3]);
                        *(u32x4*)(rowp + bj * HALF) = w; } }
        } else {
            bf16_t* vp; int sbj, sn, sj;
            if (MODE == 0) { vp = VT + ((size_t)((((u.pm * BM) >> 11) * 8 + (u.pn - 8) * 4 + (wc >> 1)) * 64 + (wc & 1) * 32 + 8 * fq)) * 2048 + ((u.pm * BM) & 2047) + wr * 64 + fr; sbj = 2 * 64 * 2048; sn = 4 * 2048; sj = 2048; }
            else           { vp = VT + ((size_t)((u.pm * 4 + (u.pn - 4)) * 256 + wc * 32 + 8 * fq)) * 256 + wr * 64 + fr; sbj = 128 * 256; sn = 4 * 256; sj = 256; }
#pragma unroll
            for (int ai = 0; ai < 2; ++ai)
#pragma unroll
                for (int m = 0; m < 4; ++m)
#pragma unroll
                    for (int bj = 0; bj < 2; ++bj)
#pragma unroll
                        for (int n = 0; n < 2; ++n) { bf16_t* q = vp + bj * sbj + n * sn + ai * HALF + m * 16;
                            const unsigned w0 = cvt_pk_bf16(acc[ai][bj][m][n][0], acc[ai][bj][m][n][1]), w1 = cvt_pk_bf16(acc[ai][bj][m][n][2], acc[ai][bj][m][n][3]);
                            q[0] = (bf16_t)(w0 & 0xffffu); q[sj] = (bf16_t)(w0 >> 16); q[2 * sj] = (bf16_t)(w1 & 0xffffu); q[3 * sj] = (bf16_t)(w1 >> 16); }
        }
    }
};
template <class Epi, class Sched, bool ALIGN_EPI = false, bool SP2 = false>
__device__ __forceinline__ void gemm_phase(PG8_LAS unsigned char* lds, const Gemm g, const Sched& S, const Epi& E, const int tid) {
    const int wid = __builtin_amdgcn_readfirstlane(tid >> 6), lane = tid & 63, wr = wid >> 2, wc = wid & 3, fr = lane & 15, fq = lane >> 4;
    const int K = g.K, nt = K / BK;
    unsigned voffA[2], voffB[2];
#pragma unroll
    for (int i = 0; i < 2; ++i) { int R, C; stage_rc(tid * 16 + i * 8192, R, C); const int Rb = Epi::PERM ? ((R & ~31) + perm32(R & 31)) : R;
        voffA[i] = (unsigned)(R * K + C) * 2u; voffB[i] = (unsigned)(Rb * K + C) * 2u; }
    const size_t kstep = (size_t)(BK * 2);
    const size_t hstep = (size_t)HALF * K * 2;
    const size_t tstep = 2 * hstep;
    const unsigned ldsw = (unsigned)wid * 1024u;
    const int aoff = lds_byte(wr * 64 + fr, fq * 8), boff = lds_byte(wc * 32 + fr, fq * 8);
#define PG8_SA(b, h) (((b) * 2 + (h)) * HTB)
#define PG8_SB(b, h) ((4 + (b) * 2 + (h)) * HTB)
#define PG8_STAGE(bufoff, gbase, voff) do { _Pragma("unroll") for (int _i = 0; _i < 2; ++_i) \
        __builtin_amdgcn_global_load_lds((const unsigned*)((const char*)(gbase) + (voff)[_i]), (PG8_LAS unsigned*)(lds + (bufoff) + ldsw + _i * 8192), 16, 0, 0); } while (0)
#define PG8_LDA(dst, b, h) do { _Pragma("unroll") for (int m = 0; m < 4; ++m) _Pragma("unroll") for (int k = 0; k < 2; ++k) dst[m][k] = *(const PG8_LAS bf16x8*)(lds + PG8_SA(b, h) + aoff + m * 2048 + k * 1024); } while (0)
#define PG8_LDB(dst, b, h) do { _Pragma("unroll") for (int n = 0; n < 2; ++n) _Pragma("unroll") for (int k = 0; k < 2; ++k) dst[n][k] = *(const PG8_LAS bf16x8*)(lds + PG8_SB(b, h) + boff + n * 2048 + k * 1024); } while (0)
#define PG8_MMA(ai, bj, At, Bt) do { __builtin_amdgcn_s_setprio(1); _Pragma("unroll") for (int m = 0; m < 4; ++m) _Pragma("unroll") for (int n = 0; n < 2; ++n) _Pragma("unroll") for (int k = 0; k < 2; ++k) \
        acc[ai][bj][m][n] = __builtin_amdgcn_mfma_f32_16x16x32_bf16(Bt[n][k], At[m][k], acc[ai][bj][m][n], 0, 0, 0); __builtin_amdgcn_s_setprio(0); } while (0)
#define PG8_WAIT_V(n) asm volatile("s_waitcnt vmcnt(" #n ")" ::: "memory")
#define PG8_WAIT_L(n) asm volatile("s_waitcnt lgkmcnt(" #n ")" ::: "memory")
#define PG8_BAR __builtin_amdgcn_s_barrier()
#define PG8_SCHED __builtin_amdgcn_sched_barrier(0)
    Unit cur, nxt; int ui = 0;
    if (!S.next(0, cur)) return;
    f32x4 acc[2][2][4][2];
#pragma unroll
    for (int a = 0; a < 2; ++a)
#pragma unroll
        for (int b = 0; b < 2; ++b)
#pragma unroll
            for (int m = 0; m < 4; ++m)
#pragma unroll
                for (int n = 0; n < 2; ++n) acc[a][b][m][n] = (f32x4){0.f, 0.f, 0.f, 0.f};
    bf16x8 At[4][2], B0[2][2], B1[2][2];
    const char* cA = (const char*)g.A + (size_t)cur.pm * tstep; const char* cB = (const char*)g.Bt + (size_t)cur.pn * tstep;
    S.a_ready(cur);
    if constexpr (SP2) {
        PG8_STAGE(PG8_SB(0, 0), cB, voffB); PG8_STAGE(PG8_SB(0, 1), cB + hstep, voffB); PG8_STAGE(PG8_SA(0, 0), cA, voffA); PG8_STAGE(PG8_SA(0, 1), cA + hstep, voffA);
        if (wr == 1) PG8_BAR;
        PG8_WAIT_V(2); PG8_BAR;
        PG8_STAGE(PG8_SB(1, 0), cB + kstep, voffB); PG8_STAGE(PG8_SA(1, 0), cA + kstep, voffA); PG8_STAGE(PG8_SB(1, 1), cB + hstep + kstep, voffB);
        PG8_WAIT_V(6); PG8_BAR;
    } else {
        PG8_STAGE(PG8_SB(0, 0), cB, voffB); PG8_STAGE(PG8_SA(0, 0), cA, voffA); PG8_STAGE(PG8_SB(0, 1), cB + hstep, voffB); PG8_STAGE(PG8_SA(0, 1), cA + hstep, voffA);
        if (wr == 1) PG8_BAR;
        PG8_WAIT_V(4); PG8_BAR;
        PG8_STAGE(PG8_SB(1, 0), cB + kstep, voffB); PG8_STAGE(PG8_SA(1, 0), cA + kstep, voffA); PG8_STAGE(PG8_SB(1, 1), cB + hstep + kstep, voffB);
        PG8_WAIT_V(6); PG8_BAR;
    }
    for (;;) {
        const bool has_next = S.next(ui + 1, nxt);
        const char* nA = has_next ? (const char*)g.A + (size_t)nxt.pm * tstep : cA; const char* nB = has_next ? (const char*)g.Bt + (size_t)nxt.pn * tstep : cB;
        for (int t = 0; t < nt; t += 2) {
            const bool last = (t == nt - 2);
            const char* a1 = cA + (size_t)(t + 1) * kstep;
            const char* a2 = last ? nA : cA + (size_t)(t + 2) * kstep; const char* b2 = last ? nB : cB + (size_t)(t + 2) * kstep;
            const char* a3 = a2 + kstep; const char* b3 = b2 + kstep;
            if (last && has_next) S.a_ready(nxt);
            if constexpr (SP2) {
            PG8_LDB(B0, 0, 0); PG8_LDB(B1, 0, 1); PG8_SCHED; PG8_LDA(At, 0, 0); PG8_STAGE(PG8_SA(1, 1), a1 + hstep, voffA);
            PG8_WAIT_V(8); PG8_WAIT_L(0); PG8_BAR; PG8_MMA(0, 0, At, B0); PG8_MMA(0, 1, At, B1); PG8_BAR; PG8_SCHED;
            PG8_LDA(At, 0, 1); PG8_STAGE(PG8_SB(0, 0), b2, voffB); PG8_STAGE(PG8_SB(0, 1), b2 + hstep, voffB); PG8_STAGE(PG8_SA(0, 0), a2, voffA);
            PG8_WAIT_V(8); PG8_WAIT_L(0); PG8_BAR; PG8_MMA(1, 0, At, B0); PG8_MMA(1, 1, At, B1); PG8_BAR; PG8_SCHED;
            PG8_LDB(B0, 1, 0); PG8_LDB(B1, 1, 1); PG8_SCHED; PG8_LDA(At, 1, 0); PG8_STAGE(PG8_SA(0, 1), a2 + hstep, voffA);
            PG8_WAIT_V(8); PG8_WAIT_L(0); PG8_BAR; PG8_MMA(0, 0, At, B0); PG8_MMA(0, 1, At, B1); PG8_BAR; PG8_SCHED;
            PG8_LDA(At, 1, 1); PG8_STAGE(PG8_SB(1, 0), b3, voffB); PG8_STAGE(PG8_SB(1, 1), b3 + hstep, voffB); PG8_STAGE(PG8_SA(1, 0), a3, voffA);
            PG8_WAIT_V(8); PG8_WAIT_L(0); PG8_BAR; PG8_MMA(1, 0, At, B0); PG8_MMA(1, 1, At, B1); PG8_BAR; PG8_SCHED;
            } else {
            PG8_LDB(B0, 0, 0); PG8_SCHED; PG8_LDA(At, 0, 0); PG8_STAGE(PG8_SA(1, 1), a1 + hstep, voffA);
            PG8_WAIT_L(8); PG8_BAR; PG8_WAIT_L(0); PG8_MMA(0, 0, At, B0); PG8_BAR; PG8_SCHED;
            PG8_LDB(B1, 0, 1); PG8_STAGE(PG8_SB(0, 0), b2, voffB);
            PG8_BAR; PG8_WAIT_L(0); PG8_MMA(0, 1, At, B1); PG8_BAR;
            PG8_LDA(At, 0, 1); PG8_STAGE(PG8_SA(0, 0), a2, voffA);
            PG8_BAR; PG8_WAIT_L(0); PG8_MMA(1, 0, At, B0); PG8_BAR; PG8_SCHED;
            PG8_STAGE(PG8_SB(0, 1), b2 + hstep, voffB);
            PG8_WAIT_V(6); PG8_BAR; PG8_MMA(1, 1, At, B1); PG8_BAR;
            PG8_LDB(B0, 1, 0); PG8_SCHED; PG8_LDA(At, 1, 0); PG8_STAGE(PG8_SA(0, 1), a2 + hstep, voffA);
            PG8_WAIT_L(8); PG8_BAR; PG8_WAIT_L(0); PG8_MMA(0, 0, At, B0); PG8_BAR; PG8_SCHED;
            PG8_LDB(B1, 1, 1); PG8_STAGE(PG8_SB(1, 0), b3, voffB);
            PG8_BAR; PG8_WAIT_L(0); PG8_MMA(0, 1, At, B1); PG8_BAR;
            PG8_LDA(At, 1, 1); PG8_STAGE(PG8_SA(1, 0), a3, voffA);
            PG8_BAR; PG8_WAIT_L(0); PG8_MMA(1, 0, At, B0); PG8_BAR; PG8_SCHED;
            PG8_STAGE(PG8_SB(1, 1), b3 + hstep, voffB);
            PG8_WAIT_V(6); PG8_BAR; PG8_MMA(1, 1, At, B1); PG8_BAR;
            }
        }
        if constexpr (ALIGN_EPI) { if (wr == 0) PG8_BAR; }
        if constexpr (!Epi::AFTER_DRAIN) { int l2_; asm volatile("v_mbcnt_lo_u32_b32 %0, -1, 0\n\tv_mbcnt_hi_u32_b32 %0, -1, %0" : "=v"(l2_)); E(acc, cur, wr, wc, l2_ & 15, l2_ >> 4); S.done(cur); }
        if (!has_next) break;
#pragma unroll
        for (int a = 0; a < 2; ++a)
#pragma unroll
            for (int b = 0; b < 2; ++b)
#pragma unroll
                for (int m = 0; m < 4; ++m)
#pragma unroll
                    for (int n = 0; n < 2; ++n) acc[a][b][m][n] = (f32x4){0.f, 0.f, 0.f, 0.f};
        cur = nxt; cA = nA; cB = nB; ++ui;
        if constexpr (ALIGN_EPI) { if (wr == 1) PG8_BAR; }
    }
    PG8_WAIT_V(0);
    if constexpr (!ALIGN_EPI) { if (wr == 0) PG8_BAR; }
    PG8_BAR;
    if constexpr (Epi::AFTER_DRAIN) { E.fused(acc, cur, wr, wc, fr, fq, lds, wid, lane); S.done(cur); }
#undef PG8_SA
#undef PG8_SB
#undef PG8_STAGE
#undef PG8_LDA
#undef PG8_LDB
#undef PG8_MMA
#undef PG8_WAIT_V
#undef PG8_WAIT_L
#undef PG8_BAR
#undef PG8_SCHED
}
}
#ifndef REP_GU
#define REP_GU 1
#endif
#ifndef REP_DOWN
#define REP_DOWN 1
#endif
#ifndef REP_IN
#define REP_IN 1
#endif
#ifndef REP_MERGE
#define REP_MERGE 1
#endif
#ifndef REP_SQ
#define REP_SQ 1
#endif
#ifndef REP_S5A
#define REP_S5A 1
#endif
#ifndef REP_GLAA
#define REP_GLAA 1
#endif
#ifndef REP_FOX
#define REP_FOX 1
#endif
#ifndef REP_S5C
#define REP_S5C 1
#endif
#ifndef REP_GLAC
#define REP_GLAC 1
#endif
#ifndef REP_MIXA
#define REP_MIXA 1
#endif
#ifndef REP_MIXC
#define REP_MIXC 1
#endif
#ifndef REP_XA
#define REP_XA 1
#endif
#ifndef REP_CONV
#define REP_CONV 1
#endif
#ifndef REP_ROW
#define REP_ROW 0
#endif
#ifndef EN_S5A
#define EN_S5A 1
#endif
#ifndef EN_GLAA
#define EN_GLAA 1
#endif
#ifndef EN_FOX
#define EN_FOX 1
#endif
#ifndef EN_S5C
#define EN_S5C 1
#endif
#ifndef EN_GLAC
#define EN_GLAC 1
#endif
#ifndef EN_XA
#define EN_XA 1
#endif
#ifndef EN_CONV
#define EN_CONV 1
#endif
typedef unsigned short bf16;
typedef unsigned v4u __attribute__((ext_vector_type(4)));
typedef unsigned v2u __attribute__((ext_vector_type(2)));
typedef float f32x4 __attribute__((ext_vector_type(4)));
typedef short bf16x8 __attribute__((ext_vector_type(8)));
#define LAS __attribute__((address_space(3)))

constexpr int MTOK = 16384, DM = 1024, SEQ = 2048, NB = 8, DFF = 2816, NMEM = 256, MMEM = NB * NMEM, DEPTH = 4;
constexpr int LDP = 5888, D_IN = 5656;
constexpr int PC_GQ = 0, PC_GK = 128, PC_GV = 256, PC_GR = 512, PC_SU = 768, PC_FQ = 1024, PC_FK = 1536, PC_FV = 2048, PC_GD = 2560, PC_FF = 2576, PC_GATE = 2816;
constexpr float EPS = 1e-6f;
constexpr int NTHR = 512, NWAVES = 8;
constexpr int LDS_BYTES = 147456;

constexpr size_t WO_GU1 = 0, WO_DOWN1 = WO_GU1 + (size_t)5632 * 1024, WO_IN = WO_DOWN1 + (size_t)1024 * 2816, WO_GLAUP = WO_IN + (size_t)5888 * 1024, WO_S5UP = WO_GLAUP + 1024 * 256,
                 WO_FOXUP = WO_S5UP + 1024 * 256, WO_GLU = WO_FOXUP + 1024 * 512, WO_MIXOUT = WO_GLU + 256 * 256, WO_Q = WO_MIXOUT + 1024 * 1024, WO_KV = WO_Q + 1024 * 1024,
                 WO_O = WO_KV + 2048 * 1024, WO_GU2 = WO_O + 1024 * 1024, WO_DOWN2 = WO_GU2 + (size_t)5632 * 1024, WO_END = WO_DOWN2 + (size_t)1024 * 2816;
constexpr size_t MiB = (size_t)1 << 20;
constexpr size_t WS_W = 1 * MiB, WS_P = 64 * MiB, WS_H = 248 * MiB, WS_Y = 280 * MiB, WS_BRG = 344 * MiB, WS_BRS = 352 * MiB, WS_BRF = 360 * MiB, WS_MIXB = 376 * MiB,
                 WS_Q = 344 * MiB, WS_XO = 376 * MiB, WS_KV = 408 * MiB, WS_MEMN = 416 * MiB, WS_DS = 420 * MiB, WS_DEC = 428 * MiB, WS_S5L = 429 * MiB, WS_S5P = 431 * MiB, WS_VT = 432 * MiB, WS_VTX = 448 * MiB, WS_END = 452 * MiB;
static_assert(WS_W + WO_END * 2 <= WS_P, "weights fit");
static_assert(WS_P + (size_t)MTOK * LDP * 2 <= WS_H, "P fits");
constexpr size_t S5P_ABAR = 0, S5P_A64 = 8192, S5P_BBAR = 16384, S5P_CMAT = 16384 + 131072;

struct Params { const float* in[37]; float* out; unsigned char* ws; };

__device__ __forceinline__ unsigned f2bf(float f) { unsigned u = __builtin_bit_cast(unsigned, f); return (u + 0x7fffu + ((u >> 16) & 1u)) >> 16; }
__device__ __forceinline__ unsigned pk2(float lo, float hi) { return f2bf(lo) | (f2bf(hi) << 16); }
__device__ __forceinline__ float bf2f(unsigned h) { return __uint_as_float(h << 16); }
__device__ __forceinline__ float bflo(unsigned w) { return __uint_as_float(w << 16); }
__device__ __forceinline__ float bfhi(unsigned w) { return __uint_as_float(w & 0xffff0000u); }
#define LDS_WAIT() asm volatile("s_waitcnt lgkmcnt(0)" ::: "memory")
__device__ __forceinline__ float wave_sum(float v) {
#pragma unroll
    for (int o = 1; o < 64; o <<= 1) v += __shfl_xor(v, o);
    return v;
}
__device__ __forceinline__ float logsig(float z) { return fminf(z, 0.f) - logf(1.0f + expf(-fabsf(z))); }
__device__ __forceinline__ float sigmoidf_(float x) { return 1.0f / (1.0f + __expf(-x)); }
__device__ __forceinline__ float gelu_tanh(float x) { const float z = 0.7978845608028654f * (x + 0.044715f * x * x * x); const float t = 1.0f - 2.0f / (__expf(2.0f * z) + 1.0f); return 0.5f * x * (1.0f + t); }

__device__ __forceinline__ int srccol(int kind, int j) {
    if (kind == 0) return j;
    if (kind == 1) { const int pn = j >> 8, r = j & 255; return r < 128 ? 128 * pn + r : 2816 + 128 * pn + (r - 128); }
    if (j < 768) return j;
    if (j < 1024) return 784 + (j - 768);
    if (j < 2560) return 1040 + (j - 1024);
    if (j < 2576) return 768 + (j - 2560);
    if (j < 2584) return 2576 + (j - 2576);
    if (j < 2816) return -1;
    return 2584 + (j - 2816);
}
__device__ __forceinline__ void transpose_item(const float* W, int K, int Nsrc, int Ndst, int kind, bf16* WT, float* scr, int item, int lane) {
    const int nblk = Ndst / 32, kb = item / nblk, nb = item % nblk, k0 = 64 * kb, n0 = 32 * nb;
    const int nn = 4 * (lane & 7), sc = srccol(kind, n0 + nn);
    f32x4 v[8];
#pragma unroll
    for (int i = 0; i < 8; ++i) { const int kk = 8 * i + (lane >> 3); v[i] = sc >= 0 ? *(const f32x4*)(W + (size_t)(k0 + kk) * Nsrc + sc) : (f32x4){0.f, 0.f, 0.f, 0.f}; }
#pragma unroll
    for (int i = 0; i < 8; ++i) { const int kk = 8 * i + (lane >> 3); float* d = scr + kk * 33 + nn; d[0] = v[i][0]; d[1] = v[i][1]; d[2] = v[i][2]; d[3] = v[i][3]; }
    LDS_WAIT();
    const int c = lane & 7;
#pragma unroll
    for (int j = 0; j < 4; ++j) { const int n = (lane >> 3) + 8 * j; const float* s = scr + (8 * c) * 33 + n;
        v4u o; o.x = pk2(s[0 * 33], s[1 * 33]); o.y = pk2(s[2 * 33], s[3 * 33]); o.z = pk2(s[4 * 33], s[5 * 33]); o.w = pk2(s[6 * 33], s[7 * 33]);
        *(v4u*)(WT + (size_t)(n0 + n) * K + k0 + 8 * c) = o; }
    LDS_WAIT();
}
struct ConvJob { int in_idx; int K, Nsrc, Ndst, kind; size_t wo; };
__device__ __forceinline__ void convert_weights(unsigned char* ws, const float* const* tab, int l, char* lds, int gw, int NGW, int wave, int lane) {
    float* scr = (float*)(lds + wave * 8448);
    bf16* Wb = (bf16*)(ws + WS_W);
    const int  jin[13]  = {3, 4, 7, 11, 22, 24, 20, 25, 29, 30, 31, 34, 35};
    const int  jK[13]   = {1024, 2816, 1024, 256, 256, 512, 256, 1024, 1024, 1024, 1024, 1024, 2816};
    const int  jNs[13]  = {5632, 1024, D_IN, 1024, 1024, 1024, 256, 1024, 1024, 2048, 1024, 5632, 1024};
    const int  jNd[13]  = {5632, 1024, 5888, 1024, 1024, 1024, 256, 1024, 1024, 2048, 1024, 5632, 1024};
    const int  jkind[13]= {1, 0, 2, 0, 0, 0, 0, 0, 0, 0, 0, 1, 0};
    const size_t jwo[13]= {WO_GU1, WO_DOWN1, WO_IN, WO_GLAUP, WO_S5UP, WO_FOXUP, WO_GLU, WO_MIXOUT, WO_Q, WO_KV, WO_O, WO_GU2, WO_DOWN2};
    int base = 0;
#pragma unroll
    for (int j = 0; j < 13; ++j) {
        const int K = jK[j], Ns = jNs[j], Nd = jNd[j];
        const int nitems = (K / 64) * (Nd / 32);
        const float* W = tab[jin[j]] + (size_t)l * K * Ns;
        int first = (gw - (base % NGW) + NGW) % NGW;
        for (int it = first; it < nitems; it += NGW) transpose_item(W, K, Ns, Nd, jkind[j], Wb + jwo[j], scr, it, lane);
        base += nitems;
    }
}
__device__ __forceinline__ void s5_prep(unsigned char* ws, const float* const* tab, int l, int gtid, int GT) {
    unsigned char* sp = ws + WS_S5P;
    float2* ABAR = (float2*)(sp + S5P_ABAR); float2* A64 = (float2*)(sp + S5P_A64); float2* BBAR = (float2*)(sp + S5P_BBAR); bf16* CMAT = (bf16*)(sp + S5P_CMAT);
    const float* a_re = tab[12] + l * 1024; const float* a_im = tab[13] + l * 1024; const float* log_dt = tab[14] + l * 16;
    const float* b_re = tab[15] + (size_t)l * 16384; const float* b_im = tab[16] + (size_t)l * 16384;
    const float* c_re = tab[17] + (size_t)l * 16384; const float* c_im = tab[18] + (size_t)l * 16384;
    for (int idx = gtid; idx < 1024; idx += GT) {
        const int g = idx >> 6;
        const float lre = fminf(a_re[idx], -1e-4f), lim = a_im[idx], dt = expf(log_dt[g]);
        const float mag = expf(lre * dt);
        float sn, cs; sincosf(lim * dt, &sn, &cs);
        const float abr = mag * cs, abi = mag * sn;
        const float den = lre * lre + lim * lim;
        const float zr = ((abr - 1.0f) * lre + abi * lim) / den, zi = (abi * lre - (abr - 1.0f) * lim) / den;
        ABAR[idx] = make_float2(abr, abi);
        float pr = abr, pi = abi;
#pragma unroll
        for (int s = 0; s < 6; ++s) { const float nr = pr * pr - pi * pi, ni = 2.0f * pr * pi; pr = nr; pi = ni; }
        A64[idx] = make_float2(pr, pi);
        for (int h = 0; h < 16; ++h) { const float br = b_re[idx * 16 + h], bi = b_im[idx * 16 + h]; BBAR[idx * 16 + h] = make_float2(zr * br - zi * bi, zr * bi + zi * br); }
    }
    for (int idx = gtid; idx < 32768; idx += GT) {
        const int j = idx & 7, ln = (idx >> 3) & 63, ks = (idx >> 9) & 3, g = idx >> 11;
        const int k = 32 * ks + 8 * (ln >> 4) + j, h = ln & 15;
        const float v = k < 64 ? c_re[(g * 16 + h) * 64 + k] : -c_im[(g * 16 + h) * 64 + (k - 64)];
        CMAT[idx] = (bf16)f2bf(v);
    }
}
template <bool HASY, bool HASX, bool HASH>
__device__ __forceinline__ void rowop(const float* xin, float* xout, const bf16* Y, const float* postg, float coef, const float* preg, bf16* H, int nrows, int gw, int NGW, int lane) {
    for (int m = gw; m < nrows; m += NGW) {
        const f32x4* xr = (const f32x4*)(xin + (size_t)m * DM) + lane;
        f32x4 v[4];
#pragma unroll
        for (int j = 0; j < 4; ++j) v[j] = xr[64 * j];
        if (HASY) {
            const v2u* yr = (const v2u*)(Y + (size_t)m * DM) + lane; f32x4 y[4]; float s = 0.f;
#pragma unroll
            for (int j = 0; j < 4; ++j) { const v2u w = yr[64 * j]; y[j] = (f32x4){bflo(w.x), bfhi(w.x), bflo(w.y), bfhi(w.y)}; s += (y[j].x * y[j].x + y[j].y * y[j].y) + (y[j].z * y[j].z + y[j].w * y[j].w); }
            const float r = coef / sqrtf(wave_sum(s) * (1.0f / DM) + EPS);
#pragma unroll
            for (int j = 0; j < 4; ++j) { const f32x4 g = ((const f32x4*)postg)[lane + 64 * j]; v[j] += y[j] * g * r; }
        }
        if (HASX) { f32x4* xo = (f32x4*)(xout + (size_t)m * DM) + lane;
#pragma unroll
            for (int j = 0; j < 4; ++j) xo[64 * j] = v[j]; }
        if (HASH) {
            float s2 = 0.f;
#pragma unroll
            for (int j = 0; j < 4; ++j) s2 += (v[j].x * v[j].x + v[j].y * v[j].y) + (v[j].z * v[j].z + v[j].w * v[j].w);
            const float r2 = 1.0f / sqrtf(wave_sum(s2) * (1.0f / DM) + EPS);
            v2u* ho = (v2u*)(H + (size_t)m * DM) + lane;
#pragma unroll
            for (int j = 0; j < 4; ++j) { const f32x4 g = ((const f32x4*)preg)[lane + 64 * j]; v2u w; w.x = pk2(v[j].x * r2 * g.x, v[j].y * r2 * g.y); w.y = pk2(v[j].z * r2 * g.z, v[j].w * r2 * g.w); ho[64 * j] = w; }
        }
    }
}
template <int DH, bool FOX>
__device__ __forceinline__ void attn_unit(char* lds, const bf16* Qp, int ldq, const bf16* Kp, int ldk, const bf16* Vp, int ldv, bf16* Op, int ldo,
                                          int qpos0, int nkt, int mask_from, const float* Fc, float scale, int tid) {
    constexpr int KS = DH + 8, VS = 72, NPASS = DH / 64, CPR = DH / 8;
    bf16* Ks = (bf16*)lds; bf16* Vt = Ks + 64 * KS;
    const int lane = tid & 63, wave = tid >> 6, li = lane & 15, qd = lane >> 4;
    bf16x8 qf[DH / 32];
    { const bf16* qrow = Qp + (size_t)(wave * 16 + li) * ldq;
#pragma unroll
      for (int ks = 0; ks < DH / 32; ++ks) { const v4u w = *(const v4u*)(qrow + 32 * ks + 8 * qd); const float qs = scale * 1.4426950408889634f;
          v4u o; o.x = pk2(bflo(w.x) * qs, bfhi(w.x) * qs); o.y = pk2(bflo(w.y) * qs, bfhi(w.y) * qs); o.z = pk2(bflo(w.z) * qs, bfhi(w.z) * qs); o.w = pk2(bflo(w.w) * qs, bfhi(w.w) * qs);
          qf[ks] = __builtin_bit_cast(bf16x8, o); } }
    const int qpos = qpos0 + wave * 16 + li;
    f32x4 oacc[DH / 16];
#pragma unroll
    for (int i = 0; i < DH / 16; ++i) oacc[i] = (f32x4){0.f, 0.f, 0.f, 0.f};
    float mrun = -INFINITY, lsum = 0.f;
    v4u kregA[NPASS], vregA[NPASS], kregB[NPASS], vregB[NPASS];
    const bf16* kbase = Kp + (size_t)(tid / CPR) * ldk + (tid % CPR) * 8;
    const bf16* vbase = Vp + (size_t)(tid >> 3) * ldv + (tid & 7) * 8;
#define ATTN_PREFETCH(KR, VR, T) do { if ((T) < nkt) { _Pragma("unroll") for (int ps = 0; ps < NPASS; ++ps) { \
        KR[ps] = *(const v4u*)(kbase + (size_t)((T) * 64 + ps * (NTHR / CPR)) * ldk); VR[ps] = *(const v4u*)(vbase + (size_t)(ps * 64) * ldv + (T) * 64); } } } while (0)
    constexpr int PD = (DH == 64) ? 2 : 1;
    auto& kreg2 = *(PD == 2 ? &kregB : &kregA); auto& vreg2 = *(PD == 2 ? &vregB : &vregA);
    ATTN_PREFETCH(kregA, vregA, 0);
    if (PD == 2) ATTN_PREFETCH(kregB, vregB, 1);
    for (int kt2 = 0; kt2 < nkt; kt2 += 2) {
#define KR kregA
#define VR vregA
      { const int kt = kt2;
        __syncthreads();
#pragma unroll
        for (int ps = 0; ps < NPASS; ++ps) { const int c = tid + NTHR * ps, key = c / CPR, dc = c % CPR;
            *(v4u*)(Ks + key * KS + dc * 8) = KR[ps];
            *(v4u*)(Vt + (c >> 3) * VS + (c & 7) * 8) = VR[ps]; }
        __syncthreads();
        ATTN_PREFETCH(KR, VR, kt + PD);
        f32x4 s[4];
#pragma unroll
        for (int kb = 0; kb < 4; ++kb) { s[kb] = FOX ? *(const f32x4*)(Fc + kt * 64 + 16 * kb + 4 * qd) : (f32x4){0.f, 0.f, 0.f, 0.f};
#pragma unroll
            for (int ks = 0; ks < DH / 32; ++ks) { const bf16x8 a = *(const bf16x8*)(Ks + (16 * kb + li) * KS + 32 * ks + 8 * qd); s[kb] = __builtin_amdgcn_mfma_f32_16x16x32_bf16(a, qf[ks], s[kb], 0, 0, 0); } }
        float tmax = -INFINITY;
#pragma unroll
        for (int kb = 0; kb < 4; ++kb)
#pragma unroll
            for (int i = 0; i < 4; ++i) { float v = s[kb][i];
                if (FOX && kt >= mask_from) { const int key = kt * 64 + 16 * kb + 4 * qd + i; if (key > qpos) v = -INFINITY; s[kb][i] = v; }
                tmax = fmaxf(tmax, v); }
        tmax = fmaxf(tmax, __shfl_xor(tmax, 16)); tmax = fmaxf(tmax, __shfl_xor(tmax, 32));
        const float mnew = fmaxf(mrun, tmax);
        const float alpha = __builtin_amdgcn_exp2f(mrun - mnew);
        mrun = mnew;
        float psum = 0.f;
#pragma unroll
        for (int kb = 0; kb < 4; ++kb)
#pragma unroll
            for (int i = 0; i < 4; ++i) { const float e = __builtin_amdgcn_exp2f(s[kb][i] - mnew); s[kb][i] = e; psum += e; }
        lsum = lsum * alpha + psum;
#pragma unroll
        for (int i = 0; i < DH / 16; ++i) oacc[i] *= alpha;
        bf16x8 pf[2];
#pragma unroll
        for (int kk = 0; kk < 2; ++kk) { v4u w; w.x = pk2(s[2 * kk][0], s[2 * kk][1]); w.y = pk2(s[2 * kk][2], s[2 * kk][3]); w.z = pk2(s[2 * kk + 1][0], s[2 * kk + 1][1]); w.w = pk2(s[2 * kk + 1][2], s[2 * kk + 1][3]);
            pf[kk] = __builtin_bit_cast(bf16x8, w); }
#pragma unroll
        for (int db = 0; db < DH / 16; ++db)
#pragma unroll
            for (int kk = 0; kk < 2; ++kk) { const bf16* vp = Vt + (16 * db + li) * VS + 32 * kk + 4 * qd;
                const v2u lo = *(const v2u*)vp, hi = *(const v2u*)(vp + 16);
                v4u w; w.x = lo.x; w.y = lo.y; w.z = hi.x; w.w = hi.y;
                oacc[db] = __builtin_amdgcn_mfma_f32_16x16x32_bf16(__builtin_bit_cast(bf16x8, w), pf[kk], oacc[db], 0, 0, 0); }
      }
#undef KR
#undef VR
#define KR kreg2
#define VR vreg2
      { const int kt = kt2 + 1;
        __syncthreads();
#pragma unroll
        for (int ps = 0; ps < NPASS; ++ps) { const int c = tid + NTHR * ps, key = c / CPR, dc = c % CPR;
            *(v4u*)(Ks + key * KS + dc * 8) = KR[ps];
            *(v4u*)(Vt + (c >> 3) * VS + (c & 7) * 8) = VR[ps]; }
        __syncthreads();
        ATTN_PREFETCH(KR, VR, kt + PD);
        f32x4 s[4];
#pragma unroll
        for (int kb = 0; kb < 4; ++kb) { s[kb] = FOX ? *(const f32x4*)(Fc + kt * 64 + 16 * kb + 4 * qd) : (f32x4){0.f, 0.f, 0.f, 0.f};
#pragma unroll
            for (int ks = 0; ks < DH / 32; ++ks) { const bf16x8 a = *(const bf16x8*)(Ks + (16 * kb + li) * KS + 32 * ks + 8 * qd); s[kb] = __builtin_amdgcn_mfma_f32_16x16x32_bf16(a, qf[ks], s[kb], 0, 0, 0); } }
        float tmax = -INFINITY;
#pragma unroll
        for (int kb = 0; kb < 4; ++kb)
#pragma unroll
            for (int i = 0; i < 4; ++i) { float v = s[kb][i];
                if (FOX && kt >= mask_from) { const int key = kt * 64 + 16 * kb + 4 * qd + i; if (key > qpos) v = -INFINITY; s[kb][i] = v; }
                tmax = fmaxf(tmax, v); }
        tmax = fmaxf(tmax, __shfl_xor(tmax, 16)); tmax = fmaxf(tmax, __shfl_xor(tmax, 32));
        const float mnew = fmaxf(mrun, tmax);
        const float alpha = __builtin_amdgcn_exp2f(mrun - mnew);
        mrun = mnew;
        float psum = 0.f;
#pragma unroll
        for (int kb = 0; kb < 4; ++kb)
#pragma unroll
            for (int i = 0; i < 4; ++i) { const float e = __builtin_amdgcn_exp2f(s[kb][i] - mnew); s[kb][i] = e; psum += e; }
        lsum = lsum * alpha + psum;
#pragma unroll
        for (int i = 0; i < DH / 16; ++i) oacc[i] *= alpha;
        bf16x8 pf[2];
#pragma unroll
        for (int kk = 0; kk < 2; ++kk) { v4u w; w.x = pk2(s[2 * kk][0], s[2 * kk][1]); w.y = pk2(s[2 * kk][2], s[2 * kk][3]); w.z = pk2(s[2 * kk + 1][0], s[2 * kk + 1][1]); w.w = pk2(s[2 * kk + 1][2], s[2 * kk + 1][3]);
            pf[kk] = __builtin_bit_cast(bf16x8, w); }
#pragma unroll
        for (int db = 0; db < DH / 16; ++db)
#pragma unroll
            for (int kk = 0; kk < 2; ++kk) { const bf16* vp = Vt + (16 * db + li) * VS + 32 * kk + 4 * qd;
                const v2u lo = *(const v2u*)vp, hi = *(const v2u*)(vp + 16);
                v4u w; w.x = lo.x; w.y = lo.y; w.z = hi.x; w.w = hi.y;
                oacc[db] = __builtin_amdgcn_mfma_f32_16x16x32_bf16(__builtin_bit_cast(bf16x8, w), pf[kk], oacc[db], 0, 0, 0); }
      }
#undef KR
#undef VR
    }
#undef ATTN_PREFETCH
    lsum += __shfl_xor(lsum, 16); lsum += __shfl_xor(lsum, 32);
    const float inv = 1.0f / lsum;
    bf16* orow = Op + (size_t)(wave * 16 + li) * ldo + 4 * qd;
#pragma unroll
    for (int db = 0; db < DH / 16; ++db) { v2u w; w.x = pk2(oacc[db][0] * inv, oacc[db][1] * inv); w.y = pk2(oacc[db][2] * inv, oacc[db][3] * inv); *(v2u*)(orow + 16 * db) = w; }
}
__device__ __forceinline__ void fox_cumsum(const bf16* P, int b, int h, float fb, float* Fc, float* red, int tid) {
    const int lane = tid & 63, wave = tid >> 6;
    float lf[4];
#pragma unroll
    for (int i = 0; i < 4; ++i) { const float z = bf2f(P[(size_t)(b * SEQ + 4 * tid + i) * LDP + PC_FF + h]) + fb; lf[i] = logsig(z); }
    const float loc = (lf[0] + lf[1]) + (lf[2] + lf[3]);
    float inc = loc;
#pragma unroll
    for (int o = 1; o < 64; o <<= 1) { const float t = __shfl_up(inc, o); if (lane >= o) inc += t; }
    __syncthreads();
    if (lane == 63) red[wave] = inc;
    __syncthreads();
    float off = inc - loc;
    for (int w = 0; w < wave; ++w) off += red[w];
    float run = off;
#pragma unroll
    for (int i = 0; i < 4; ++i) { run += lf[i]; Fc[4 * tid + i] = -run * 1.4426950408889634f; }
    __syncthreads();
}
__device__ __forceinline__ void s5_load_u(const bf16* P, int row0, int g, float* us, int lane) {
    const v4u* src = (const v4u*)(P + (size_t)(row0 + lane) * LDP + PC_SU + g * 16);
    const v4u a = src[0], c = src[1];
    f32x4* dst = (f32x4*)(us + lane * 16);
    dst[0] = (f32x4){bflo(a.x), bfhi(a.x), bflo(a.y), bfhi(a.y)}; dst[1] = (f32x4){bflo(a.z), bfhi(a.z), bflo(a.w), bfhi(a.w)};
    dst[2] = (f32x4){bflo(c.x), bfhi(c.x), bflo(c.y), bfhi(c.y)}; dst[3] = (f32x4){bflo(c.z), bfhi(c.z), bflo(c.w), bfhi(c.w)};
    LDS_WAIT();
}
__device__ __forceinline__ void s5_bu(const float* us, int t, const float (&bre)[16], const float (&bim)[16], float& bur, float& bui) {
    const f32x4* up = (const f32x4*)(us + t * 16);
    bur = 0.f; bui = 0.f;
#pragma unroll
    for (int q = 0; q < 4; ++q) { const f32x4 u4 = up[q];
#pragma unroll
        for (int j = 0; j < 4; ++j) { bur += bre[4 * q + j] * u4[j]; bui += bim[4 * q + j] * u4[j]; } }
}
__device__ __forceinline__ void s5_passA(unsigned char* ws, const float* const* tab, char* lds, int gw, int NGW, int wave, int lane) {
    const bf16* P = (const bf16*)(ws + WS_P);
    const float2* ABAR = (const float2*)(ws + WS_S5P + S5P_ABAR); const float2* BBAR = (const float2*)(ws + WS_S5P + S5P_BBAR);
    float* L = (float*)(ws + WS_S5L);
    float* us = (float*)(lds + wave * 4096);
    for (int u = gw; u < 4096; u += NGW) {
        const int n = u & 31, g = (u >> 5) & 15, b = u >> 9;
        LDS_WAIT();
        s5_load_u(P, b * SEQ + n * 64, g, us, lane);
        float bre[16], bim[16];
#pragma unroll
        for (int h = 0; h < 16; ++h) { const float2 v = BBAR[(g * 64 + lane) * 16 + h]; bre[h] = v.x; bim[h] = v.y; }
        const float2 ab = ABAR[g * 64 + lane];
        float xr = 0.f, xi = 0.f;
        for (int t = 0; t < 64; ++t) { float bur, bui; s5_bu(us, t, bre, bim, bur, bui);
            const float nr = ab.x * xr - ab.y * xi + bur, ni = ab.x * xi + ab.y * xr + bui; xr = nr; xi = ni; }
        L[(size_t)u * 128 + lane] = xr; L[(size_t)u * 128 + 64 + lane] = xi;
    }
}
__device__ __forceinline__ void s5_passC(unsigned char* ws, const float* const* tab, int l, char* lds, int unit, int tid) {
    const int lane = tid & 63, wave = tid >> 6, li = lane & 15, qd = lane >> 4;
    const int b = unit >> 5, n = unit & 31, row0 = b * SEQ + n * 64;
    const bf16* P = (const bf16*)(ws + WS_P);
    const float2* ABAR = (const float2*)(ws + WS_S5P + S5P_ABAR); const float2* A64 = (const float2*)(ws + WS_S5P + S5P_A64);
    const float2* BBAR = (const float2*)(ws + WS_S5P + S5P_BBAR); const bf16* CMAT = (const bf16*)(ws + WS_S5P + S5P_CMAT);
    const float* L = (const float*)(ws + WS_S5L);
    bf16* Xs = (bf16*)(lds + wave * 8704);
    float* us = (float*)(lds + 69632 + wave * 4096);
    bf16* Ys = (bf16*)(lds + 102400);
    __syncthreads();
    for (int gi = 0; gi < 2; ++gi) {
        const int g = 2 * wave + gi;
        LDS_WAIT();
        s5_load_u(P, row0, g, us, lane);
        float xr = 0.f, xi = 0.f;
        { const float2 a64 = A64[g * 64 + lane]; const float* Lb = L + (size_t)((b * 16 + g) * 32) * 128 + lane;
          for (int m0 = 0; m0 < n; m0 += 8) { float lr[8], lim[8];
#pragma unroll
              for (int j = 0; j < 8; ++j) { const bool ok = (m0 + j) < n; const int mi = ok ? (m0 + j) : 0; lr[j] = Lb[mi * 128]; lim[j] = Lb[mi * 128 + 64]; if (!ok) { lr[j] = __builtin_nanf(""); } }
#pragma unroll
              for (int j = 0; j < 8; ++j) { if (lr[j] == lr[j]) { const float nr = a64.x * xr - a64.y * xi + lr[j], ni = a64.x * xi + a64.y * xr + lim[j]; xr = nr; xi = ni; } } } }
        float bre[16], bim[16];
#pragma unroll
        for (int h = 0; h < 16; ++h) { const float2 v = BBAR[(g * 64 + lane) * 16 + h]; bre[h] = v.x; bim[h] = v.y; }
        const float2 ab = ABAR[g * 64 + lane];
        bf16x8 cfr[4];
#pragma unroll
        for (int ks = 0; ks < 4; ++ks) cfr[ks] = *(const bf16x8*)(CMAT + ((size_t)((g * 4 + ks) * 64 + lane)) * 8);
        const float dsk = tab[19][l * 256 + g * 16 + li];
        for (int half = 0; half < 2; ++half) {
            for (int tt = 0; tt < 32; ++tt) { const int t = half * 32 + tt; float bur, bui; s5_bu(us, t, bre, bim, bur, bui);
                const float nr = ab.x * xr - ab.y * xi + bur, ni = ab.x * xi + ab.y * xr + bui; xr = nr; xi = ni;
                Xs[tt * 136 + lane] = (bf16)f2bf(xr); Xs[tt * 136 + 64 + lane] = (bf16)f2bf(xi); }
            LDS_WAIT();
#pragma unroll
            for (int rb = 0; rb < 2; ++rb) { f32x4 acc = (f32x4){0.f, 0.f, 0.f, 0.f};
#pragma unroll
                for (int ks = 0; ks < 4; ++ks) { const bf16x8 a = *(const bf16x8*)(Xs + (16 * rb + li) * 136 + 32 * ks + 8 * qd); acc = __builtin_amdgcn_mfma_f32_16x16x32_bf16(a, cfr[ks], acc, 0, 0, 0); }
#pragma unroll
                for (int i = 0; i < 4; ++i) { const int t = half * 32 + 16 * rb + 4 * qd + i; const float yv = gelu_tanh(acc[i] + dsk * us[t * 16 + li]); Ys[t * 264 + g * 16 + li] = (bf16)f2bf(yv); } }
            LDS_WAIT();
        }
    }
    __syncthreads();
    { const bf16* Wg = (const bf16*)(ws + WS_W) + WO_GLU; const float* gb = tab[21] + l * 256; bf16* BRS = (bf16*)(ws + WS_BRS);
      f32x4 acc[4][2];
#pragma unroll
      for (int rb = 0; rb < 4; ++rb) { acc[rb][0] = (f32x4){0.f, 0.f, 0.f, 0.f}; acc[rb][1] = (f32x4){0.f, 0.f, 0.f, 0.f}; }
#pragma unroll
      for (int ks = 0; ks < 8; ++ks) { bf16x8 bfr[2];
#pragma unroll
          for (int cb = 0; cb < 2; ++cb) bfr[cb] = *(const bf16x8*)(Wg + (size_t)(32 * wave + 16 * cb + li) * 256 + 32 * ks + 8 * qd);
#pragma unroll
          for (int rb = 0; rb < 4; ++rb) { const bf16x8 a = *(const bf16x8*)(Ys + (16 * rb + li) * 264 + 32 * ks + 8 * qd);
#pragma unroll
              for (int cb = 0; cb < 2; ++cb) acc[rb][cb] = __builtin_amdgcn_mfma_f32_16x16x32_bf16(a, bfr[cb], acc[rb][cb], 0, 0, 0); } }
#pragma unroll
      for (int rb = 0; rb < 4; ++rb)
#pragma unroll
          for (int cb = 0; cb < 2; ++cb) { const int col = 32 * wave + 16 * cb + li; const float bias = gb[col];
#pragma unroll
              for (int i = 0; i < 4; ++i) { const int t = 16 * rb + 4 * qd + i; const float yv = bf2f(Ys[t * 264 + col]); const float o = yv * sigmoidf_(acc[rb][cb][i] + bias);
                  BRS[(size_t)(row0 + t) * 256 + col] = (bf16)f2bf(o); } } }
    __syncthreads();
}
struct GlaLds { float* QF; float* QI; float* KI; float* KE; float* G; float* V; float* AT; float* SP; float* GD; };
__device__ __forceinline__ GlaLds gla_lds(char* lds) { GlaLds s; float* f = (float*)lds; s.QF = f; s.QI = f + 2112; s.KI = f + 4224; s.KE = f + 6336; s.G = f + 8448; s.V = f + 10560; s.AT = f + 14656; s.SP = f + 18816; s.GD = f + 20864; return s; }
__device__ __forceinline__ void gla_load(unsigned char* ws, const float* const* tab, int l, const GlaLds& s, int row0, int h, int tid, bool need_q) {
    const bf16* P = (const bf16*)(ws + WS_P);
    const int t = tid >> 3, c8 = tid & 7;
    const bf16* prow = P + (size_t)(row0 + t) * LDP;
    if (need_q) { const v2u w = *(const v2u*)(prow + PC_GQ + h * 32 + 4 * c8); float* d = s.QF + t * 33 + 4 * c8; d[0] = bflo(w.x); d[1] = bfhi(w.x); d[2] = bflo(w.y); d[3] = bfhi(w.y); }
    { const v2u w = *(const v2u*)(prow + PC_GK + h * 32 + 4 * c8); float* d = s.KI + t * 33 + 4 * c8; d[0] = bflo(w.x); d[1] = bfhi(w.x); d[2] = bflo(w.y); d[3] = bfhi(w.y); }
    { const v4u w = *(const v4u*)(prow + PC_GV + h * 64 + 8 * c8); f32x4* d = (f32x4*)(s.V + t * 64 + 8 * c8); d[0] = (f32x4){bflo(w.x), bfhi(w.x), bflo(w.y), bfhi(w.y)}; d[1] = (f32x4){bflo(w.z), bfhi(w.z), bflo(w.w), bfhi(w.w)}; }
    if (tid < 128) { const int tt = tid >> 1, hf = tid & 1; const v4u w = *(const v4u*)(P + (size_t)(row0 + tt) * LDP + PC_GD + 8 * hf); float* d = s.GD + tt * 16 + 8 * hf;
        d[0] = bflo(w.x); d[1] = bfhi(w.x); d[2] = bflo(w.y); d[3] = bfhi(w.y); d[4] = bflo(w.z); d[5] = bfhi(w.z); d[6] = bflo(w.w); d[7] = bfhi(w.w); }
    __syncthreads();
    const float* gw = tab[8] + l * 2048; const float* gbias = tab[9] + l * 128;
#pragma unroll
    for (int i = 0; i < 4; ++i) { const int d = 4 * c8 + i; float z = gbias[h * 32 + d];
#pragma unroll
        for (int r = 0; r < 16; ++r) z += s.GD[t * 16 + r] * gw[r * 128 + h * 32 + d];
        s.G[t * 33 + d] = logsig(z) * (1.0f / 16.0f); }
    __syncthreads();
    if (tid < 32) { float v[64];
#pragma unroll
        for (int tt = 0; tt < 64; ++tt) v[tt] = s.G[tt * 33 + tid];
#pragma unroll
        for (int tt = 1; tt < 64; ++tt) v[tt] += v[tt - 1];
#pragma unroll
        for (int tt = 0; tt < 64; ++tt) s.G[tt * 33 + tid] = v[tt]; }
    __syncthreads();
}
__device__ __forceinline__ void gla_passA(unsigned char* ws, const float* const* tab, int l, char* lds, int unit, int tid) {
    const GlaLds s = gla_lds(lds);
    const int b = unit >> 5, n = unit & 31, row0 = b * SEQ + n * 64;
    float* DS = (float*)(ws + WS_DS); float* DEC = (float*)(ws + WS_DEC);
    __syncthreads();
    for (int h = 0; h < 4; ++h) {
        gla_load(ws, tab, l, s, row0, h, tid, false);
        { const int t = tid >> 3, c8 = tid & 7;
#pragma unroll
          for (int i = 0; i < 4; ++i) { const int d = 4 * c8 + i; s.KI[t * 33 + d] *= expf(s.G[63 * 33 + d] - s.G[t * 33 + d]); } }
        __syncthreads();
        { const int d = tid >> 4, e0 = 4 * (tid & 15); f32x4 acc = (f32x4){0.f, 0.f, 0.f, 0.f};
          for (int c = 0; c < 64; ++c) acc += s.KI[c * 33 + d] * *(const f32x4*)(s.V + c * 64 + e0);
          const size_t ub = (size_t)((b * 4 + h) * 32 + n);
          *(f32x4*)(DS + ub * 2048 + d * 64 + e0) = acc;
          if ((tid & 15) == 0) DEC[ub * 32 + d] = expf(s.G[63 * 33 + d]); }
        __syncthreads();
    }
}
__device__ __forceinline__ void gla_passC(unsigned char* ws, const float* const* tab, int l, char* lds, int unit, int tid) {
    const GlaLds s = gla_lds(lds);
    const int b = unit >> 5, n = unit & 31, row0 = b * SEQ + n * 64;
    const float* DS = (const float*)(ws + WS_DS); const float* DEC = (const float*)(ws + WS_DEC);
    const bf16* P = (const bf16*)(ws + WS_P); bf16* BRG = (bf16*)(ws + WS_BRG);
    const float* gn = tab[10] + l * 256;
    __syncthreads();
    for (int h = 0; h < 4; ++h) {
        gla_load(ws, tab, l, s, row0, h, tid, true);
        { const int t = tid >> 3, c8 = tid & 7;
#pragma unroll
          for (int i = 0; i < 4; ++i) { const int d = 4 * c8 + i; const float g = s.G[t * 33 + d]; const float eg = expf(g), ieg = expf(-g);
              const float q = s.QF[t * 33 + d] * 0.17677669529663687f, k = s.KI[t * 33 + d];
              s.QF[t * 33 + d] = q * eg; s.QI[t * 33 + d] = q * ieg; s.KI[t * 33 + d] = k * ieg; s.KE[t * 33 + d] = k * eg; } }
        __syncthreads();
        { const int i = tid >> 3, jb = tid & 7;
#pragma unroll
          for (int jj = 0; jj < 8; ++jj) { const int j = jb + 8 * jj; const float* qa = (j <= i) ? s.QF : s.QI; const float* kb = (j <= i) ? s.KI : s.KE; float dot = 0.f;
#pragma unroll
              for (int d = 0; d < 32; ++d) dot += qa[i * 33 + d] * kb[j * 33 + d];
              s.AT[i * 65 + j] = dot; } }
        { const int idx4 = tid * 4, d = idx4 >> 6; f32x4 S = (f32x4){0.f, 0.f, 0.f, 0.f};
          const float* base = DS + (size_t)((b * 4 + h) * 32) * 2048 + idx4; const float* decb = DEC + (size_t)((b * 4 + h) * 32) * 32 + d;
          for (int m0 = 0; m0 < n; m0 += 8) { f32x4 v[8]; float dd[8];
#pragma unroll
              for (int j = 0; j < 8; ++j) { const bool ok = (m0 + j) < n; const int mi = ok ? (m0 + j) : 0; v[j] = *(const f32x4*)(base + (size_t)mi * 2048); dd[j] = decb[mi * 32];
                  if (!ok) { v[j] = (f32x4){0.f, 0.f, 0.f, 0.f}; dd[j] = 1.0f; } }
#pragma unroll
              for (int j = 0; j < 8; ++j) S = S * dd[j] + v[j]; }
          *(f32x4*)(s.SP + idx4) = S; }
        __syncthreads();
        { const int i = tid >> 3, e0 = 8 * (tid & 7); f32x4 a0 = (f32x4){0.f, 0.f, 0.f, 0.f}, a1 = a0;
          for (int j = 0; j < 64; ++j) { const float a = s.AT[i * 65 + j]; a0 += a * *(const f32x4*)(s.V + j * 64 + e0); a1 += a * *(const f32x4*)(s.V + j * 64 + e0 + 4); }
          for (int d = 0; d < 32; ++d) { const float a = s.QF[i * 33 + d]; a0 += a * *(const f32x4*)(s.SP + d * 64 + e0); a1 += a * *(const f32x4*)(s.SP + d * 64 + e0 + 4); }
          float ss = (a0[0] * a0[0] + a0[1] * a0[1]) + (a0[2] * a0[2] + a0[3] * a0[3]) + (a1[0] * a1[0] + a1[1] * a1[1]) + (a1[2] * a1[2] + a1[3] * a1[3]);
          ss += __shfl_xor(ss, 1); ss += __shfl_xor(ss, 2); ss += __shfl_xor(ss, 4);
          const float r = 1.0f / sqrtf(ss * (1.0f / 64.0f) + EPS);
          const v4u gr = *(const v4u*)(P + (size_t)(row0 + i) * LDP + PC_GR + h * 64 + e0);
          const float grv[8] = {bflo(gr.x), bfhi(gr.x), bflo(gr.y), bfhi(gr.y), bflo(gr.z), bfhi(gr.z), bflo(gr.w), bfhi(gr.w)};
          float o[8];
#pragma unroll
          for (int k = 0; k < 8; ++k) { const float v = (k < 4 ? a0[k & 3] : a1[k & 3]) * r * gn[h * 64 + e0 + k]; const float gg = grv[k]; o[k] = v * gg * sigmoidf_(gg); }
          v4u w; w.x = pk2(o[0], o[1]); w.y = pk2(o[2], o[3]); w.z = pk2(o[4], o[5]); w.w = pk2(o[6], o[7]);
          *(v4u*)(BRG + (size_t)(row0 + i) * 256 + h * 64 + e0) = w; }
        __syncthreads();
    }
}

__device__ __forceinline__ void gla_passC_mfma(unsigned char* ws, const float* const* tab, int l, char* lds, int unit, int tid) {
    const int b = unit >> 5, n = unit & 31, row0 = b * SEQ + n * 64;
    const float* DS = (const float*)(ws + WS_DS); const float* DEC = (const float*)(ws + WS_DEC);
    const bf16* P = (const bf16*)(ws + WS_P); bf16* BRG = (bf16*)(ws + WS_BRG);
    const float* gn = tab[10] + l * 256; const float* gw = tab[8] + l * 2048; const float* gbias = tab[9] + l * 128;
    const int lane = tid & 63, wave = tid >> 6, li = lane & 15, qd = lane >> 4;
    const int slot = tid >> 8, st = tid & 255, t = st >> 2, c4 = st & 3, wr = wave & 3;
    char* sb = lds + slot * 52480;
    bf16* QFb = (bf16*)sb; bf16* QIb = QFb + 2560; bf16* KIb = QIb + 2560; bf16* KEb = KIb + 2560;
    bf16* Vt = (bf16*)(sb + 20480); bf16* ATb = (bf16*)(sb + 29696); bf16* SPt = (bf16*)(sb + 38912); float* Gs = (float*)(sb + 44032);
    float* GD = (float*)(lds + 104960);
    __syncthreads();
    if (tid < 128) { const int tt = tid >> 1, hf = tid & 1; const v4u w = *(const v4u*)(P + (size_t)(row0 + tt) * LDP + PC_GD + 8 * hf); float* d = GD + tt * 16 + 8 * hf;
        d[0] = bflo(w.x); d[1] = bfhi(w.x); d[2] = bflo(w.y); d[3] = bfhi(w.y); d[4] = bflo(w.z); d[5] = bfhi(w.z); d[6] = bflo(w.w); d[7] = bfhi(w.w); }
    for (int hp = 0; hp < 2; ++hp) {
        const int h = 2 * hp + slot;
        const bf16* prow = P + (size_t)(row0 + t) * LDP;
        const v4u qw = *(const v4u*)(prow + PC_GQ + h * 32 + 8 * c4);
        const v4u kw = *(const v4u*)(prow + PC_GK + h * 32 + 8 * c4);
        { const v4u v0 = *(const v4u*)(prow + PC_GV + h * 64 + 16 * c4), v1 = *(const v4u*)(prow + PC_GV + h * 64 + 16 * c4 + 8);
          bf16* vt = Vt + (16 * c4) * 72 + t;
          vt[0 * 72] = (bf16)(v0.x & 0xffffu); vt[1 * 72] = (bf16)(v0.x >> 16); vt[2 * 72] = (bf16)(v0.y & 0xffffu); vt[3 * 72] = (bf16)(v0.y >> 16);
          vt[4 * 72] = (bf16)(v0.z & 0xffffu); vt[5 * 72] = (bf16)(v0.z >> 16); vt[6 * 72] = (bf16)(v0.w & 0xffffu); vt[7 * 72] = (bf16)(v0.w >> 16);
          vt[8 * 72] = (bf16)(v1.x & 0xffffu); vt[9 * 72] = (bf16)(v1.x >> 16); vt[10 * 72] = (bf16)(v1.y & 0xffffu); vt[11 * 72] = (bf16)(v1.y >> 16);
          vt[12 * 72] = (bf16)(v1.z & 0xffffu); vt[13 * 72] = (bf16)(v1.z >> 16); vt[14 * 72] = (bf16)(v1.w & 0xffffu); vt[15 * 72] = (bf16)(v1.w >> 16); }
        __syncthreads();
#pragma unroll
        for (int i = 0; i < 8; ++i) { const int d = 8 * c4 + i; float z = gbias[h * 32 + d];
#pragma unroll
            for (int r = 0; r < 16; ++r) z += GD[t * 16 + r] * gw[r * 128 + h * 32 + d];
            Gs[t * 33 + d] = logsig(z) * (1.0f / 16.0f); }
        __syncthreads();
        if (st < 32) { float v[64];
#pragma unroll
            for (int tt = 0; tt < 64; ++tt) v[tt] = Gs[tt * 33 + st];
#pragma unroll
            for (int tt = 1; tt < 64; ++tt) v[tt] += v[tt - 1];
#pragma unroll
            for (int tt = 0; tt < 64; ++tt) Gs[tt * 33 + st] = v[tt]; }
        __syncthreads();
        { const float qv[8] = {bflo(qw.x), bfhi(qw.x), bflo(qw.y), bfhi(qw.y), bflo(qw.z), bfhi(qw.z), bflo(qw.w), bfhi(qw.w)};
          const float kv[8] = {bflo(kw.x), bfhi(kw.x), bflo(kw.y), bfhi(kw.y), bflo(kw.z), bfhi(kw.z), bflo(kw.w), bfhi(kw.w)};
          float qf[8], qi[8], ki[8], ke[8];
#pragma unroll
          for (int i = 0; i < 8; ++i) { const float g = Gs[t * 33 + 8 * c4 + i]; const float eg = expf(g), ieg = expf(-g); const float q = qv[i] * 0.17677669529663687f;
              qf[i] = q * eg; qi[i] = q * ieg; ki[i] = kv[i] * ieg; ke[i] = kv[i] * eg; }
          v4u w;
          w.x = pk2(qf[0], qf[1]); w.y = pk2(qf[2], qf[3]); w.z = pk2(qf[4], qf[5]); w.w = pk2(qf[6], qf[7]); *(v4u*)(QFb + t * 40 + 8 * c4) = w;
          w.x = pk2(qi[0], qi[1]); w.y = pk2(qi[2], qi[3]); w.z = pk2(qi[4], qi[5]); w.w = pk2(qi[6], qi[7]); *(v4u*)(QIb + t * 40 + 8 * c4) = w;
          w.x = pk2(ki[0], ki[1]); w.y = pk2(ki[2], ki[3]); w.z = pk2(ki[4], ki[5]); w.w = pk2(ki[6], ki[7]); *(v4u*)(KIb + t * 40 + 8 * c4) = w;
          w.x = pk2(ke[0], ke[1]); w.y = pk2(ke[2], ke[3]); w.z = pk2(ke[4], ke[5]); w.w = pk2(ke[6], ke[7]); *(v4u*)(KEb + t * 40 + 8 * c4) = w; }
        { const int idx8 = st * 8, d = idx8 >> 6, e0 = idx8 & 63; f32x4 S0 = (f32x4){0.f, 0.f, 0.f, 0.f}, S1 = S0;
          const float* base = DS + (size_t)((b * 4 + h) * 32) * 2048 + idx8; const float* decb = DEC + (size_t)((b * 4 + h) * 32) * 32 + d;
          for (int m0 = 0; m0 < n; m0 += 4) { f32x4 va[4], vb[4]; float dd[4];
#pragma unroll
              for (int j = 0; j < 4; ++j) { const bool ok = (m0 + j) < n; const int mi = ok ? (m0 + j) : 0; va[j] = *(const f32x4*)(base + (size_t)mi * 2048); vb[j] = *(const f32x4*)(base + (size_t)mi * 2048 + 4); dd[j] = decb[mi * 32];
                  if (!ok) { va[j] = (f32x4){0.f, 0.f, 0.f, 0.f}; vb[j] = va[j]; dd[j] = 1.0f; } }
#pragma unroll
              for (int j = 0; j < 4; ++j) { S0 = S0 * dd[j] + va[j]; S1 = S1 * dd[j] + vb[j]; } }
#pragma unroll
          for (int i = 0; i < 4; ++i) { SPt[(e0 + i) * 40 + d] = (bf16)f2bf(S0[i]); SPt[(e0 + 4 + i) * 40 + d] = (bf16)f2bf(S1[i]); } }
        __syncthreads();
        { const bf16x8 aqf = *(const bf16x8*)(QFb + (16 * wr + li) * 40 + 8 * qd), aqi = *(const bf16x8*)(QIb + (16 * wr + li) * 40 + 8 * qd);
#pragma unroll
          for (int cb = 0; cb < 4; ++cb) { const bf16x8 bki = *(const bf16x8*)(KIb + (16 * cb + li) * 40 + 8 * qd), bke = *(const bf16x8*)(KEb + (16 * cb + li) * 40 + 8 * qd);
              const f32x4 z4 = (f32x4){0.f, 0.f, 0.f, 0.f};
              const f32x4 af = __builtin_amdgcn_mfma_f32_16x16x32_bf16(aqf, bki, z4, 0, 0, 0), ab = __builtin_amdgcn_mfma_f32_16x16x32_bf16(aqi, bke, z4, 0, 0, 0);
#pragma unroll
              for (int r = 0; r < 4; ++r) { const int i = 16 * wr + 4 * qd + r, j = 16 * cb + li; ATb[i * 72 + j] = (bf16)f2bf(j <= i ? af[r] : ab[r]); } }
          LDS_WAIT();
          f32x4 oa[4];
#pragma unroll
          for (int cb = 0; cb < 4; ++cb) { oa[cb] = (f32x4){0.f, 0.f, 0.f, 0.f};
#pragma unroll
              for (int ks = 0; ks < 2; ++ks) { const bf16x8 a = *(const bf16x8*)(ATb + (16 * wr + li) * 72 + 32 * ks + 8 * qd), bv = *(const bf16x8*)(Vt + (16 * cb + li) * 72 + 32 * ks + 8 * qd);
                  oa[cb] = __builtin_amdgcn_mfma_f32_16x16x32_bf16(a, bv, oa[cb], 0, 0, 0); }
              const bf16x8 bs = *(const bf16x8*)(SPt + (16 * cb + li) * 40 + 8 * qd);
              oa[cb] = __builtin_amdgcn_mfma_f32_16x16x32_bf16(aqf, bs, oa[cb], 0, 0, 0); }
#pragma unroll
          for (int r = 0; r < 4; ++r) { float ss = (oa[0][r] * oa[0][r] + oa[1][r] * oa[1][r]) + (oa[2][r] * oa[2][r] + oa[3][r] * oa[3][r]);
              ss += __shfl_xor(ss, 1); ss += __shfl_xor(ss, 2); ss += __shfl_xor(ss, 4); ss += __shfl_xor(ss, 8);
              const float rs = 1.0f / sqrtf(ss * (1.0f / 64.0f) + EPS);
              const int i = 16 * wr + 4 * qd + r;
#pragma unroll
              for (int cb = 0; cb < 4; ++cb) { const int e = 16 * cb + li; const float gg = bf2f(P[(size_t)(row0 + i) * LDP + PC_GR + h * 64 + e]);
                  const float o = oa[cb][r] * rs * gn[h * 64 + e] * gg * sigmoidf_(gg);
                  BRG[(size_t)(row0 + i) * 256 + h * 64 + e] = (bf16)f2bf(o); } } }
        __syncthreads();
    }
}
__device__ __forceinline__ void gsync(unsigned char* wsb, unsigned G, int wave_s) {
    unsigned char* wl_ = wsb; asm volatile("" : "+s"(wl_)); unsigned* ctr = (unsigned*)(wl_ + 1024);
    int ln_; asm volatile("v_mbcnt_lo_u32_b32 %0, -1, 0\n\tv_mbcnt_hi_u32_b32 %0, -1, %0" : "=v"(ln_));
    const bool leader = (wave_s == 0) && (ln_ == 0);
    asm volatile("s_waitcnt vmcnt(0)" ::: "memory");
    __syncthreads();
    if (leader) {
        __builtin_amdgcn_fence(__ATOMIC_RELEASE, "agent");
        asm volatile("s_waitcnt vmcnt(0)" ::: "memory");
        const unsigned old = __hip_atomic_fetch_add(ctr, 1u, __ATOMIC_RELAXED, __HIP_MEMORY_SCOPE_AGENT);
        const unsigned want = (old | (G - 1u)) + 1u;
        while (__hip_atomic_load(ctr, __ATOMIC_RELAXED, __HIP_MEMORY_SCOPE_AGENT) < want) __builtin_amdgcn_s_sleep(2);
        __builtin_amdgcn_fence(__ATOMIC_ACQUIRE, "agent");
        asm volatile("s_waitcnt vmcnt(0)" ::: "memory");
    }
    __syncthreads();
}
__global__ void __launch_bounds__(NTHR, 2) fwd_mega(Params p) {
    extern __shared__ __attribute__((aligned(16))) unsigned char lds_raw[];
    char* lds = (char*)lds_raw;
    PG8_LAS unsigned char* ldsg = (PG8_LAS unsigned char*)lds_raw;
    cg::grid_group grid = cg::this_grid();
    constexpr int G = 256; const int bid = blockIdx.x;
    const int wave_s = __builtin_amdgcn_readfirstlane(threadIdx.x >> 6);
    const int NGW = G * NWAVES;
#define TIDS() int tid; { int ln_; asm volatile("v_mbcnt_lo_u32_b32 %0, -1, 0\n\tv_mbcnt_hi_u32_b32 %0, -1, %0" : "=v"(ln_)); tid = wave_s * 64 + ln_; } const int lane = tid & 63, wave = __builtin_amdgcn_readfirstlane(tid >> 6), gw = bid * NWAVES + wave; (void)lane; (void)gw
    if (threadIdx.x < 38) ((const float**)p.ws)[threadIdx.x] = threadIdx.x < 37 ? p.in[threadIdx.x] : (const float*)p.out;
    if (bid == 0 && threadIdx.x >= 64 && threadIdx.x < 128) ((unsigned*)(p.ws + 1024))[threadIdx.x - 64] = 0u;
    grid.sync();
#define PTRS() unsigned char* ws = p.ws; asm volatile("" : "+s"(ws)); const float* const* tab = (const float* const*)ws; (void)tab
#define GSYNC() gsync(p.ws, 256u, wave_s)
#define Wb ((bf16*)(ws + WS_W))
#define P ((bf16*)(ws + WS_P))
#define ACT ((bf16*)(ws + WS_P))
#define H ((bf16*)(ws + WS_H))
#define Y ((float*)(ws + WS_Y))
#define YB ((bf16*)(ws + WS_Y))
#define BRG ((bf16*)(ws + WS_BRG))
#define BRS ((bf16*)(ws + WS_BRS))
#define BRF ((bf16*)(ws + WS_BRF))
#define MIXB ((bf16*)(ws + WS_MIXB))
#define Qb ((bf16*)(ws + WS_Q))
#define XO ((bf16*)(ws + WS_XO))
#define KV ((bf16*)(ws + WS_KV))
#define MEMN ((bf16*)(ws + WS_MEMN))
#define X ((float*)tab[37])

#define GEMM(EpiT, epi, Ap, Bp, Mv, Nv, Kv) do { pg8::Gemm g_{(const pg8::bf16_t*)(Ap), (const pg8::bf16_t*)(Bp), (Mv), (Nv), (Kv)}; int bid_ = bid; const int G_ = G; asm volatile("" : "+s"(bid_)); pg8::StaticOrder S_; S_.init((Mv), (Nv), G_, bid_); \
        TIDS(); pg8::gemm_phase<EpiT, pg8::StaticOrder, true, true>(ldsg, g_, S_, epi, tid); __syncthreads(); } while (0)

    { PTRS(); TIDS();
#if EN_CONV
      convert_weights(ws, tab, 0, lds, gw, NGW, wave, lane);
      s5_prep(ws, tab, 0, bid * NTHR + tid, G * NTHR);
#if REP_CONV > 1
      convert_weights(ws, tab, 0, lds, gw, NGW, wave, lane);
#endif
#endif
      rowop<false, false, true>(tab[1], nullptr, nullptr, nullptr, 0.f, tab[28], MEMN, MMEM, gw, NGW, lane);
      rowop<false, true, true>(tab[0], X, nullptr, nullptr, 0.f, tab[2], H, MTOK, gw, NGW, lane); }
    GSYNC();

    for (int l = 0; l < DEPTH; ++l) {
        { PTRS(); pg8::EpiSwiGLU e{ACT, DFF}; GEMM(pg8::EpiSwiGLU, e, H, Wb + WO_GU1, MTOK, 5632, 1024); }
#if REP_GU > 1
        { PTRS(); pg8::EpiSwiGLU e{ACT, DFF}; GEMM(pg8::EpiSwiGLU, e, H, Wb + WO_GU1, MTOK, 5632, 1024); }
#endif
        GSYNC();
        { PTRS(); pg8::EpiBf16 e{YB, DM}; GEMM(pg8::EpiBf16, e, ACT, Wb + WO_DOWN1, MTOK, 1024, DFF); }
#if REP_DOWN > 1
        { PTRS(); pg8::EpiBf16 e{YB, DM}; GEMM(pg8::EpiBf16, e, ACT, Wb + WO_DOWN1, MTOK, 1024, DFF); }
#endif
        GSYNC();
        { PTRS(); TIDS(); rowop<true, true, true>(X, X, YB, tab[5] + l * DM, 0.5f, tab[6] + l * DM, H, MTOK, gw, NGW, lane); }
#if REP_ROW
        { PTRS(); TIDS(); rowop<true, true, true>(X, (float*)(ws + WS_P), YB, tab[5] + l * DM, 0.5f, tab[6] + l * DM, (bf16*)(ws + WS_P + 64 * MiB), MTOK, gw, NGW, lane); }
#endif
        GSYNC();
        { PTRS(); pg8::EpiBf16VT<0> e{P, LDP, (bf16*)(ws + WS_VT)}; GEMM(pg8::EpiBf16VT<0>, e, H, Wb + WO_IN, MTOK, LDP, 1024); }
#if REP_IN > 1
        { PTRS(); pg8::EpiBf16VT<0> e{P, LDP, (bf16*)(ws + WS_VT)}; GEMM(pg8::EpiBf16VT<0>, e, H, Wb + WO_IN, MTOK, LDP, 1024); }
#endif
        { PTRS(); pg8::EpiBf16VT<1> e{KV, 2048, (bf16*)(ws + WS_VTX)}; GEMM(pg8::EpiBf16VT<1>, e, MEMN, Wb + WO_KV, MMEM, 2048, 1024); }
#if REP_IN > 1
        { PTRS(); pg8::EpiBf16VT<1> e{KV, 2048, (bf16*)(ws + WS_VTX)}; GEMM(pg8::EpiBf16VT<1>, e, MEMN, Wb + WO_KV, MMEM, 2048, 1024); }
#endif
        GSYNC();
        for (int rep_ = 0; rep_ < REP_MIXA; ++rep_) {
#if EN_S5A
        for (int r2_ = 0; r2_ < REP_S5A; ++r2_) { PTRS(); TIDS(); s5_passA(ws, tab, lds, gw, NGW, wave, lane); }
#endif
#if EN_GLAA
        for (int r2_ = 0; r2_ < REP_GLAA; ++r2_) { PTRS(); TIDS(); for (int u = bid; u < 256; u += G) gla_passA(ws, tab, l, lds, u, tid); }
#endif
#if EN_FOX
        for (int r2_ = 0; r2_ < REP_FOX; ++r2_) { PTRS(); TIDS();
          for (int pr = bid; pr < 512; pr += G) {
            const int bh = pr >> 3, pp = pr & 7, b = bh >> 3, h = bh & 7;
            float* Fc = (float*)(lds + 24576); float* red = (float*)(lds + 24576 + 8192);
            __syncthreads();
            fox_cumsum(P, b, h, tab[23][l * 8 + h], Fc, red, tid);
            for (int hf = 0; hf < 2; ++hf) { const int qb = hf ? 15 - pp : pp;
                const size_t rq = (size_t)(b * SEQ + qb * 128);
                attn_unit<64, true>(lds, P + rq * LDP + PC_FQ + h * 64, LDP, P + (size_t)(b * SEQ) * LDP + PC_FK + h * 64, LDP, (const bf16*)(ws + WS_VT) + (size_t)((b * 8 + h) * 64) * 2048, 2048,
                                    BRF + rq * 512 + h * 64, 512, qb * 128, 2 * qb + 2, 2 * qb, Fc, 0.125f, tid); }
          } }
#endif
        }
        GSYNC();
        for (int rep_ = 0; rep_ < REP_MIXC; ++rep_) {
#if EN_S5C
        for (int r2_ = 0; r2_ < REP_S5C; ++r2_) { PTRS(); TIDS(); for (int u = bid; u < 256; u += G) s5_passC(ws, tab, l, lds, u, tid); }
#endif
#if EN_GLAC
        for (int r2_ = 0; r2_ < REP_GLAC; ++r2_) { PTRS(); TIDS(); for (int u = bid; u < 256; u += G) gla_passC_mfma(ws, tab, l, lds, u, tid); }
#endif
        }
        GSYNC();
        { PTRS(); pg8::EpiMerge<0> e{Y, MIXB, P + PC_GATE, LDP}; GEMM(pg8::EpiMerge<0>, e, BRG, Wb + WO_GLAUP, MTOK, 1024, 256); }
        { PTRS(); pg8::EpiMerge<1> e{Y, MIXB, P + PC_GATE + 1024, LDP}; GEMM(pg8::EpiMerge<1>, e, BRS, Wb + WO_S5UP, MTOK, 1024, 256); }
        { PTRS(); pg8::EpiMerge<2> e{Y, MIXB, P + PC_GATE + 2048, LDP}; GEMM(pg8::EpiMerge<2>, e, BRF, Wb + WO_FOXUP, MTOK, 1024, 512); }
#if REP_MERGE > 1
        { PTRS(); pg8::EpiMerge<0> e{Y, MIXB, P + PC_GATE, LDP}; GEMM(pg8::EpiMerge<0>, e, BRG, Wb + WO_GLAUP, MTOK, 1024, 256); }
        { PTRS(); pg8::EpiMerge<1> e{Y, MIXB, P + PC_GATE + 1024, LDP}; GEMM(pg8::EpiMerge<1>, e, BRS, Wb + WO_S5UP, MTOK, 1024, 256); }
        { PTRS(); pg8::EpiMerge<2> e{Y, MIXB, P + PC_GATE + 2048, LDP}; GEMM(pg8::EpiMerge<2>, e, BRF, Wb + WO_FOXUP, MTOK, 1024, 512); }
#endif
        GSYNC();
        { PTRS(); pg8::EpiBf16 e{YB, DM}; GEMM(pg8::EpiBf16, e, MIXB, Wb + WO_MIXOUT, MTOK, 1024, 1024); }
#if REP_SQ > 1
        { PTRS(); pg8::EpiBf16 e{YB, DM}; GEMM(pg8::EpiBf16, e, MIXB, Wb + WO_MIXOUT, MTOK, 1024, 1024); }
#endif
        GSYNC();
        { PTRS(); TIDS(); rowop<true, true, true>(X, X, YB, tab[26] + l * DM, 1.0f, tab[27] + l * DM, H, MTOK, gw, NGW, lane); }
#if REP_ROW
        { PTRS(); TIDS(); rowop<true, true, true>(X, (float*)(ws + WS_P), YB, tab[26] + l * DM, 1.0f, tab[27] + l * DM, (bf16*)(ws + WS_P + 64 * MiB), MTOK, gw, NGW, lane); }
#endif
        GSYNC();
        { PTRS(); pg8::EpiBf16 e{Qb, DM}; GEMM(pg8::EpiBf16, e, H, Wb + WO_Q, MTOK, 1024, 1024); }
#if REP_SQ > 1
        { PTRS(); pg8::EpiBf16 e{Qb, DM}; GEMM(pg8::EpiBf16, e, H, Wb + WO_Q, MTOK, 1024, 1024); }
#endif
        GSYNC();
#if EN_XA
        for (int rep_ = 0; rep_ < REP_XA; ++rep_)
        { PTRS(); TIDS();
          for (int u = bid; u < 512; u += G) { const int qb = u & 15, hd = (u >> 4) & 3, b = u >> 6;
            const size_t rq = (size_t)(b * SEQ + qb * 128);
            attn_unit<256, false>(lds, Qb + rq * DM + hd * 256, DM, KV + (size_t)(b * NMEM) * 2048 + hd * 256, 2048, (const bf16*)(ws + WS_VTX) + (size_t)((b * 4 + hd) * 256) * 256, 256,
                                  XO + rq * DM + hd * 256, DM, 0, 4, 0, nullptr, 0.0625f, tid); } }
#endif
        GSYNC();
        { PTRS(); pg8::EpiBf16 e{YB, DM}; GEMM(pg8::EpiBf16, e, XO, Wb + WO_O, MTOK, 1024, 1024); }
#if REP_SQ > 1
        { PTRS(); pg8::EpiBf16 e{YB, DM}; GEMM(pg8::EpiBf16, e, XO, Wb + WO_O, MTOK, 1024, 1024); }
#endif
        GSYNC();
        { PTRS(); TIDS(); rowop<true, true, true>(X, X, YB, tab[32] + l * DM, 1.0f, tab[33] + l * DM, H, MTOK, gw, NGW, lane); }
#if REP_ROW
        { PTRS(); TIDS(); rowop<true, true, true>(X, (float*)(ws + WS_P), YB, tab[32] + l * DM, 1.0f, tab[33] + l * DM, (bf16*)(ws + WS_P + 64 * MiB), MTOK, gw, NGW, lane); }
#endif
        GSYNC();
        { PTRS(); pg8::EpiSwiGLU e{ACT, DFF}; GEMM(pg8::EpiSwiGLU, e, H, Wb + WO_GU2, MTOK, 5632, 1024); }
#if REP_GU > 1
        { PTRS(); pg8::EpiSwiGLU e{ACT, DFF}; GEMM(pg8::EpiSwiGLU, e, H, Wb + WO_GU2, MTOK, 5632, 1024); }
#endif
        GSYNC();
        { PTRS(); pg8::EpiBf16 e{YB, DM}; GEMM(pg8::EpiBf16, e, ACT, Wb + WO_DOWN2, MTOK, 1024, DFF); }
#if REP_DOWN > 1
        { PTRS(); pg8::EpiBf16 e{YB, DM}; GEMM(pg8::EpiBf16, e, ACT, Wb + WO_DOWN2, MTOK, 1024, DFF); }
#endif
        GSYNC();
        if (l + 1 < DEPTH) {
            { PTRS(); TIDS(); rowop<true, true, true>(X, X, YB, tab[36] + l * DM, 0.5f, tab[2] + (l + 1) * DM, H, MTOK, gw, NGW, lane); }
#if REP_ROW
            { PTRS(); TIDS(); rowop<true, true, true>(X, (float*)(ws + WS_P), YB, tab[36] + l * DM, 0.5f, tab[2] + (l + 1) * DM, (bf16*)(ws + WS_P + 64 * MiB), MTOK, gw, NGW, lane); }
#endif
            __syncthreads();
            { PTRS(); TIDS();
#if EN_CONV
              convert_weights(ws, tab, l + 1, lds, gw, NGW, wave, lane);
              s5_prep(ws, tab, l + 1, bid * NTHR + tid, G * NTHR);
#if REP_CONV > 1
              convert_weights(ws, tab, l + 1, lds, gw, NGW, wave, lane);
#endif
#endif
              rowop<false, false, true>(tab[1], nullptr, nullptr, nullptr, 0.f, tab[28] + (l + 1) * DM, MEMN, MMEM, gw, NGW, lane); }
            GSYNC();
        } else {
            { PTRS(); TIDS(); rowop<true, true, false>(X, X, YB, tab[36] + l * DM, 0.5f, nullptr, nullptr, MTOK, gw, NGW, lane); }
        }
    }
}

extern "C" void kernel_launch(void* const* d_in, const int* in_sizes, int n_in, void* d_out, int out_size, void* d_ws, size_t ws_size, hipStream_t stream) {
    static int grid = 0;
    if (grid == 0) {
        if (n_in != 37 || out_size != MTOK * DM || ws_size < WS_END) { fprintf(stderr, "kernel_launch: unexpected shapes (n_in %d out %d ws %zu need %zu)\n", n_in, out_size, ws_size, (size_t)WS_END); grid = -1; return; }
        int dev = 0, cus = 0, per_cu = 0;
        hipGetDevice(&dev); hipDeviceGetAttribute(&cus, hipDeviceAttributeMultiprocessorCount, dev);
        if (hipFuncSetAttribute((const void*)fwd_mega, hipFuncAttributeMaxDynamicSharedMemorySize, LDS_BYTES) != hipSuccess) { fprintf(stderr, "kernel_launch: hipFuncSetAttribute failed\n"); grid = -1; return; }
        hipOccupancyMaxActiveBlocksPerMultiprocessor(&per_cu, (const void*)fwd_mega, NTHR, LDS_BYTES);
        (void)hipGetLastError();
        if (per_cu < 1) { fprintf(stderr, "kernel_launch: occupancy query says %d blocks/CU\n", per_cu); }
        if (cus < 256) { fprintf(stderr, "kernel_launch: needs 256 CUs, device has %d\n", cus); grid = -1; return; }
        grid = 256;
    }
    if (grid < 0) return;
    Params p{};
    for (int i = 0; i < 37; ++i) p.in[i] = (const float*)d_in[i];
    p.out = (float*)d_out; p.ws = (unsigned char*)d_ws;
    void* args[] = {&p};
    hipError_t e = hipLaunchCooperativeKernel((const void*)fwd_mega, dim3(grid), dim3(NTHR), args, LDS_BYTES, stream);
    if (e != hipSuccess) fprintf(stderr, "cooperative launch failed: %s (grid %d)\n", hipGetErrorString(e), grid);
}
```

```cpp
#include <hip/hip_runtime.h>
#include <hip/hip_cooperative_groups.h>
#include <cstdio>
#include <cstdint>
namespace cg = cooperative_groups;
namespace pg8 {
#define PG8_LAS __attribute__((address_space(3)))
typedef unsigned short bf16_t;
typedef short bf16x8 __attribute__((ext_vector_type(8)));
typedef float f32x4 __attribute__((ext_vector_type(4)));
typedef unsigned u32x4 __attribute__((ext_vector_type(4)));
constexpr int BM = 256, BK = 64, HALF = 128, HTB = HALF * BK * 2  , STAGE_BYTES = 8 * HTB, NXCD = 8, WGM = 8;

__host__ __device__ __forceinline__ int lds_byte(int r, int c) { const int st = (r >> 4) * 2 + (c >> 5), rr = r & 15, cc = c & 31, ob = rr * 64 + cc * 2; return st * 1024 + (ob ^ (((ob >> 9) & 1) << 5)); }
__host__ __device__ __forceinline__ void stage_rc(int b, int& R, int& C) { const int st = b / 1024, sb = b % 1024, swz = sb ^ (((sb >> 9) & 1) << 5); R = (st >> 1) * 16 + swz / 64; C = (st & 1) * 32 + (swz % 64) / 2; }
__host__ __device__ __forceinline__ int perm32(int rho) { const int n = rho >> 4, i = rho & 15; return 8 * (i >> 2) + 4 * n + (i & 3); }

struct Unit { int pm, pn; };
struct Gemm { const bf16_t* A; const bf16_t* Bt; int M, N, K; };

struct StaticOrder {
    int nM, nN, nwg, G, c;
    __host__ __device__ void init(int M, int N, int G_, int c_) { nM = M / BM; nN = N / BM; nwg = nM * nN; G = G_; c = c_; }
    __host__ __device__ bool next(int i, Unit& u) const {
        const long L = (long)i * G + c; if (L >= nwg) return false;
        int wgid = (int)L; { const int q = nwg / NXCD, r = nwg % NXCD, xcd = wgid % NXCD, off = wgid / NXCD; wgid = (xcd < r ? xcd * (q + 1) : r * (q + 1) + (xcd - r) * q) + off; }
        const int nig = WGM * nN, gid = wgid / nig, fm = gid * WGM, gsz = (nM - fm) < WGM ? (nM - fm) : WGM;
        u.pm = fm + ((wgid % nig) % gsz); u.pn = (wgid % nig) / gsz; return true;
    }
    __device__ __forceinline__ void a_ready(const Unit&) const {}
    __device__ __forceinline__ void done(const Unit&) const {}
};

__device__ __forceinline__ unsigned cvt_pk_bf16(float lo, float hi) { unsigned r; asm volatile("v_cvt_pk_bf16_f32 %0, %1, %2" : "=v"(r) : "v"(lo), "v"(hi)); return r; }
typedef float f32x2 __attribute__((ext_vector_type(2)));
typedef unsigned u32x2 __attribute__((ext_vector_type(2)));
__device__ __forceinline__ float fast_sigmoid(float x) { return __builtin_amdgcn_rcpf(1.0f + __expf(-x)); }
__device__ __forceinline__ float bf_lo(unsigned w) { return __uint_as_float(w << 16); }
__device__ __forceinline__ float bf_hi(unsigned w) { return __uint_as_float(w & 0xffff0000u); }
struct EpiBf16 {
    static constexpr bool PERM = true, AFTER_DRAIN = false;
    bf16_t* O; int ldc;
    __device__ __forceinline__ void operator()(const f32x4 (&acc)[2][2][4][2], const Unit& u, int wr, int wc, int fr, int fq) const {
        const int row0 = u.pm * BM + wr * 64 + fr; const int col0 = u.pn * BM + wc * 32 + 8 * fq;
#pragma unroll
        for (int ai = 0; ai < 2; ++ai)
#pragma unroll
            for (int m = 0; m < 4; ++m) { bf16_t* rowp = O + (size_t)(row0 + ai * HALF + m * 16) * ldc + col0;
#pragma unroll
                for (int bj = 0; bj < 2; ++bj) { const f32x4 v0 = acc[ai][bj][m][0], v1 = acc[ai][bj][m][1];
                    u32x4 w; w.x = cvt_pk_bf16(v0[0], v0[1]); w.y = cvt_pk_bf16(v0[2], v0[3]); w.z = cvt_pk_bf16(v1[0], v1[1]); w.w = cvt_pk_bf16(v1[2], v1[3]);
                    *(u32x4*)(rowp + bj * HALF) = w; } }
    }
};
struct EpiSwiGLU {
    static constexpr bool PERM = true, AFTER_DRAIN = false;
    bf16_t* O; int ldc;
    __device__ __forceinline__ void operator()(const f32x4 (&acc)[2][2][4][2], const Unit& u, int wr, int wc, int fr, int fq) const {
        const int row0 = u.pm * BM + wr * 64 + fr; const int col0 = u.pn * HALF + wc * 32 + 8 * fq;
#pragma unroll
        for (int ai = 0; ai < 2; ++ai)
#pragma unroll
            for (int m = 0; m < 4; ++m) { bf16_t* rowp = O + (size_t)(row0 + ai * HALF + m * 16) * ldc + col0;
                float r[8];
#pragma unroll
                for (int n = 0; n < 2; ++n)
#pragma unroll
                    for (int j = 0; j < 4; ++j) { const float g = acc[ai][0][m][n][j], up = acc[ai][1][m][n][j]; r[n * 4 + j] = g * fast_sigmoid(g) * up; }
                u32x4 w; w.x = cvt_pk_bf16(r[0], r[1]); w.y = cvt_pk_bf16(r[2], r[3]); w.z = cvt_pk_bf16(r[4], r[5]); w.w = cvt_pk_bf16(r[6], r[7]);
                *(u32x4*)rowp = w; }
    }
};
struct EpiF32 {
    static constexpr bool PERM = false, AFTER_DRAIN = false;
    float* O; int ldc;
    __device__ __forceinline__ void operator()(const f32x4 (&acc)[2][2][4][2], const Unit& u, int wr, int wc, int fr, int fq) const {
        const int row0 = u.pm * BM + wr * 64 + fr; const int col0 = u.pn * BM + wc * 32 + 4 * fq;
#pragma unroll
        for (int ai = 0; ai < 2; ++ai)
#pragma unroll
            for (int m = 0; m < 4; ++m) { float* rowp = O + (size_t)(row0 + ai * HALF + m * 16) * ldc + col0;
#pragma unroll
                for (int bj = 0; bj < 2; ++bj)
#pragma unroll
                    for (int n = 0; n < 2; ++n) *(f32x4*)(rowp + bj * HALF + n * 16) = acc[ai][bj][m][n]; }
    }
};
template <int MODE> struct EpiMerge {
    static constexpr bool PERM = false, AFTER_DRAIN = false;
    bf16_t* F; bf16_t* B; const bf16_t* G; int ldg;
    __device__ __forceinline__ void operator()(const f32x4 (&acc)[2][2][4][2], const Unit& u, int wr, int wc, int fr, int fq) const {
        const int row0 = u.pm * BM + wr * 64 + fr; const int col0 = u.pn * BM + wc * 32 + 4 * fq;
#pragma unroll
        for (int ai = 0; ai < 2; ++ai)
#pragma unroll
            for (int m = 0; m < 4; ++m) { const size_t row = (size_t)(row0 + ai * HALF + m * 16);
#pragma unroll
                for (int bj = 0; bj < 2; ++bj)
#pragma unroll
                    for (int n = 0; n < 2; ++n) { const int c = col0 + bj * HALF + n * 16;
                        const u32x2 gw = *(const u32x2*)(G + row * ldg + c);
                        f32x4 s; s[0] = fast_sigmoid(bf_lo(gw.x)); s[1] = fast_sigmoid(bf_hi(gw.x)); s[2] = fast_sigmoid(bf_lo(gw.y)); s[3] = fast_sigmoid(bf_hi(gw.y));
                        f32x4 v = s * acc[ai][bj][m][n];
                        bf16_t* fp = F + row * 1024 + c;
                        if (MODE >= 1) { const u32x2 pw = *(const u32x2*)fp; v[0] += bf_lo(pw.x); v[1] += bf_hi(pw.x); v[2] += bf_lo(pw.y); v[3] += bf_hi(pw.y); }
                        u32x2 w; w.x = cvt_pk_bf16(v[0], v[1]); w.y = cvt_pk_bf16(v[2], v[3]);
                        if (MODE <= 1) *(u32x2*)fp = w; else *(u32x2*)(B + row * 1024 + c) = w; } }
    }
};

template <int MODE> struct EpiBf16VT {
    static constexpr bool PERM = true, AFTER_DRAIN = false;
    bf16_t* O; int ldc; bf16_t* VT;
    __device__ __forceinline__ void operator()(const f32x4 (&acc)[2][2][4][2], const Unit& u, int wr, int wc, int fr, int fq) const {
        const int row0 = u.pm * BM + wr * 64 + fr; const int col0 = u.pn * BM + wc * 32 + 8 * fq;
        const bool tr = MODE == 0 ? (u.pn == 8 || u.pn == 9) : (u.pn >= 4);
        if (!tr) {
#pragma unroll
            for (int ai = 0; ai < 2; ++ai)
#pragma unroll
                for (int m = 0; m < 4; ++m) { bf16_t* rowp = O + (size_t)(row0 + ai * HALF + m * 16) * ldc + col0;
#pragma unroll
                    for (int bj = 0; bj < 2; ++bj) { const f32x4 v0 = acc[ai][bj][m][0], v1 = acc[ai][bj][m][1];
                        u32x4 w; w.x = cvt_pk_bf16(v0[0], v0[1]); w.y = cvt_pk_bf16(v0[2], v0[3]); w.z = cvt_pk_bf16(v1[0], v1[1]); w.w = cvt_pk_bf16(v1[2], v1[3]);
                        *(u32x4*)(rowp + bj * HALF) = w; } }
        } else {
            bf16_t* vp; int sbj, sn, sj;
            if (MODE == 0) { vp = VT + ((size_t)((((u.pm * BM) >> 11) * 8 + (u.pn - 8) * 4 + (wc >> 1)) * 64 + (wc & 1) * 32 + 8 * fq)) * 2048 + ((u.pm * BM) & 2047) + wr * 64 + fr; sbj = 2 * 64 * 2048; sn = 4 * 2048; sj = 2048; }
            else           { vp = VT + ((size_t)((u.pm * 4 + (u.pn - 4)) * 256 + wc * 32 + 8 * fq)) * 256 + wr * 64 + fr; sbj = 128 * 256; sn = 4 * 256; sj = 256; }
#pragma unroll
            for (int ai = 0; ai < 2; ++ai)
#pragma unroll
                for (int m = 0; m < 4; ++m)
#pragma unroll
                    for (int bj = 0; bj < 2; ++bj)
#pragma unroll
                        for (int n = 0; n < 2; ++n) { bf16_t* q = vp + bj * sbj + n * sn + ai * HALF + m * 16;
                            const unsigned w0 = cvt_pk_bf16(acc[ai][bj][m][n][0], acc[ai][bj][m][n][1]), w1 = cvt_pk_bf16(acc[ai][bj][m][n][2], acc[ai][bj][m][n][3]);
                            q[0] = (bf16_t)(w0 & 0xffffu); q[sj] = (bf16_t)(w0 >> 16); q[2 * sj] = (bf16_t)(w1 & 0xffffu); q[3 * sj] = (bf16_t)(w1 >> 16); }
        }
    }
};
template <class Epi, class Sched, bool ALIGN_EPI = false, bool SP2 = false>
__device__ __forceinline__ void gemm_phase(PG8_LAS unsigned char* lds, const Gemm g, const Sched& S, const Epi& E, const int tid) {
    const int wid = __builtin_amdgcn_readfirstlane(tid >> 6), lane = tid & 63, wr = wid >> 2, wc = wid & 3, fr = lane & 15, fq = lane >> 4;
    const int K = g.K, nt = K / BK;
    unsigned voffA[2], voffB[2];
#pragma unroll
    for (int i = 0; i < 2; ++i) { int R, C; stage_rc(tid * 16 + i * 8192, R, C); const int Rb = Epi::PERM ? ((R & ~31) + perm32(R & 31)) : R;
        voffA[i] = (unsigned)(R * K + C) * 2u; voffB[i] = (unsigned)(Rb * K + C) * 2u; }
    const size_t kstep = (size_t)(BK * 2);
    const size_t hstep = (size_t)HALF * K * 2;
    const size_t tstep = 2 * hstep;
    const unsigned ldsw = (unsigned)wid * 1024u;
    const int aoff = lds_byte(wr * 64 + fr, fq * 8), boff = lds_byte(wc * 32 + fr, fq * 8);
#define PG8_SA(b, h) (((b) * 2 + (h)) * HTB)
#define PG8_SB(b, h) ((4 + (b) * 2 + (h)) * HTB)
#define PG8_STAGE(bufoff, gbase, voff) do { _Pragma("unroll") for (int _i = 0; _i < 2; ++_i) \
        __builtin_amdgcn_global_load_lds((const unsigned*)((const char*)(gbase) + (voff)[_i]), (PG8_LAS unsigned*)(lds + (bufoff) + ldsw + _i * 8192), 16, 0, 0); } while (0)
#define PG8_LDA(dst, b, h) do { _Pragma("unroll") for (int m = 0; m < 4; ++m) _Pragma("unroll") for (int k = 0; k < 2; ++k) dst[m][k] = *(const PG8_LAS bf16x8*)(lds + PG8_SA(b, h) + aoff + m * 2048 + k * 1024); } while (0)
#define PG8_LDB(dst, b, h) do { _Pragma("unroll") for (int n = 0; n < 2; ++n) _Pragma("unroll") for (int k = 0; k < 2; ++k) dst[n][k] = *(const PG8_LAS bf16x8*)(lds + PG8_SB(b, h) + boff + n * 2048 + k * 1024); } while (0)
#define PG8_MMA(ai, bj, At, Bt) do { __builtin_amdgcn_s_setprio(1); _Pragma("unroll") for (int m = 0; m < 4; ++m) _Pragma("unroll") for (int n = 0; n < 2; ++n) _Pragma("unroll") for (int k = 0; k < 2; ++k) \
        acc[ai][bj][m][n] = __builtin_amdgcn_mfma_f32_16x16x32_bf16(Bt[n][k], At[m][k], acc[ai][bj][m][n], 0, 0, 0); __builtin_amdgcn_s_setprio(0); } while (0)
#define PG8_WAIT_V(n) asm volatile("s_waitcnt vmcnt(" #n ")" ::: "memory")
#define PG8_WAIT_L(n) asm volatile("s_waitcnt lgkmcnt(" #n ")" ::: "memory")
#define PG8_BAR __builtin_amdgcn_s_barrier()
#define PG8_SCHED __builtin_amdgcn_sched_barrier(0)
    Unit cur, nxt; int ui = 0;
    if (!S.next(0, cur)) return;
    f32x4 acc[2][2][4][2];
#pragma unroll
    for (int a = 0; a < 2; ++a)
#pragma unroll
        for (int b = 0; b < 2; ++b)
#pragma unroll
            for (int m = 0; m < 4; ++m)
#pragma unroll
                for (int n = 0; n < 2; ++n) acc[a][b][m][n] = (f32x4){0.f, 0.f, 0.f, 0.f};
    bf16x8 At[4][2], B0[2][2], B1[2][2];
    const char* cA = (const char*)g.A + (size_t)cur.pm * tstep; const char* cB = (const char*)g.Bt + (size_t)cur.pn * tstep;
    S.a_ready(cur);
    if constexpr (SP2) {
        PG8_STAGE(PG8_SB(0, 0), cB, voffB); PG8_STAGE(PG8_SB(0, 1), cB + hstep, voffB); PG8_STAGE(PG8_SA(0, 0), cA, voffA); PG8_STAGE(PG8_SA(0, 1), cA + hstep, voffA);
        if (wr == 1) PG8_BAR;
        PG8_WAIT_V(2); PG8_BAR;
        PG8_STAGE(PG8_SB(1, 0), cB + kstep, voffB); PG8_STAGE(PG8_SA(1, 0), cA + kstep, voffA); PG8_STAGE(PG8_SB(1, 1), cB + hstep + kstep, voffB);
        PG8_WAIT_V(6); PG8_BAR;
    } else {
        PG8_STAGE(PG8_SB(0, 0), cB, voffB); PG8_STAGE(PG8_SA(0, 0), cA, voffA); PG8_STAGE(PG8_SB(0, 1), cB + hstep, voffB); PG8_STAGE(PG8_SA(0, 1), cA + hstep, voffA);
        if (wr == 1) PG8_BAR;
        PG8_WAIT_V(4); PG8_BAR;
        PG8_STAGE(PG8_SB(1, 0), cB + kstep, voffB); PG8_STAGE(PG8_SA(1, 0), cA + kstep, voffA); PG8_STAGE(PG8_SB(1, 1), cB + hstep + kstep, voffB);
        PG8_WAIT_V(6); PG8_BAR;
    }
    for (;;) {
        const bool has_next = S.next(ui + 1, nxt);
        const char* nA = has_next ? (const char*)g.A + (size_t)nxt.pm * tstep : cA; const char* nB = has_next ? (const char*)g.Bt + (size_t)nxt.pn * tstep : cB;
        for (int t = 0; t < nt; t += 2) {
            const bool last = (t == nt - 2);
            const char* a1 = cA + (size_t)(t + 1) * kstep;
            const char* a2 = last ? nA : cA + (size_t)(t + 2) * kstep; const char* b2 = last ? nB : cB + (size_t)(t + 2) * kstep;
            const char* a3 = a2 + kstep; const char* b3 = b2 + kstep;
            if (last && has_next) S.a_ready(nxt);
            if constexpr (SP2) {
            PG8_LDB(B0, 0, 0); PG8_LDB(B1, 0, 1); PG8_SCHED; PG8_LDA(At, 0, 0); PG8_STAGE(PG8_SA(1, 1), a1 + hstep, voffA);
            PG8_WAIT_V(8); PG8_WAIT_L(0); PG8_BAR; PG8_MMA(0, 0, At, B0); PG8_MMA(0, 1, At, B1); PG8_BAR; PG8_SCHED;
            PG8_LDA(At, 0, 1); PG8_STAGE(PG8_SB(0, 0), b2, voffB); PG8_STAGE(PG8_SB(0, 1), b2 + hstep, voffB); PG8_STAGE(PG8_SA(0, 0), a2, voffA);
            PG8_WAIT_V(8); PG8_WAIT_L(0); PG8_BAR; PG8_MMA(1, 0, At, B0); PG8_MMA(1, 1, At, B1); PG8_BAR; PG8_SCHED;
            PG8_LDB(B0, 1, 0); PG8_LDB(B1, 1, 1); PG8_SCHED; PG8_LDA(At, 1, 0); PG8_STAGE(PG8_SA(0, 1), a2 + hstep, voffA);
            PG8_WAIT_V(8); PG8_WAIT_L(0); PG8_BAR; PG8_MMA(0, 0, At, B0); PG8_MMA(0, 1, At, B1); PG8_BAR; PG8_SCHED;
            PG8_LDA(At, 1, 1); PG8_STAGE(PG8_SB(1, 0), b3, voffB); PG8_STAGE(PG8_SB(1, 1), b3 + hstep, voffB); PG8_STAGE(PG8_SA(1, 0), a3, voffA);
            PG8_WAIT_V(8); PG8_WAIT_L(0); PG8_BAR; PG8_MMA(1, 0, At, B0); PG8_MMA(1, 1, At, B1); PG8_BAR; PG8_SCHED;
            } else {
            PG8_LDB(B0, 0, 0); PG8_SCHED; PG8_LDA(At, 0, 0); PG8_STAGE(PG8_SA(1, 1), a1 + hstep, voffA);
            PG8_WAIT_L(8); PG8_BAR; PG8_WAIT_L(0); PG8_MMA(0, 0, At, B0); PG8_BAR; PG8_SCHED;
            PG8_LDB(B1, 0, 1); PG8_STAGE(PG8_SB(0, 0), b2, voffB);
            PG8_BAR; PG8_WAIT_L(0); PG8_MMA(0, 1, At, B1); PG8_BAR;
            PG8_LDA(At, 0, 1); PG8_STAGE(PG8_SA(0, 0), a2, voffA);
            PG8_BAR; PG8_WAIT_L(0); PG8_MMA(1, 0, At, B0); PG8_BAR; PG8_SCHED;
            PG8_STAGE(PG8_SB(0, 1), b2 + hstep, voffB);
            PG8_WAIT_V(6); PG8_BAR; PG8_MMA(1, 1, At, B1); PG8_BAR;
            PG8_LDB(B0, 1, 0); PG8_SCHED; PG8_LDA(At, 1, 0); PG8_STAGE(PG8_SA(0, 1), a2 + hstep, voffA);
            PG8_WAIT_L(8); PG8_BAR; PG8_WAIT_L(0); PG8_MMA(0, 0, At, B0); PG8_BAR; PG8_SCHED;
            PG8_LDB(B1, 1, 1); PG8_STAGE(PG8_SB(1, 0), b3, voffB);
            PG8_BAR; PG8_WAIT_L(0); PG8_MMA(0, 1, At, B1); PG8_BAR;
            PG8_LDA(At, 1, 1); PG8_STAGE(PG8_SA(1, 0), a3, voffA);
            PG8_BAR; PG8_WAIT_L(0); PG8_MMA(1, 0, At, B0); PG8_BAR; PG8_SCHED;
            PG8_STAGE(PG8_SB(1, 1), b3 + hstep, voffB);
            PG8_WAIT_V(6); PG8_BAR; PG8_MMA(1, 1, At, B1); PG8_BAR;
            }
        }
        if constexpr (ALIGN_EPI) { if (wr == 0) PG8_BAR; }
        if constexpr (!Epi::AFTER_DRAIN) { int l2_; asm volatile("v_mbcnt_lo_u32_b32 %0, -1, 0\n\tv_mbcnt_hi_u32_b32 %0, -1, %0" : "=v"(l2_)); E(acc, cur, wr, wc, l2_ & 15, l2_ >> 4); S.done(cur); }
        if (!has_next) break;
#pragma unroll
        for (int a = 0; a < 2; ++a)
#pragma unroll
            for (int b = 0; b < 2; ++b)
#pragma unroll
                for (int m = 0; m < 4; ++m)
#pragma unroll
                    for (int n = 0; n < 2; ++n) acc[a][b][m][n] = (f32x4){0.f, 0.f, 0.f, 0.f};
        cur = nxt; cA = nA; cB = nB; ++ui;
        if constexpr (ALIGN_EPI) { if (wr == 1) PG8_BAR; }
    }
    PG8_WAIT_V(0);
    if constexpr (!ALIGN_EPI) { if (wr == 0) PG8_BAR; }
    PG8_BAR;
    if constexpr (Epi::AFTER_DRAIN) { E.fused(acc, cur, wr, wc, fr, fq, lds, wid, lane); S.done(cur); }
#undef PG8_SA
#undef PG8_SB
#undef PG8_STAGE
#undef PG8_LDA
#undef PG8_LDB
#undef PG8_MMA
#undef PG8_WAIT_V
#undef PG8_WAIT_L
#undef PG8_BAR
#undef PG8_SCHED
}
}
#ifndef REP_GU
#define REP_GU 1
#endif
#ifndef REP_DOWN
#define REP_DOWN 1
#endif
#ifndef REP_IN
#define REP_IN 1
#endif
#ifndef REP_MERGE
#define REP_MERGE 1
#endif
#ifndef REP_SQ
#define REP_SQ 1
#endif
#ifndef REP_S5A
#define REP_S5A 1
#endif
#ifndef REP_GLAA
#define REP_GLAA 1
#endif
#ifndef REP_FOX
#define REP_FOX 1
#endif
#ifndef REP_S5C
#define REP_S5C 1
#endif
#ifndef REP_GLAC
#define REP_GLAC 1
#endif
#ifndef REP_MIXA
#define REP_MIXA 1
#endif
#ifndef REP_MIXC
#define REP_MIXC 1
#endif
#ifndef REP_XA
#define REP_XA 1
#endif
#ifndef REP_CONV
#define REP_CONV 1
#endif
#ifndef REP_ROW
#define REP_ROW 0
#endif
#ifndef EN_S5A
#define EN_S5A 1
#endif
#ifndef EN_GLAA
#define EN_GLAA 1
#endif
#ifndef EN_FOX
#define EN_FOX 1
#endif
#ifndef EN_S5C
#define EN_S5C 1
#endif
#ifndef EN_GLAC
#define EN_GLAC 1
#endif
#ifndef EN_XA
#define EN_XA 1
#endif
#ifndef EN_CONV
#define EN_CONV 1
#endif
typedef unsigned short bf16;
typedef unsigned v4u __attribute__((ext_vector_type(4)));
typedef unsigned v2u __attribute__((ext_vector_type(2)));
typedef float f32x4 __attribute__((ext_vector_type(4)));
typedef short bf16x8 __attribute__((ext_vector_type(8)));
#define LAS __attribute__((address_space(3)))

constexpr int MTOK = 16384, DM = 1024, SEQ = 2048, NB = 8, DFF = 2816, NMEM = 256, MMEM = NB * NMEM, DEPTH = 4;
constexpr int LDP = 5888, D_IN = 5656;
constexpr int PC_GQ = 0, PC_GK = 128, PC_GV = 256, PC_GR = 512, PC_SU = 768, PC_FQ = 1024, PC_FK = 1536, PC_FV = 2048, PC_GD = 2560, PC_FF = 2576, PC_GATE = 2816;
constexpr float EPS = 1e-6f;
constexpr int NTHR = 512, NWAVES = 8;
constexpr int LDS_BYTES = 147456;

constexpr size_t WO_GU1 = 0, WO_DOWN1 = WO_GU1 + (size_t)5632 * 1024, WO_IN = WO_DOWN1 + (size_t)1024 * 2816, WO_GLAUP = WO_IN + (size_t)5888 * 1024, WO_S5UP = WO_GLAUP + 1024 * 256,
                 WO_FOXUP = WO_S5UP + 1024 * 256, WO_GLU = WO_FOXUP + 1024 * 512, WO_MIXOUT = WO_GLU + 256 * 256, WO_Q = WO_MIXOUT + 1024 * 1024, WO_KV = WO_Q + 1024 * 1024,
                 WO_O = WO_KV + 2048 * 1024, WO_GU2 = WO_O + 1024 * 1024, WO_DOWN2 = WO_GU2 + (size_t)5632 * 1024, WO_END = WO_DOWN2 + (size_t)1024 * 2816;
constexpr size_t MiB = (size_t)1 << 20;
constexpr size_t WS_W = 1 * MiB, WS_P = 64 * MiB, WS_H = 248 * MiB, WS_Y = 280 * MiB, WS_BRG = 344 * MiB, WS_BRS = 352 * MiB, WS_BRF = 360 * MiB, WS_MIXB = 376 * MiB,
                 WS_Q = 344 * MiB, WS_XO = 376 * MiB, WS_KV = 408 * MiB, WS_MEMN = 416 * MiB, WS_DS = 420 * MiB, WS_DEC = 428 * MiB, WS_S5L = 429 * MiB, WS_S5P = 431 * MiB, WS_VT = 432 * MiB, WS_VTX = 448 * MiB, WS_END = 452 * MiB;
static_assert(WS_W + WO_END * 2 <= WS_P, "weights fit");
static_assert(WS_P + (size_t)MTOK * LDP * 2 <= WS_H, "P fits");
constexpr size_t S5P_ABAR = 0, S5P_A64 = 8192, S5P_BBAR = 16384, S5P_CMAT = 16384 + 131072;

struct Params { const float* in[37]; float* out; unsigned char* ws; };

__device__ __forceinline__ unsigned f2bf(float f) { unsigned u = __builtin_bit_cast(unsigned, f); return (u + 0x7fffu + ((u >> 16) & 1u)) >> 16; }
__device__ __forceinline__ unsigned pk2(float lo, float hi) { return f2bf(lo) | (f2bf(hi) << 16); }
__device__ __forceinline__ float bf2f(unsigned h) { return __uint_as_float(h << 16); }
__device__ __forceinline__ float bflo(unsigned w) { return __uint_as_float(w << 16); }
__device__ __forceinline__ float bfhi(unsigned w) { return __uint_as_float(w & 0xffff0000u); }
#define LDS_WAIT() asm volatile("s_waitcnt lgkmcnt(0)" ::: "memory")
__device__ __forceinline__ float wave_sum(float v) {
#pragma unroll
    for (int o = 1; o < 64; o <<= 1) v += __shfl_xor(v, o);
    return v;
}
__device__ __forceinline__ float logsig(float z) { return fminf(z, 0.f) - logf(1.0f + expf(-fabsf(z))); }
__device__ __forceinline__ float sigmoidf_(float x) { return 1.0f / (1.0f + __expf(-x)); }
__device__ __forceinline__ float gelu_tanh(float x) { const float z = 0.7978845608028654f * (x + 0.044715f * x * x * x); const float t = 1.0f - 2.0f / (__expf(2.0f * z) + 1.0f); return 0.5f * x * (1.0f + t); }

__device__ __forceinline__ int srccol(int kind, int j) {
    if (kind == 0) return j;
    if (kind == 1) { const int pn = j >> 8, r = j & 255; return r < 128 ? 128 * pn + r : 2816 + 128 * pn + (r - 128); }
    if (j < 768) return j;
    if (j < 1024) return 784 + (j - 768);
    if (j < 2560) return 1040 + (j - 1024);
    if (j < 2576) return 768 + (j - 2560);
    if (j < 2584) return 2576 + (j - 2576);
    if (j < 2816) return -1;
    return 2584 + (j - 2816);
}
__device__ __forceinline__ void transpose_item(const float* W, int K, int Nsrc, int Ndst, int kind, bf16* WT, float* scr, int item, int lane) {
    const int nblk = Ndst / 32, kb = item / nblk, nb = item % nblk, k0 = 64 * kb, n0 = 32 * nb;
    const int nn = 4 * (lane & 7), sc = srccol(kind, n0 + nn);
    f32x4 v[8];
#pragma unroll
    for (int i = 0; i < 8; ++i) { const int kk = 8 * i + (lane >> 3); v[i] = sc >= 0 ? *(const f32x4*)(W + (size_t)(k0 + kk) * Nsrc + sc) : (f32x4){0.f, 0.f, 0.f, 0.f}; }
#pragma unroll
    for (int i = 0; i < 8; ++i) { const int kk = 8 * i + (lane >> 3); float* d = scr + kk * 33 + nn; d[0] = v[i][0]; d[1] = v[i][1]; d[2] = v[i][2]; d[3] = v[i][3]; }
    LDS_WAIT();
    const int c = lane & 7;
#pragma unroll
    for (int j = 0; j < 4; ++j) { const int n = (lane >> 3) + 8 * j; const float* s = scr + (8 * c) * 33 + n;
        v4u o; o.x = pk2(s[0 * 33], s[1 * 33]); o.y = pk2(s[2 * 33], s[3 * 33]); o.z = pk2(s[4 * 33], s[5 * 33]); o.w = pk2(s[6 * 33], s[7 * 33]);
        *(v4u*)(WT + (size_t)(n0 + n) * K + k0 + 8 * c) = o; }
    LDS_WAIT();
}
struct ConvJob { int in_idx; int K, Nsrc, Ndst, kind; size_t wo; };
__device__ __forceinline__ void convert_weights(unsigned char* ws, const float* const* tab, int l, char* lds, int gw, int NGW, int wave, int lane) {
    float* scr = (float*)(lds + wave * 8448);
    bf16* Wb = (bf16*)(ws + WS_W);
    const int  jin[13]  = {3, 4, 7, 11, 22, 24, 20, 25, 29, 30, 31, 34, 35};
    const int  jK[13]   = {1024, 2816, 1024, 256, 256, 512, 256, 1024, 1024, 1024, 1024, 1024, 2816};
    const int  jNs[13]  = {5632, 1024, D_IN, 1024, 1024, 1024, 256, 1024, 1024, 2048, 1024, 5632, 1024};
    const int  jNd[13]  = {5632, 1024, 5888, 1024, 1024, 1024, 256, 1024, 1024, 2048, 1024, 5632, 1024};
    const int  jkind[13]= {1, 0, 2, 0, 0, 0, 0, 0, 0, 0, 0, 1, 0};
    const size_t jwo[13]= {WO_GU1, WO_DOWN1, WO_IN, WO_GLAUP, WO_S5UP, WO_FOXUP, WO_GLU, WO_MIXOUT, WO_Q, WO_KV, WO_O, WO_GU2, WO_DOWN2};
    int base = 0;
#pragma unroll
    for (int j = 0; j < 13; ++j) {
        const int K = jK[j], Ns = jNs[j], Nd = jNd[j];
        const int nitems = (K / 64) * (Nd / 32);
        const float* W = tab[jin[j]] + (size_t)l * K * Ns;
        int first = (gw - (base % NGW) + NGW) % NGW;
        for (int it = first; it < nitems; it += NGW) transpose_item(W, K, Ns, Nd, jkind[j], Wb + jwo[j], scr, it, lane);
        base += nitems;
    }
}
__device__ __forceinline__ void s5_prep(unsigned char* ws, const float* const* tab, int l, int gtid, int GT) {
    unsigned char* sp = ws + WS_S5P;
    float2* ABAR = (float2*)(sp + S5P_ABAR); float2* A64 = (float2*)(sp + S5P_A64); float2* BBAR = (float2*)(sp + S5P_BBAR); bf16* CMAT = (bf16*)(sp + S5P_CMAT);
    const float* a_re = tab[12] + l * 1024; const float* a_im = tab[13] + l * 1024; const float* log_dt = tab[14] + l * 16;
    const float* b_re = tab[15] + (size_t)l * 16384; const float* b_im = tab[16] + (size_t)l * 16384;
    const float* c_re = tab[17] + (size_t)l * 16384; const float* c_im = tab[18] + (size_t)l * 16384;
    for (int idx = gtid; idx < 1024; idx += GT) {
        const int g = idx >> 6;
        const float lre = fminf(a_re[idx], -1e-4f), lim = a_im[idx], dt = expf(log_dt[g]);
        const float mag = expf(lre * dt);
        float sn, cs; sincosf(lim * dt, &sn, &cs);
        const float abr = mag * cs, abi = mag * sn;
        const float den = lre * lre + lim * lim;
        const float zr = ((abr - 1.0f) * lre + abi * lim) / den, zi = (abi * lre - (abr - 1.0f) * lim) / den;
        ABAR[idx] = make_float2(abr, abi);
        float pr = abr, pi = abi;
#pragma unroll
        for (int s = 0; s < 6; ++s) { const float nr = pr * pr - pi * pi, ni = 2.0f * pr * pi; pr = nr; pi = ni; }
        A64[idx] = make_float2(pr, pi);
        for (int h = 0; h < 16; ++h) { const float br = b_re[idx * 16 + h], bi = b_im[idx * 16 + h]; BBAR[idx * 16 + h] = make_float2(zr * br - zi * bi, zr * bi + zi * br); }
    }
    for (int idx = gtid; idx < 32768; idx += GT) {
        const int j = idx & 7, ln = (idx >> 3) & 63, ks = (idx >> 9) & 3, g = idx >> 11;
        const int k = 32 * ks + 8 * (ln >> 4) + j, h = ln & 15;
        const float v = k < 64 ? c_re[(g * 16 + h) * 64 + k] : -c_im[(g * 16 + h) * 64 + (k - 64)];
        CMAT[idx] = (bf16)f2bf(v);
    }
}
template <bool HASY, bool HASX, bool HASH>
__device__ __forceinline__ void rowop(const float* xin, float* xout, const bf16* Y, const float* postg, float coef, const float* preg, bf16* H, int nrows, int gw, int NGW, int lane) {
    for (int m = gw; m < nrows; m += NGW) {
        const f32x4* xr = (const f32x4*)(xin + (size_t)m * DM) + lane;
        f32x4 v[4];
#pragma unroll
        for (int j = 0; j < 4; ++j) v[j] = xr[64 * j];
        if (HASY) {
            const v2u* yr = (const v2u*)(Y + (size_t)m * DM) + lane; f32x4 y[4]; float s = 0.f;
#pragma unroll
            for (int j = 0; j < 4; ++j) { const v2u w = yr[64 * j]; y[j] = (f32x4){bflo(w.x), bfhi(w.x), bflo(w.y), bfhi(w.y)}; s += (y[j].x * y[j].x + y[j].y * y[j].y) + (y[j].z * y[j].z + y[j].w * y[j].w); }
            const float r = coef / sqrtf(wave_sum(s) * (1.0f / DM) + EPS);
#pragma unroll
            for (int j = 0; j < 4; ++j) { const f32x4 g = ((const f32x4*)postg)[lane + 64 * j]; v[j] += y[j] * g * r; }
        }
        if (HASX) { f32x4* xo = (f32x4*)(xout + (size_t)m * DM) + lane;
#pragma unroll
            for (int j = 0; j < 4; ++j) xo[64 * j] = v[j]; }
        if (HASH) {
            float s2 = 0.f;
#pragma unroll
            for (int j = 0; j < 4; ++j) s2 += (v[j].x * v[j].x + v[j].y * v[j].y) + (v[j].z * v[j].z + v[j].w * v[j].w);
            const float r2 = 1.0f / sqrtf(wave_sum(s2) * (1.0f / DM) + EPS);
            v2u* ho = (v2u*)(H + (size_t)m * DM) + lane;
#pragma unroll
            for (int j = 0; j < 4; ++j) { const f32x4 g = ((const f32x4*)preg)[lane + 64 * j]; v2u w; w.x = pk2(v[j].x * r2 * g.x, v[j].y * r2 * g.y); w.y = pk2(v[j].z * r2 * g.z, v[j].w * r2 * g.w); ho[64 * j] = w; }
        }
    }
}
template <int DH, bool FOX>
__device__ __forceinline__ void attn_unit(char* lds, const bf16* Qp, int ldq, const bf16* Kp, int ldk, const bf16* Vp, int ldv, bf16* Op, int ldo,
                                          int qpos0, int nkt, int mask_from, const float* Fc, float scale, int tid) {
    constexpr int KS = DH + 8, VS = 72, NPASS = DH / 64, CPR = DH / 8;
    bf16* Ks = (bf16*)lds; bf16* Vt = Ks + 64 * KS;
    const int lane = tid & 63, wave = tid >> 6, li = lane & 15, qd = lane >> 4;
    bf16x8 qf[DH / 32];
    { const bf16* qrow = Qp + (size_t)(wave * 16 + li) * ldq;
#pragma unroll
      for (int ks = 0; ks < DH / 32; ++ks) { const v4u w = *(const v4u*)(qrow + 32 * ks + 8 * qd); const float qs = scale * 1.4426950408889634f;
          v4u o; o.x = pk2(bflo(w.x) * qs, bfhi(w.x) * qs); o.y = pk2(bflo(w.y) * qs, bfhi(w.y) * qs); o.z = pk2(bflo(w.z) * qs, bfhi(w.z) * qs); o.w = pk2(bflo(w.w) * qs, bfhi(w.w) * qs);
          qf[ks] = __builtin_bit_cast(bf16x8, o); } }
    const int qpos = qpos0 + wave * 16 + li;
    f32x4 oacc[DH / 16];
#pragma unroll
    for (int i = 0; i < DH / 16; ++i) oacc[i] = (f32x4){0.f, 0.f, 0.f, 0.f};
    float mrun = -INFINITY, lsum = 0.f;
    v4u kregA[NPASS], vregA[NPASS], kregB[NPASS], vregB[NPASS];
    const bf16* kbase = Kp + (size_t)(tid / CPR) * ldk + (tid % CPR) * 8;
    const bf16* vbase = Vp + (size_t)(tid >> 3) * ldv + (tid & 7) * 8;
#define ATTN_PREFETCH(KR, VR, T) do { if ((T) < nkt) { _Pragma("unroll") for (int ps = 0; ps < NPASS; ++ps) { \
        KR[ps] = *(const v4u*)(kbase + (size_t)((T) * 64 + ps * (NTHR / CPR)) * ldk); VR[ps] = *(const v4u*)(vbase + (size_t)(ps * 64) * ldv + (T) * 64); } } } while (0)
    constexpr int PD = (DH == 64) ? 2 : 1;
    auto& kreg2 = *(PD == 2 ? &kregB : &kregA); auto& vreg2 = *(PD == 2 ? &vregB : &vregA);
    ATTN_PREFETCH(kregA, vregA, 0);
    if (PD == 2) ATTN_PREFETCH(kregB, vregB, 1);
    for (int kt2 = 0; kt2 < nkt; kt2 += 2) {
#define KR kregA
#define VR vregA
      { const int kt = kt2;
        __syncthreads();
#pragma unroll
        for (int ps = 0; ps < NPASS; ++ps) { const int c = tid + NTHR * ps, key = c / CPR, dc = c % CPR;
            *(v4u*)(Ks + key * KS + dc * 8) = KR[ps];
            *(v4u*)(Vt + (c >> 3) * VS + (c & 7) * 8) = VR[ps]; }
        __syncthreads();
        ATTN_PREFETCH(KR, VR, kt + PD);
        f32x4 s[4];
#pragma unroll
        for (int kb = 0; kb < 4; ++kb) { s[kb] = FOX ? *(const f32x4*)(Fc + kt * 64 + 16 * kb + 4 * qd) : (f32x4){0.f, 0.f, 0.f, 0.f};
#pragma unroll
            for (int ks = 0; ks < DH / 32; ++ks) { const bf16x8 a = *(const bf16x8*)(Ks + (16 * kb + li) * KS + 32 * ks + 8 * qd); s[kb] = __builtin_amdgcn_mfma_f32_16x16x32_bf16(a, qf[ks], s[kb], 0, 0, 0); } }
        float tmax = -INFINITY;
#pragma unroll
        for (int kb = 0; kb < 4; ++kb)
#pragma unroll
            for (int i = 0; i < 4; ++i) { float v = s[kb][i];
                if (FOX && kt >= mask_from) { const int key = kt * 64 + 16 * kb + 4 * qd + i; if (key > qpos) v = -INFINITY; s[kb][i] = v; }
                tmax = fmaxf(tmax, v); }
        tmax = fmaxf(tmax, __shfl_xor(tmax, 16)); tmax = fmaxf(tmax, __shfl_xor(tmax, 32));
        const float mnew = fmaxf(mrun, tmax);
        const float alpha = __builtin_amdgcn_exp2f(mrun - mnew);
        mrun = mnew;
        float psum = 0.f;
#pragma unroll
        for (int kb = 0; kb < 4; ++kb)
#pragma unroll
            for (int i = 0; i < 4; ++i) { const float e = __builtin_amdgcn_exp2f(s[kb][i] - mnew); s[kb][i] = e; psum += e; }
        lsum = lsum * alpha + psum;
#pragma unroll
        for (int i = 0; i < DH / 16; ++i) oacc[i] *= alpha;
        bf16x8 pf[2];
#pragma unroll
        for (int kk = 0; kk < 2; ++kk) { v4u w; w.x = pk2(s[2 * kk][0], s[2 * kk][1]); w.y = pk2(s[2 * kk][2], s[2 * kk][3]); w.z = pk2(s[2 * kk + 1][0], s[2 * kk + 1][1]); w.w = pk2(s[2 * kk + 1][2], s[2 * kk + 1][3]);
            pf[kk] = __builtin_bit_cast(bf16x8, w); }
#pragma unroll
        for (int db = 0; db < DH / 16; ++db)
#pragma unroll
            for (int kk = 0; kk < 2; ++kk) { const bf16* vp = Vt + (16 * db + li) * VS + 32 * kk + 4 * qd;
                const v2u lo = *(const v2u*)vp, hi = *(const v2u*)(vp + 16);
                v4u w; w.x = lo.x; w.y = lo.y; w.z = hi.x; w.w = hi.y;
                oacc[db] = __builtin_amdgcn_mfma_f32_16x16x32_bf16(__builtin_bit_cast(bf16x8, w), pf[kk], oacc[db], 0, 0, 0); }
      }
#undef KR
#undef VR
#define KR kreg2
#define VR vreg2
      { const int kt = kt2 + 1;
        __syncthreads();
#pragma unroll
        for (int ps = 0; ps < NPASS; ++ps) { const int c = tid + NTHR * ps, key = c / CPR, dc = c % CPR;
            *(v4u*)(Ks + key * KS + dc * 8) = KR[ps];
            *(v4u*)(Vt + (c >> 3) * VS + (c & 7) * 8) = VR[ps]; }
        __syncthreads();
        ATTN_PREFETCH(KR, VR, kt + PD);
        f32x4 s[4];
#pragma unroll
        for (int kb = 0; kb < 4; ++kb) { s[kb] = FOX ? *(const f32x4*)(Fc + kt * 64 + 16 * kb + 4 * qd) : (f32x4){0.f, 0.f, 0.f, 0.f};
#pragma unroll
            for (int ks = 0; ks < DH / 32; ++ks) { const bf16x8 a = *(const bf16x8*)(Ks + (16 * kb + li) * KS + 32 * ks + 8 * qd); s[kb] = __builtin_amdgcn_mfma_f32_16x16x32_bf16(a, qf[ks], s[kb], 0, 0, 0); } }
        float tmax = -INFINITY;
#pragma unroll
        for (int kb = 0; kb < 4; ++kb)
#pragma unroll
            for (int i = 0; i < 4; ++i) { float v = s[kb][i];
                if (FOX && kt >= mask_from) { const int key = kt * 64 + 16 * kb + 4 * qd + i; if (key > qpos) v = -INFINITY; s[kb][i] = v; }
                tmax = fmaxf(tmax, v); }
        tmax = fmaxf(tmax, __shfl_xor(tmax, 16)); tmax = fmaxf(tmax, __shfl_xor(tmax, 32));
        const float mnew = fmaxf(mrun, tmax);
        const float alpha = __builtin_amdgcn_exp2f(mrun - mnew);
        mrun = mnew;
        float psum = 0.f;
#pragma unroll
        for (int kb = 0; kb < 4; ++kb)
#pragma unroll
            for (int i = 0; i < 4; ++i) { const float e = __builtin_amdgcn_exp2f(s[kb][i] - mnew); s[kb][i] = e; psum += e; }
        lsum = lsum * alpha + psum;
#pragma unroll
        for (int i = 0; i < DH / 16; ++i) oacc[i] *= alpha;
        bf16x8 pf[2];
#pragma unroll
        for (int kk = 0; kk < 2; ++kk) { v4u w; w.x = pk2(s[2 * kk][0], s[2 * kk][1]); w.y = pk2(s[2 * kk][2], s[2 * kk][3]); w.z = pk2(s[2 * kk + 1][0], s[2 * kk + 1][1]); w.w = pk2(s[2 * kk + 1][2], s[2 * kk + 1][3]);
            pf[kk] = __builtin_bit_cast(bf16x8, w); }
#pragma unroll
        for (int db = 0; db < DH / 16; ++db)
#pragma unroll
            for (int kk = 0; kk < 2; ++kk) { const bf16* vp = Vt + (16 * db + li) * VS + 32 * kk + 4 * qd;
                const v2u lo = *(const v2u*)vp, hi = *(const v2u*)(vp + 16);
                v4u w; w.x = lo.x; w.y = lo.y; w.z = hi.x; w.w = hi.y;
                oacc[db] = __builtin_amdgcn_mfma_f32_16x16x32_bf16(__builtin_bit_cast(bf16x8, w), pf[kk], oacc[db], 0, 0, 0); }
      }
#undef KR
#undef VR
    }
#undef ATTN_PREFETCH
    lsum += __shfl_xor(lsum, 16); lsum += __shfl_xor(lsum, 32);
    const float inv = 1.0f / lsum;
    bf16* orow = Op + (size_t)(wave * 16 + li) * ldo + 4 * qd;
#pragma unroll
    for (int db = 0; db < DH / 16; ++db) { v2u w; w.x = pk2(oacc[db][0] * inv, oacc[db][1] * inv); w.y = pk2(oacc[db][2] * inv, oacc[db][3] * inv); *(v2u*)(orow + 16 * db) = w; }
}
__device__ __forceinline__ void fox_cumsum(const bf16* P, int b, int h, float fb, float* Fc, float* red, int tid) {
    const int lane = tid & 63, wave = tid >> 6;
    float lf[4];
#pragma unroll
    for (int i = 0; i < 4; ++i) { const float z = bf2f(P[(size_t)(b * SEQ + 4 * tid + i) * LDP + PC_FF + h]) + fb; lf[i] = logsig(z); }
    const float loc = (lf[0] + lf[1]) + (lf[2] + lf[3]);
    float inc = loc;
#pragma unroll
    for (int o = 1; o < 64; o <<= 1) { const float t = __shfl_up(inc, o); if (lane >= o) inc += t; }
    __syncthreads();
    if (lane == 63) red[wave] = inc;
    __syncthreads();
    float off = inc - loc;
    for (int w = 0; w < wave; ++w) off += red[w];
    float run = off;
#pragma unroll
    for (int i = 0; i < 4; ++i) { run += lf[i]; Fc[4 * tid + i] = -run * 1.4426950408889634f; }
    __syncthreads();
}
__device__ __forceinline__ void s5_load_u(const bf16* P, int row0, int g, float* us, int lane) {
    const v4u* src = (const v4u*)(P + (size_t)(row0 + lane) * LDP + PC_SU + g * 16);
    const v4u a = src[0], c = src[1];
    f32x4* dst = (f32x4*)(us + lane * 16);
    dst[0] = (f32x4){bflo(a.x), bfhi(a.x), bflo(a.y), bfhi(a.y)}; dst[1] = (f32x4){bflo(a.z), bfhi(a.z), bflo(a.w), bfhi(a.w)};
    dst[2] = (f32x4){bflo(c.x), bfhi(c.x), bflo(c.y), bfhi(c.y)}; dst[3] = (f32x4){bflo(c.z), bfhi(c.z), bflo(c.w), bfhi(c.w)};
    LDS_WAIT();
}
__device__ __forceinline__ void s5_bu(const float* us, int t, const float (&bre)[16], const float (&bim)[16], float& bur, float& bui) {
    const f32x4* up = (const f32x4*)(us + t * 16);
    bur = 0.f; bui = 0.f;
#pragma unroll
    for (int q = 0; q < 4; ++q) { const f32x4 u4 = up[q];
#pragma unroll
        for (int j = 0; j < 4; ++j) { bur += bre[4 * q + j] * u4[j]; bui += bim[4 * q + j] * u4[j]; } }
}
__device__ __forceinline__ void s5_passA(unsigned char* ws, const float* const* tab, char* lds, int gw, int NGW, int wave, int lane) {
    const bf16* P = (const bf16*)(ws + WS_P);
    const float2* ABAR = (const float2*)(ws + WS_S5P + S5P_ABAR); const float2* BBAR = (const float2*)(ws + WS_S5P + S5P_BBAR);
    float* L = (float*)(ws + WS_S5L);
    float* us = (float*)(lds + wave * 4096);
    for (int u = gw; u < 4096; u += NGW) {
        const int n = u & 31, g = (u >> 5) & 15, b = u >> 9;
        LDS_WAIT();
        s5_load_u(P, b * SEQ + n * 64, g, us, lane);
        float bre[16], bim[16];
#pragma unroll
        for (int h = 0; h < 16; ++h) { const float2 v = BBAR[(g * 64 + lane) * 16 + h]; bre[h] = v.x; bim[h] = v.y; }
        const float2 ab = ABAR[g * 64 + lane];
        float xr = 0.f, xi = 0.f;
        for (int t = 0; t < 64; ++t) { float bur, bui; s5_bu(us, t, bre, bim, bur, bui);
            const float nr = ab.x * xr - ab.y * xi + bur, ni = ab.x * xi + ab.y * xr + bui; xr = nr; xi = ni; }
        L[(size_t)u * 128 + lane] = xr; L[(size_t)u * 128 + 64 + lane] = xi;
    }
}
__device__ __forceinline__ void s5_passC(unsigned char* ws, const float* const* tab, int l, char* lds, int unit, int tid) {
    const int lane = tid & 63, wave = tid >> 6, li = lane & 15, qd = lane >> 4;
    const int b = unit >> 5, n = unit & 31, row0 = b * SEQ + n * 64;
    const bf16* P = (const bf16*)(ws + WS_P);
    const float2* ABAR = (const float2*)(ws + WS_S5P + S5P_ABAR); const float2* A64 = (const float2*)(ws + WS_S5P + S5P_A64);
    const float2* BBAR = (const float2*)(ws + WS_S5P + S5P_BBAR); const bf16* CMAT = (const bf16*)(ws + WS_S5P + S5P_CMAT);
    const float* L = (const float*)(ws + WS_S5L);
    bf16* Xs = (bf16*)(lds + wave * 8704);
    float* us = (float*)(lds + 69632 + wave * 4096);
    bf16* Ys = (bf16*)(lds + 102400);
    __syncthreads();
    for (int gi = 0; gi < 2; ++gi) {
        const int g = 2 * wave + gi;
        LDS_WAIT();
        s5_load_u(P, row0, g, us, lane);
        float xr = 0.f, xi = 0.f;
        { const float2 a64 = A64[g * 64 + lane]; const float* Lb = L + (size_t)((b * 16 + g) * 32) * 128 + lane;
          for (int m0 = 0; m0 < n; m0 += 8) { float lr[8], lim[8];
#pragma unroll
              for (int j = 0; j < 8; ++j) { const bool ok = (m0 + j) < n; const int mi = ok ? (m0 + j) : 0; lr[j] = Lb[mi * 128]; lim[j] = Lb[mi * 128 + 64]; if (!ok) { lr[j] = __builtin_nanf(""); } }
#pragma unroll
              for (int j = 0; j < 8; ++j) { if (lr[j] == lr[j]) { const float nr = a64.x * xr - a64.y * xi + lr[j], ni = a64.x * xi + a64.y * xr + lim[j]; xr = nr; xi = ni; } } } }
        float bre[16], bim[16];
#pragma unroll
        for (int h = 0; h < 16; ++h) { const float2 v = BBAR[(g * 64 + lane) * 16 + h]; bre[h] = v.x; bim[h] = v.y; }
        const float2 ab = ABAR[g * 64 + lane];
        bf16x8 cfr[4];
#pragma unroll
        for (int ks = 0; ks < 4; ++ks) cfr[ks] = *(const bf16x8*)(CMAT + ((size_t)((g * 4 + ks) * 64 + lane)) * 8);
        const float dsk = tab[19][l * 256 + g * 16 + li];
        for (int half = 0; half < 2; ++half) {
            for (int tt = 0; tt < 32; ++tt) { const int t = half * 32 + tt; float bur, bui; s5_bu(us, t, bre, bim, bur, bui);
                const float nr = ab.x * xr - ab.y * xi + bur, ni = ab.x * xi + ab.y * xr + bui; xr = nr; xi = ni;
                Xs[tt * 136 + lane] = (bf16)f2bf(xr); Xs[tt * 136 + 64 + lane] = (bf16)f2bf(xi); }
            LDS_WAIT();
#pragma unroll
            for (int rb = 0; rb < 2; ++rb) { f32x4 acc = (f32x4){0.f, 0.f, 0.f, 0.f};
#pragma unroll
                for (int ks = 0; ks < 4; ++ks) { const bf16x8 a = *(const bf16x8*)(Xs + (16 * rb + li) * 136 + 32 * ks + 8 * qd); acc = __builtin_amdgcn_mfma_f32_16x16x32_bf16(a, cfr[ks], acc, 0, 0, 0); }
#pragma unroll
                for (int i = 0; i < 4; ++i) { const int t = half * 32 + 16 * rb + 4 * qd + i; const float yv = gelu_tanh(acc[i] + dsk * us[t * 16 + li]); Ys[t * 264 + g * 16 + li] = (bf16)f2bf(yv); } }
            LDS_WAIT();
        }
    }
    __syncthreads();
    { const bf16* Wg = (const bf16*)(ws + WS_W) + WO_GLU; const float* gb = tab[21] + l * 256; bf16* BRS = (bf16*)(ws + WS_BRS);
      f32x4 acc[4][2];
#pragma unroll
      for (int rb = 0; rb < 4; ++rb) { acc[rb][0] = (f32x4){0.f, 0.f, 0.f, 0.f}; acc[rb][1] = (f32x4){0.f, 0.f, 0.f, 0.f}; }
#pragma unroll
      for (int ks = 0; ks < 8; ++ks) { bf16x8 bfr[2];
#pragma unroll
          for (int cb = 0; cb < 2; ++cb) bfr[cb] = *(const bf16x8*)(Wg + (size_t)(32 * wave + 16 * cb + li) * 256 + 32 * ks + 8 * qd);
#pragma unroll
          for (int rb = 0; rb < 4; ++rb) { const bf16x8 a = *(const bf16x8*)(Ys + (16 * rb + li) * 264 + 32 * ks + 8 * qd);
#pragma unroll
              for (int cb = 0; cb < 2; ++cb) acc[rb][cb] = __builtin_amdgcn_mfma_f32_16x16x32_bf16(a, bfr[cb], acc[rb][cb], 0, 0, 0); } }
#pragma unroll
      for (int rb = 0; rb < 4; ++rb)
#pragma unroll
          for (int cb = 0; cb < 2; ++cb) { const int col = 32 * wave + 16 * cb + li; const float bias = gb[col];
#pragma unroll
              for (int i = 0; i < 4; ++i) { const int t = 16 * rb + 4 * qd + i; const float yv = bf2f(Ys[t * 264 + col]); const float o = yv * sigmoidf_(acc[rb][cb][i] + bias);
                  BRS[(size_t)(row0 + t) * 256 + col] = (bf16)f2bf(o); } } }
    __syncthreads();
}
struct GlaLds { float* QF; float* QI; float* KI; float* KE; float* G; float* V; float* AT; float* SP; float* GD; };
__device__ __forceinline__ GlaLds gla_lds(char* lds) { GlaLds s; float* f = (float*)lds; s.QF = f; s.QI = f + 2112; s.KI = f + 4224; s.KE = f + 6336; s.G = f + 8448; s.V = f + 10560; s.AT = f + 14656; s.SP = f + 18816; s.GD = f + 20864; return s; }
__device__ __forceinline__ void gla_load(unsigned char* ws, const float* const* tab, int l, const GlaLds& s, int row0, int h, int tid, bool need_q) {
    const bf16* P = (const bf16*)(ws + WS_P);
    const int t = tid >> 3, c8 = tid & 7;
    const bf16* prow = P + (size_t)(row0 + t) * LDP;
    if (need_q) { const v2u w = *(const v2u*)(prow + PC_GQ + h * 32 + 4 * c8); float* d = s.QF + t * 33 + 4 * c8; d[0] = bflo(w.x); d[1] = bfhi(w.x); d[2] = bflo(w.y); d[3] = bfhi(w.y); }
    { const v2u w = *(const v2u*)(prow + PC_GK + h * 32 + 4 * c8); float* d = s.KI + t * 33 + 4 * c8; d[0] = bflo(w.x); d[1] = bfhi(w.x); d[2] = bflo(w.y); d[3] = bfhi(w.y); }
    { const v4u w = *(const v4u*)(prow + PC_GV + h * 64 + 8 * c8); f32x4* d = (f32x4*)(s.V + t * 64 + 8 * c8); d[0] = (f32x4){bflo(w.x), bfhi(w.x), bflo(w.y), bfhi(w.y)}; d[1] = (f32x4){bflo(w.z), bfhi(w.z), bflo(w.w), bfhi(w.w)}; }
    if (tid < 128) { const int tt = tid >> 1, hf = tid & 1; const v4u w = *(const v4u*)(P + (size_t)(row0 + tt) * LDP + PC_GD + 8 * hf); float* d = s.GD + tt * 16 + 8 * hf;
        d[0] = bflo(w.x); d[1] = bfhi(w.x); d[2] = bflo(w.y); d[3] = bfhi(w.y); d[4] = bflo(w.z); d[5] = bfhi(w.z); d[6] = bflo(w.w); d[7] = bfhi(w.w); }
    __syncthreads();
    const float* gw = tab[8] + l * 2048; const float* gbias = tab[9] + l * 128;
#pragma unroll
    for (int i = 0; i < 4; ++i) { const int d = 4 * c8 + i; float z = gbias[h * 32 + d];
#pragma unroll
        for (int r = 0; r < 16; ++r) z += s.GD[t * 16 + r] * gw[r * 128 + h * 32 + d];
        s.G[t * 33 + d] = logsig(z) * (1.0f / 16.0f); }
    __syncthreads();
    if (tid < 32) { float v[64];
#pragma unroll
        for (int tt = 0; tt < 64; ++tt) v[tt] = s.G[tt * 33 + tid];
#pragma unroll
        for (int tt = 1; tt < 64; ++tt) v[tt] += v[tt - 1];
#pragma unroll
        for (int tt = 0; tt < 64; ++tt) s.G[tt * 33 + tid] = v[tt]; }
    __syncthreads();
}
__device__ __forceinline__ void gla_passA(unsigned char* ws, const float* const* tab, int l, char* lds, int unit, int tid) {
    const GlaLds s = gla_lds(lds);
    const int b = unit >> 5, n = unit & 31, row0 = b * SEQ + n * 64;
    float* DS = (float*)(ws + WS_DS); float* DEC = (float*)(ws + WS_DEC);
    __syncthreads();
    for (int h = 0; h < 4; ++h) {
        gla_load(ws, tab, l, s, row0, h, tid, false);
        { const int t = tid >> 3, c8 = tid & 7;
#pragma unroll
          for (int i = 0; i < 4; ++i) { const int d = 4 * c8 + i; s.KI[t * 33 + d] *= expf(s.G[63 * 33 + d] - s.G[t * 33 + d]); } }
        __syncthreads();
        { const int d = tid >> 4, e0 = 4 * (tid & 15); f32x4 acc = (f32x4){0.f, 0.f, 0.f, 0.f};
          for (int c = 0; c < 64; ++c) acc += s.KI[c * 33 + d] * *(const f32x4*)(s.V + c * 64 + e0);
          const size_t ub = (size_t)((b * 4 + h) * 32 + n);
          *(f32x4*)(DS + ub * 2048 + d * 64 + e0) = acc;
          if ((tid & 15) == 0) DEC[ub * 32 + d] = expf(s.G[63 * 33 + d]); }
        __syncthreads();
    }
}
__device__ __forceinline__ void gla_passC(unsigned char* ws, const float* const* tab, int l, char* lds, int unit, int tid) {
    const GlaLds s = gla_lds(lds);
    const int b = unit >> 5, n = unit & 31, row0 = b * SEQ + n * 64;
    const float* DS = (const float*)(ws + WS_DS); const float* DEC = (const float*)(ws + WS_DEC);
    const bf16* P = (const bf16*)(ws + WS_P); bf16* BRG = (bf16*)(ws + WS_BRG);
    const float* gn = tab[10] + l * 256;
    __syncthreads();
    for (int h = 0; h < 4; ++h) {
        gla_load(ws, tab, l, s, row0, h, tid, true);
        { const int t = tid >> 3, c8 = tid & 7;
#pragma unroll
          for (int i = 0; i < 4; ++i) { const int d = 4 * c8 + i; const float g = s.G[t * 33 + d]; const float eg = expf(g), ieg = expf(-g);
              const float q = s.QF[t * 33 + d] * 0.17677669529663687f, k = s.KI[t * 33 + d];
              s.QF[t * 33 + d] = q * eg; s.QI[t * 33 + d] = q * ieg; s.KI[t * 33 + d] = k * ieg; s.KE[t * 33 + d] = k * eg; } }
        __syncthreads();
        { const int i = tid >> 3, jb = tid & 7;
#pragma unroll
          for (int jj = 0; jj < 8; ++jj) { const int j = jb + 8 * jj; const float* qa = (j <= i) ? s.QF : s.QI; const float* kb = (j <= i) ? s.KI : s.KE; float dot = 0.f;
#pragma unroll
              for (int d = 0; d < 32; ++d) dot += qa[i * 33 + d] * kb[j * 33 + d];
              s.AT[i * 65 + j] = dot; } }
        { const int idx4 = tid * 4, d = idx4 >> 6; f32x4 S = (f32x4){0.f, 0.f, 0.f, 0.f};
          const float* base = DS + (size_t)((b * 4 + h) * 32) * 2048 + idx4; const float* decb = DEC + (size_t)((b * 4 + h) * 32) * 32 + d;
          for (int m0 = 0; m0 < n; m0 += 8) { f32x4 v[8]; float dd[8];
#pragma unroll
              for (int j = 0; j < 8; ++j) { const bool ok = (m0 + j) < n; const int mi = ok ? (m0 + j) : 0; v[j] = *(const f32x4*)(base + (size_t)mi * 2048); dd[j] = decb[mi * 32];
                  if (!ok) { v[j] = (f32x4){0.f, 0.f, 0.f, 0.f}; dd[j] = 1.0f; } }
#pragma unroll
              for (int j = 0; j < 8; ++j) S = S * dd[j] + v[j]; }
          *(f32x4*)(s.SP + idx4) = S; }
        __syncthreads();
        { const int i = tid >> 3, e0 = 8 * (tid & 7); f32x4 a0 = (f32x4){0.f, 0.f, 0.f, 0.f}, a1 = a0;
          for (int j = 0; j < 64; ++j) { const float a = s.AT[i * 65 + j]; a0 += a * *(const f32x4*)(s.V + j * 64 + e0); a1 += a * *(const f32x4*)(s.V + j * 64 + e0 + 4); }
          for (int d = 0; d < 32; ++d) { const float a = s.QF[i * 33 + d]; a0 += a * *(const f32x4*)(s.SP + d * 64 + e0); a1 += a * *(const f32x4*)(s.SP + d * 64 + e0 + 4); }
          float ss = (a0[0] * a0[0] + a0[1] * a0[1]) + (a0[2] * a0[2] + a0[3] * a0[3]) + (a1[0] * a1[0] + a1[1] * a1[1]) + (a1[2] * a1[2] + a1[3] * a1[3]);
          ss += __shfl_xor(ss, 1); ss += __shfl_xor(ss, 2); ss += __shfl_xor(ss, 4);
          const float r = 1.0f / sqrtf(ss * (1.0f / 64.0f) + EPS);
          const v4u gr = *(const v4u*)(P + (size_t)(row0 + i) * LDP + PC_GR + h * 64 + e0);
          const float grv[8] = {bflo(gr.x), bfhi(gr.x), bflo(gr.y), bfhi(gr.y), bflo(gr.z), bfhi(gr.z), bflo(gr.w), bfhi(gr.w)};
          float o[8];
#pragma unroll
          for (int k = 0; k < 8; ++k) { const float v = (k < 4 ? a0[k & 3] : a1[k & 3]) * r * gn[h * 64 + e0 + k]; const float gg = grv[k]; o[k] = v * gg * sigmoidf_(gg); }
          v4u w; w.x = pk2(o[0], o[1]); w.y = pk2(o[2], o[3]); w.z = pk2(o[4], o[5]); w.w = pk2(o[6], o[7]);
          *(v4u*)(BRG + (size_t)(row0 + i) * 256 + h * 64 + e0) = w; }
        __syncthreads();
    }
}

__device__ __forceinline__ void gla_passC_mfma(unsigned char* ws, const float* const* tab, int l, char* lds, int unit, int tid) {
    const int b = unit >> 5, n = unit & 31, row0 = b * SEQ + n * 64;
    const float* DS = (const float*)(ws + WS_DS); const float* DEC = (const float*)(ws + WS_DEC);
    const bf16* P = (const bf16*)(ws + WS_P); bf16* BRG = (bf16*)(ws + WS_BRG);
    const float* gn = tab[10] + l * 256; const float* gw = tab[8] + l * 2048; const float* gbias = tab[9] + l * 128;
    const int lane = tid & 63, wave = tid >> 6, li = lane & 15, qd = lane >> 4;
    const int slot = tid >> 8, st = tid & 255, t = st >> 2, c4 = st & 3, wr = wave & 3;
    char* sb = lds + slot * 52480;
    bf16* QFb = (bf16*)sb; bf16* QIb = QFb + 2560; bf16* KIb = QIb + 2560; bf16* KEb = KIb + 2560;
    bf16* Vt = (bf16*)(sb + 20480); bf16* ATb = (bf16*)(sb + 29696); bf16* SPt = (bf16*)(sb + 38912); float* Gs = (float*)(sb + 44032);
    float* GD = (float*)(lds + 104960);
    __syncthreads();
    if (tid < 128) { const int tt = tid >> 1, hf = tid & 1; const v4u w = *(const v4u*)(P + (size_t)(row0 + tt) * LDP + PC_GD + 8 * hf); float* d = GD + tt * 16 + 8 * hf;
        d[0] = bflo(w.x); d[1] = bfhi(w.x); d[2] = bflo(w.y); d[3] = bfhi(w.y); d[4] = bflo(w.z); d[5] = bfhi(w.z); d[6] = bflo(w.w); d[7] = bfhi(w.w); }
    for (int hp = 0; hp < 2; ++hp) {
        const int h = 2 * hp + slot;
        const bf16* prow = P + (size_t)(row0 + t) * LDP;
        const v4u qw = *(const v4u*)(prow + PC_GQ + h * 32 + 8 * c4);
        const v4u kw = *(const v4u*)(prow + PC_GK + h * 32 + 8 * c4);
        { const v4u v0 = *(const v4u*)(prow + PC_GV + h * 64 + 16 * c4), v1 = *(const v4u*)(prow + PC_GV + h * 64 + 16 * c4 + 8);
          bf16* vt = Vt + (16 * c4) * 72 + t;
          vt[0 * 72] = (bf16)(v0.x & 0xffffu); vt[1 * 72] = (bf16)(v0.x >> 16); vt[2 * 72] = (bf16)(v0.y & 0xffffu); vt[3 * 72] = (bf16)(v0.y >> 16);
          vt[4 * 72] = (bf16)(v0.z & 0xffffu); vt[5 * 72] = (bf16)(v0.z >> 16); vt[6 * 72] = (bf16)(v0.w & 0xffffu); vt[7 * 72] = (bf16)(v0.w >> 16);
          vt[8 * 72] = (bf16)(v1.x & 0xffffu); vt[9 * 72] = (bf16)(v1.x >> 16); vt[10 * 72] = (bf16)(v1.y & 0xffffu); vt[11 * 72] = (bf16)(v1.y >> 16);
          vt[12 * 72] = (bf16)(v1.z & 0xffffu); vt[13 * 72] = (bf16)(v1.z >> 16); vt[14 * 72] = (bf16)(v1.w & 0xffffu); vt[15 * 72] = (bf16)(v1.w >> 16); }
        __syncthreads();
#pragma unroll
        for (int i = 0; i < 8; ++i) { const int d = 8 * c4 + i; float z = gbias[h * 32 + d];
#pragma unroll
            for (int r = 0; r < 16; ++r) z += GD[t * 16 + r] * gw[r * 128 + h * 32 + d];
            Gs[t * 33 + d] = logsig(z) * (1.0f / 16.0f); }
        __syncthreads();
        if (st < 32) { float v[64];
#pragma unroll
            for (int tt = 0; tt < 64; ++tt) v[tt] = Gs[tt * 33 + st];
#pragma unroll
            for (int tt = 1; tt < 64; ++tt) v[tt] += v[tt - 1];
#pragma unroll
            for (int tt = 0; tt < 64; ++tt) Gs[tt * 33 + st] = v[tt]; }
        __syncthreads();
        { const float qv[8] = {bflo(qw.x), bfhi(qw.x), bflo(qw.y), bfhi(qw.y), bflo(qw.z), bfhi(qw.z), bflo(qw.w), bfhi(qw.w)};
          const float kv[8] = {bflo(kw.x), bfhi(kw.x), bflo(kw.y), bfhi(kw.y), bflo(kw.z), bfhi(kw.z), bflo(kw.w), bfhi(kw.w)};
          float qf[8], qi[8], ki[8], ke[8];
#pragma unroll
          for (int i = 0; i < 8; ++i) { const float g = Gs[t * 33 + 8 * c4 + i]; const float eg = expf(g), ieg = expf(-g); const float q = qv[i] * 0.17677669529663687f;
              qf[i] = q * eg; qi[i] = q * ieg; ki[i] = kv[i] * ieg; ke[i] = kv[i] * eg; }
          v4u w;
          w.x = pk2(qf[0], qf[1]); w.y = pk2(qf[2], qf[3]); w.z = pk2(qf[4], qf[5]); w.w = pk2(qf[6], qf[7]); *(v4u*)(QFb + t * 40 + 8 * c4) = w;
          w.x = pk2(qi[0], qi[1]); w.y = pk2(qi[2], qi[3]); w.z = pk2(qi[4], qi[5]); w.w = pk2(qi[6], qi[7]); *(v4u*)(QIb + t * 40 + 8 * c4) = w;
          w.x = pk2(ki[0], ki[1]); w.y = pk2(ki[2], ki[3]); w.z = pk2(ki[4], ki[5]); w.w = pk2(ki[6], ki[7]); *(v4u*)(KIb + t * 40 + 8 * c4) = w;
          w.x = pk2(ke[0], ke[1]); w.y = pk2(ke[2], ke[3]); w.z = pk2(ke[4], ke[5]); w.w = pk2(ke[6], ke[7]); *(v4u*)(KEb + t * 40 + 8 * c4) = w; }
        { const int idx8 = st * 8, d = idx8 >> 6, e0 = idx8 & 63; f32x4 S0 = (f32x4){0.f, 0.f, 0.f, 0.f}, S1 = S0;
          const float* base = DS + (size_t)((b * 4 + h) * 32) * 2048 + idx8; const float* decb = DEC + (size_t)((b * 4 + h) * 32) * 32 + d;
          for (int m0 = 0; m0 < n; m0 += 4) { f32x4 va[4], vb[4]; float dd[4];
#pragma unroll
              for (int j = 0; j < 4; ++j) { const bool ok = (m0 + j) < n; const int mi = ok ? (m0 + j) : 0; va[j] = *(const f32x4*)(base + (size_t)mi * 2048); vb[j] = *(const f32x4*)(base + (size_t)mi * 2048 + 4); dd[j] = decb[mi * 32];
                  if (!ok) { va[j] = (f32x4){0.f, 0.f, 0.f, 0.f}; vb[j] = va[j]; dd[j] = 1.0f; } }
#pragma unroll
              for (int j = 0; j < 4; ++j) { S0 = S0 * dd[j] + va[j]; S1 = S1 * dd[j] + vb[j]; } }
#pragma unroll
          for (int i = 0; i < 4; ++i) { SPt[(e0 + i) * 40 + d] = (bf16)f2bf(S0[i]); SPt[(e0 + 4 + i) * 40 + d] = (bf16)f2bf(S1[i]); } }
        __syncthreads();
        { const bf16x8 aqf = *(const bf16x8*)(QFb + (16 * wr + li) * 40 + 8 * qd), aqi = *(const bf16x8*)(QIb + (16 * wr + li) * 40 + 8 * qd);
#pragma unroll
          for (int cb = 0; cb < 4; ++cb) { const bf16x8 bki = *(const bf16x8*)(KIb + (16 * cb + li) * 40 + 8 * qd), bke = *(const bf16x8*)(KEb + (16 * cb + li) * 40 + 8 * qd);
              const f32x4 z4 = (f32x4){0.f, 0.f, 0.f, 0.f};
              const f32x4 af = __builtin_amdgcn_mfma_f32_16x16x32_bf16(aqf, bki, z4, 0, 0, 0), ab = __builtin_amdgcn_mfma_f32_16x16x32_bf16(aqi, bke, z4, 0, 0, 0);
#pragma unroll
              for (int r = 0; r < 4; ++r) { const int i = 16 * wr + 4 * qd + r, j = 16 * cb + li; ATb[i * 72 + j] = (bf16)f2bf(j <= i ? af[r] : ab[r]); } }
          LDS_WAIT();
          f32x4 oa[4];
#pragma unroll
          for (int cb = 0; cb < 4; ++cb) { oa[cb] = (f32x4){0.f, 0.f, 0.f, 0.f};
#pragma unroll
              for (int ks = 0; ks < 2; ++ks) { const bf16x8 a = *(const bf16x8*)(ATb + (16 * wr + li) * 72 + 32 * ks + 8 * qd), bv = *(const bf16x8*)(Vt + (16 * cb + li) * 72 + 32 * ks + 8 * qd);
                  oa[cb] = __builtin_amdgcn_mfma_f32_16x16x32_bf16(a, bv, oa[cb], 0, 0, 0); }
              const bf16x8 bs = *(const bf16x8*)(SPt + (16 * cb + li) * 40 + 8 * qd);
              oa[cb] = __builtin_amdgcn_mfma_f32_16x16x32_bf16(aqf, bs, oa[cb], 0, 0, 0); }
#pragma unroll
          for (int r = 0; r < 4; ++r) { float ss = (oa[0][r] * oa[0][r] + oa[1][r] * oa[1][r]) + (oa[2][r] * oa[2][r] + oa[3][r] * oa[3][r]);
              ss += __shfl_xor(ss, 1); ss += __shfl_xor(ss, 2); ss += __shfl_xor(ss, 4); ss += __shfl_xor(ss, 8);
              const float rs = 1.0f / sqrtf(ss * (1.0f / 64.0f) + EPS);
              const int i = 16 * wr + 4 * qd + r;
#pragma unroll
              for (int cb = 0; cb < 4; ++cb) { const int e = 16 * cb + li; const float gg = bf2f(P[(size_t)(row0 + i) * LDP + PC_GR + h * 64 + e]);
                  const float o = oa[cb][r] * rs * gn[h * 64 + e] * gg * sigmoidf_(gg);
                  BRG[(size_t)(row0 + i) * 256 + h * 64 + e] = (bf16)f2bf(o); } } }
        __syncthreads();
    }
}
#define XB_TMO      128
#define XB_XCNT(j)  (256  + 64 * (j))
#define XB_XSUB(j)  (1280 + 64 * (j))
#define XB_XGEN(j)  (2304 + 64 * (j))
#define XB_TOP      3328
#define XB_TOPGEN   3392
#define XCD_BAR_WORDS 3456
#define XB_SPIN_CAP (1u << 18)

__device__ __forceinline__ unsigned xb_ld(unsigned* p)              { return __hip_atomic_load(p, __ATOMIC_RELAXED, __HIP_MEMORY_SCOPE_AGENT); }
__device__ __forceinline__ unsigned xb_add(unsigned* p, unsigned v) { return __hip_atomic_fetch_add(p, v, __ATOMIC_RELAXED, __HIP_MEMORY_SCOPE_AGENT); }
__device__ __forceinline__ unsigned xb_xcc_id() { return (unsigned)__builtin_amdgcn_s_getreg((3 << 11) | 20) & 0xFu; }
#define XB_SPIN(cond, bar) do { unsigned _sp = 0; while (cond) { __builtin_amdgcn_s_sleep(1); \
    if ((++_sp & 255u) == 0u) { if (xb_ld(&(bar)[XB_TMO])) break; if (_sp > XB_SPIN_CAP) { atomicAdd(&(bar)[XB_TMO], 1u); break; } } } } while (0)

struct XcdBarrier {
    unsigned* bar; unsigned x;
    volatile LAS unsigned* st;
};

__device__ __forceinline__ XcdBarrier xcd_barrier_post(unsigned* bar, volatile LAS unsigned* st) {
    XcdBarrier b; b.bar = bar; b.x = xb_xcc_id(); b.st = st;
    if (threadIdx.x == 0) (void)xb_add(&bar[XB_XCNT(b.x)], 1u);
    return b;
}
__device__ __forceinline__ void xcd_barrier_complete(unsigned* bar, unsigned x, unsigned& nloc, unsigned& nx) {
    const unsigned G = gridDim.x * gridDim.y * gridDim.z;
    unsigned sum, cnt, mine, sp = 0u;
    for (;;) {
        sum = 0u; cnt = 0u; mine = 0u;
#pragma unroll
        for (unsigned j = 0; j < 16; ++j) { const unsigned c = xb_ld(&bar[XB_XCNT(j)]); sum += c; cnt += (c > 0u) ? 1u : 0u; mine = (j == x) ? c : mine; }
        if (sum == G) break;
        __builtin_amdgcn_s_sleep(1);
        if ((++sp & 255u) == 0u) { if (xb_ld(&bar[XB_TMO])) break; if (sp > XB_SPIN_CAP) { atomicAdd(&bar[XB_TMO], 1u); break; } }
    }
    nloc = mine > 0u ? mine : 1u; nx = cnt > 0u ? cnt : 1u;
}


__device__ __forceinline__ void xsync(unsigned char* wsb, int wave_s, volatile LAS unsigned* st) {
    unsigned char* wl_ = wsb; asm volatile("" : "+s"(wl_)); unsigned* bar = (unsigned*)(wl_ + 4096);
    int ln_; asm volatile("v_mbcnt_lo_u32_b32 %0, -1, 0\n\tv_mbcnt_hi_u32_b32 %0, -1, %0" : "=v"(ln_));
    asm volatile("s_waitcnt vmcnt(0)" ::: "memory");
    __syncthreads();
    if (wave_s == 0 && ln_ == 0) {
        __builtin_amdgcn_s_waitcnt(0);
        const unsigned x = xb_xcc_id();
        unsigned nloc = st[0], nx = st[1];
        if (nloc == 0u) { xcd_barrier_complete(bar, x, nloc, nx); st[0] = nloc; st[1] = nx; }
        const unsigned old = xb_add(&bar[XB_XSUB(x)], 1u);
        const unsigned gen = old / nloc;
        if (old + 1u == (gen + 1u) * nloc) {
            __builtin_amdgcn_fence(__ATOMIC_RELEASE, "agent");
            asm volatile("s_waitcnt vmcnt(0)" ::: "memory");
            const unsigned og = xb_add(&bar[XB_TOP], 1u);
            const unsigned tg = og / nx;
            if (og + 1u == (tg + 1u) * nx) xb_add(&bar[XB_TOPGEN], 1u);
            else XB_SPIN(xb_ld(&bar[XB_TOPGEN]) == tg, bar);
            __builtin_amdgcn_fence(__ATOMIC_ACQUIRE, "agent");
            xb_add(&bar[XB_XGEN(x)], 1u);
            asm volatile("s_waitcnt vmcnt(0)" ::: "memory");
        } else {
            XB_SPIN(xb_ld(&bar[XB_XGEN(x)]) == gen, bar);
            __builtin_amdgcn_fence(__ATOMIC_ACQUIRE, "agent");
            asm volatile("s_waitcnt vmcnt(0)" ::: "memory");
        }
    }
    __syncthreads();
}
__device__ __forceinline__ void gsync(unsigned char* wsb, unsigned G, int wave_s) {
    unsigned char* wl_ = wsb; asm volatile("" : "+s"(wl_)); unsigned* ctr = (unsigned*)(wl_ + 1024);
    int ln_; asm volatile("v_mbcnt_lo_u32_b32 %0, -1, 0\n\tv_mbcnt_hi_u32_b32 %0, -1, %0" : "=v"(ln_));
    const bool leader = (wave_s == 0) && (ln_ == 0);
    asm volatile("s_waitcnt vmcnt(0)" ::: "memory");
    __syncthreads();
    if (leader) {
        __builtin_amdgcn_fence(__ATOMIC_RELEASE, "agent");
        asm volatile("s_waitcnt vmcnt(0)" ::: "memory");
        const unsigned old = __hip_atomic_fetch_add(ctr, 1u, __ATOMIC_RELAXED, __HIP_MEMORY_SCOPE_AGENT);
        const unsigned want = (old | (G - 1u)) + 1u;
        while (__hip_atomic_load(ctr, __ATOMIC_RELAXED, __HIP_MEMORY_SCOPE_AGENT) < want) __builtin_amdgcn_s_sleep(2);
        __builtin_amdgcn_fence(__ATOMIC_ACQUIRE, "agent");
        asm volatile("s_waitcnt vmcnt(0)" ::: "memory");
    }
    __syncthreads();
}
__global__ void __launch_bounds__(NTHR, 2) fwd_mega(Params p) {
    extern __shared__ __attribute__((aligned(16))) unsigned char lds_raw[];
    char* lds = (char*)lds_raw;
    PG8_LAS unsigned char* ldsg = (PG8_LAS unsigned char*)lds_raw;
    cg::grid_group grid = cg::this_grid();
    constexpr int G = 256; const int bid = blockIdx.x;
    const int wave_s = __builtin_amdgcn_readfirstlane(threadIdx.x >> 6);
    const int NGW = G * NWAVES;
#define TIDS() int tid; { int ln_; asm volatile("v_mbcnt_lo_u32_b32 %0, -1, 0\n\tv_mbcnt_hi_u32_b32 %0, -1, %0" : "=v"(ln_)); tid = wave_s * 64 + ln_; } const int lane = tid & 63, wave = __builtin_amdgcn_readfirstlane(tid >> 6), gw = bid * NWAVES + wave; (void)lane; (void)gw
    if (threadIdx.x < 38) ((const float**)p.ws)[threadIdx.x] = threadIdx.x < 37 ? p.in[threadIdx.x] : (const float*)p.out;
    if (bid == 0) for (int i = threadIdx.x; i < XCD_BAR_WORDS; i += NTHR) ((unsigned*)(p.ws + 4096))[i] = 0u;
    if (threadIdx.x < 4) ((volatile LAS unsigned*)(ldsg + 147440))[threadIdx.x] = 0u;
    grid.sync();
    if (threadIdx.x == 0) (void)xb_add(&((unsigned*)(p.ws + 4096))[XB_XCNT(xb_xcc_id())], 1u);
#define PTRS() unsigned char* ws = p.ws; asm volatile("" : "+s"(ws)); const float* const* tab = (const float* const*)ws; (void)tab
#define GSYNC() xsync(p.ws, wave_s, (volatile LAS unsigned*)(ldsg + 147440))
#define Wb ((bf16*)(ws + WS_W))
#define P ((bf16*)(ws + WS_P))
#define ACT ((bf16*)(ws + WS_P))
#define H ((bf16*)(ws + WS_H))
#define Y ((float*)(ws + WS_Y))
#define YB ((bf16*)(ws + WS_Y))
#define BRG ((bf16*)(ws + WS_BRG))
#define BRS ((bf16*)(ws + WS_BRS))
#define BRF ((bf16*)(ws + WS_BRF))
#define MIXB ((bf16*)(ws + WS_MIXB))
#define Qb ((bf16*)(ws + WS_Q))
#define XO ((bf16*)(ws + WS_XO))
#define KV ((bf16*)(ws + WS_KV))
#define MEMN ((bf16*)(ws + WS_MEMN))
#define X ((float*)tab[37])

#define GEMM(EpiT, epi, Ap, Bp, Mv, Nv, Kv) do { pg8::Gemm g_{(const pg8::bf16_t*)(Ap), (const pg8::bf16_t*)(Bp), (Mv), (Nv), (Kv)}; int bid_ = bid; const int G_ = G; asm volatile("" : "+s"(bid_)); pg8::StaticOrder S_; S_.init((Mv), (Nv), G_, bid_); \
        TIDS(); pg8::gemm_phase<EpiT, pg8::StaticOrder, true, true>(ldsg, g_, S_, epi, tid); __syncthreads(); } while (0)

    { PTRS(); TIDS();
#if EN_CONV
      convert_weights(ws, tab, 0, lds, gw, NGW, wave, lane);
      s5_prep(ws, tab, 0, bid * NTHR + tid, G * NTHR);
#if REP_CONV > 1
      convert_weights(ws, tab, 0, lds, gw, NGW, wave, lane);
#endif
#endif
      rowop<false, false, true>(tab[1], nullptr, nullptr, nullptr, 0.f, tab[28], MEMN, MMEM, gw, NGW, lane);
      rowop<false, true, true>(tab[0], X, nullptr, nullptr, 0.f, tab[2], H, MTOK, gw, NGW, lane); }
    GSYNC();

    for (int l = 0; l < DEPTH; ++l) {
        { PTRS(); pg8::EpiSwiGLU e{ACT, DFF}; GEMM(pg8::EpiSwiGLU, e, H, Wb + WO_GU1, MTOK, 5632, 1024); }
#if REP_GU > 1
        { PTRS(); pg8::EpiSwiGLU e{ACT, DFF}; GEMM(pg8::EpiSwiGLU, e, H, Wb + WO_GU1, MTOK, 5632, 1024); }
#endif
        GSYNC();
        { PTRS(); pg8::EpiBf16 e{YB, DM}; GEMM(pg8::EpiBf16, e, ACT, Wb + WO_DOWN1, MTOK, 1024, DFF); }
#if REP_DOWN > 1
        { PTRS(); pg8::EpiBf16 e{YB, DM}; GEMM(pg8::EpiBf16, e, ACT, Wb + WO_DOWN1, MTOK, 1024, DFF); }
#endif
        GSYNC();
        { PTRS(); TIDS(); rowop<true, true, true>(X, X, YB, tab[5] + l * DM, 0.5f, tab[6] + l * DM, H, MTOK, gw, NGW, lane); }
#if REP_ROW
        { PTRS(); TIDS(); rowop<true, true, true>(X, (float*)(ws + WS_P), YB, tab[5] + l * DM, 0.5f, tab[6] + l * DM, (bf16*)(ws + WS_P + 64 * MiB), MTOK, gw, NGW, lane); }
#endif
        GSYNC();
        { PTRS(); pg8::EpiBf16VT<0> e{P, LDP, (bf16*)(ws + WS_VT)}; GEMM(pg8::EpiBf16VT<0>, e, H, Wb + WO_IN, MTOK, LDP, 1024); }
#if REP_IN > 1
        { PTRS(); pg8::EpiBf16VT<0> e{P, LDP, (bf16*)(ws + WS_VT)}; GEMM(pg8::EpiBf16VT<0>, e, H, Wb + WO_IN, MTOK, LDP, 1024); }
#endif
        { PTRS(); pg8::EpiBf16VT<1> e{KV, 2048, (bf16*)(ws + WS_VTX)}; GEMM(pg8::EpiBf16VT<1>, e, MEMN, Wb + WO_KV, MMEM, 2048, 1024); }
#if REP_IN > 1
        { PTRS(); pg8::EpiBf16VT<1> e{KV, 2048, (bf16*)(ws + WS_VTX)}; GEMM(pg8::EpiBf16VT<1>, e, MEMN, Wb + WO_KV, MMEM, 2048, 1024); }
#endif
        GSYNC();
        for (int rep_ = 0; rep_ < REP_MIXA; ++rep_) {
#if EN_S5A
        for (int r2_ = 0; r2_ < REP_S5A; ++r2_) { PTRS(); TIDS(); s5_passA(ws, tab, lds, gw, NGW, wave, lane); }
#endif
#if EN_GLAA
        for (int r2_ = 0; r2_ < REP_GLAA; ++r2_) { PTRS(); TIDS(); for (int u = bid; u < 256; u += G) gla_passA(ws, tab, l, lds, u, tid); }
#endif
#if EN_FOX
        for (int r2_ = 0; r2_ < REP_FOX; ++r2_) { PTRS(); TIDS();
          for (int pr = bid; pr < 512; pr += G) {
            const int bh = pr >> 3, pp = pr & 7, b = bh >> 3, h = bh & 7;
            float* Fc = (float*)(lds + 24576); float* red = (float*)(lds + 24576 + 8192);
            __syncthreads();
            fox_cumsum(P, b, h, tab[23][l * 8 + h], Fc, red, tid);
            for (int hf = 0; hf < 2; ++hf) { const int qb = hf ? 15 - pp : pp;
                const size_t rq = (size_t)(b * SEQ + qb * 128);
                attn_unit<64, true>(lds, P + rq * LDP + PC_FQ + h * 64, LDP, P + (size_t)(b * SEQ) * LDP + PC_FK + h * 64, LDP, (const bf16*)(ws + WS_VT) + (size_t)((b * 8 + h) * 64) * 2048, 2048,
                                    BRF + rq * 512 + h * 64, 512, qb * 128, 2 * qb + 2, 2 * qb, Fc, 0.125f, tid); }
          } }
#endif
        }
        GSYNC();
        for (int rep_ = 0; rep_ < REP_MIXC; ++rep_) {
#if EN_S5C
        for (int r2_ = 0; r2_ < REP_S5C; ++r2_) { PTRS(); TIDS(); for (int u = bid; u < 256; u += G) s5_passC(ws, tab, l, lds, u, tid); }
#endif
#if EN_GLAC
        for (int r2_ = 0; r2_ < REP_GLAC; ++r2_) { PTRS(); TIDS(); for (int u = bid; u < 256; u += G) gla_passC_mfma(ws, tab, l, lds, u, tid); }
#endif
        }
        GSYNC();
        { PTRS(); pg8::EpiMerge<0> e{YB, MIXB, P + PC_GATE, LDP}; GEMM(pg8::EpiMerge<0>, e, BRG, Wb + WO_GLAUP, MTOK, 1024, 256); }
        { PTRS(); pg8::EpiMerge<1> e{YB, MIXB, P + PC_GATE + 1024, LDP}; GEMM(pg8::EpiMerge<1>, e, BRS, Wb + WO_S5UP, MTOK, 1024, 256); }
        { PTRS(); pg8::EpiMerge<2> e{YB, MIXB, P + PC_GATE + 2048, LDP}; GEMM(pg8::EpiMerge<2>, e, BRF, Wb + WO_FOXUP, MTOK, 1024, 512); }
#if REP_MERGE > 1
        { PTRS(); pg8::EpiMerge<0> e{YB, MIXB, P + PC_GATE, LDP}; GEMM(pg8::EpiMerge<0>, e, BRG, Wb + WO_GLAUP, MTOK, 1024, 256); }
        { PTRS(); pg8::EpiMerge<1> e{YB, MIXB, P + PC_GATE + 1024, LDP}; GEMM(pg8::EpiMerge<1>, e, BRS, Wb + WO_S5UP, MTOK, 1024, 256); }
        { PTRS(); pg8::EpiMerge<2> e{YB, MIXB, P + PC_GATE + 2048, LDP}; GEMM(pg8::EpiMerge<2>, e, BRF, Wb + WO_FOXUP, MTOK, 1024, 512); }
#endif
        GSYNC();
        { PTRS(); pg8::EpiBf16 e{YB, DM}; GEMM(pg8::EpiBf16, e, MIXB, Wb + WO_MIXOUT, MTOK, 1024, 1024); }
#if REP_SQ > 1
        { PTRS(); pg8::EpiBf16 e{YB, DM}; GEMM(pg8::EpiBf16, e, MIXB, Wb + WO_MIXOUT, MTOK, 1024, 1024); }
#endif
        GSYNC();
        { PTRS(); TIDS(); rowop<true, true, true>(X, X, YB, tab[26] + l * DM, 1.0f, tab[27] + l * DM, H, MTOK, gw, NGW, lane); }
#if REP_ROW
        { PTRS(); TIDS(); rowop<true, true, true>(X, (float*)(ws + WS_P), YB, tab[26] + l * DM, 1.0f, tab[27] + l * DM, (bf16*)(ws + WS_P + 64 * MiB), MTOK, gw, NGW, lane); }
#endif
        GSYNC();
        { PTRS(); pg8::EpiBf16 e{Qb, DM}; GEMM(pg8::EpiBf16, e, H, Wb + WO_Q, MTOK, 1024, 1024); }
#if REP_SQ > 1
        { PTRS(); pg8::EpiBf16 e{Qb, DM}; GEMM(pg8::EpiBf16, e, H, Wb + WO_Q, MTOK, 1024, 1024); }
#endif
        GSYNC();
#if EN_XA
        for (int rep_ = 0; rep_ < REP_XA; ++rep_)
        { PTRS(); TIDS();
          for (int u = bid; u < 512; u += G) { const int qb = u & 15, hd = (u >> 4) & 3, b = u >> 6;
            const size_t rq = (size_t)(b * SEQ + qb * 128);
            attn_unit<256, false>(lds, Qb + rq * DM + hd * 256, DM, KV + (size_t)(b * NMEM) * 2048 + hd * 256, 2048, (const bf16*)(ws + WS_VTX) + (size_t)((b * 4 + hd) * 256) * 256, 256,
                                  XO + rq * DM + hd * 256, DM, 0, 4, 0, nullptr, 0.0625f, tid); } }
#endif
        GSYNC();
        { PTRS(); pg8::EpiBf16 e{YB, DM}; GEMM(pg8::EpiBf16, e, XO, Wb + WO_O, MTOK, 1024, 1024); }
#if REP_SQ > 1
        { PTRS(); pg8::EpiBf16 e{YB, DM}; GEMM(pg8::EpiBf16, e, XO, Wb + WO_O, MTOK, 1024, 1024); }
#endif
        GSYNC();
        { PTRS(); TIDS(); rowop<true, true, true>(X, X, YB, tab[32] + l * DM, 1.0f, tab[33] + l * DM, H, MTOK, gw, NGW, lane); }
#if REP_ROW
        { PTRS(); TIDS(); rowop<true, true, true>(X, (float*)(ws + WS_P), YB, tab[32] + l * DM, 1.0f, tab[33] + l * DM, (bf16*)(ws + WS_P + 64 * MiB), MTOK, gw, NGW, lane); }
#endif
        GSYNC();
        { PTRS(); pg8::EpiSwiGLU e{ACT, DFF}; GEMM(pg8::EpiSwiGLU, e, H, Wb + WO_GU2, MTOK, 5632, 1024); }
#if REP_GU > 1
        { PTRS(); pg8::EpiSwiGLU e{ACT, DFF}; GEMM(pg8::EpiSwiGLU, e, H, Wb + WO_GU2, MTOK, 5632, 1024); }
#endif
        GSYNC();
        { PTRS(); pg8::EpiBf16 e{YB, DM}; GEMM(pg8::EpiBf16, e, ACT, Wb + WO_DOWN2, MTOK, 1024, DFF); }
#if REP_DOWN > 1
        { PTRS(); pg8::EpiBf16 e{YB, DM}; GEMM(pg8::EpiBf16, e, ACT, Wb + WO_DOWN2, MTOK, 1024, DFF); }
#endif
        GSYNC();
        if (l + 1 < DEPTH) {
            { PTRS(); TIDS(); rowop<true, true, true>(X, X, YB, tab[36] + l * DM, 0.5f, tab[2] + (l + 1) * DM, H, MTOK, gw, NGW, lane); }
#if REP_ROW
            { PTRS(); TIDS(); rowop<true, true, true>(X, (float*)(ws + WS_P), YB, tab[36] + l * DM, 0.5f, tab[2] + (l + 1) * DM, (bf16*)(ws + WS_P + 64 * MiB), MTOK, gw, NGW, lane); }
#endif
            __syncthreads();
            { PTRS(); TIDS();
#if EN_CONV
              convert_weights(ws, tab, l + 1, lds, gw, NGW, wave, lane);
              s5_prep(ws, tab, l + 1, bid * NTHR + tid, G * NTHR);
#if REP_CONV > 1
              convert_weights(ws, tab, l + 1, lds, gw, NGW, wave, lane);
#endif
#endif
              rowop<false, false, true>(tab[1], nullptr, nullptr, nullptr, 0.f, tab[28] + (l + 1) * DM, MEMN, MMEM, gw, NGW, lane); }
            GSYNC();
        } else {
            { PTRS(); TIDS(); rowop<true, true, false>(X, X, YB, tab[36] + l * DM, 0.5f, nullptr, nullptr, MTOK, gw, NGW, lane); }
        }
    }
}

extern "C" void kernel_launch(void* const* d_in, const int* in_sizes, int n_in, void* d_out, int out_size, void* d_ws, size_t ws_size, hipStream_t stream) {
    static int grid = 0;
    if (grid == 0) {
        if (n_in != 37 || out_size != MTOK * DM || ws_size < WS_END) { fprintf(stderr, "kernel_launch: unexpected shapes (n_in %d out %d ws %zu need %zu)\n", n_in, out_size, ws_size, (size_t)WS_END); grid = -1; return; }
        int dev = 0, cus = 0, per_cu = 0;
        hipGetDevice(&dev); hipDeviceGetAttribute(&cus, hipDeviceAttributeMultiprocessorCount, dev);
        if (hipFuncSetAttribute((const void*)fwd_mega, hipFuncAttributeMaxDynamicSharedMemorySize, LDS_BYTES) != hipSuccess) { fprintf(stderr, "kernel_launch: hipFuncSetAttribute failed\n"); grid = -1; return; }
        hipOccupancyMaxActiveBlocksPerMultiprocessor(&per_cu, (const void*)fwd_mega, NTHR, LDS_BYTES);
        (void)hipGetLastError();
        if (per_cu < 1) { fprintf(stderr, "kernel_launch: occupancy query says %d blocks/CU\n", per_cu); }
        if (cus < 256) { fprintf(stderr, "kernel_launch: needs 256 CUs, device has %d\n", cus); grid = -1; return; }
        grid = 256;
    }
    if (grid < 0) return;
    Params p{};
    for (int i = 0; i < 37; ++i) p.in[i] = (const float*)d_in[i];
    p.out = (float*)d_out; p.ws = (unsigned char*)d_ws;
    void* args[] = {&p};
    hipError_t e = hipLaunchCooperativeKernel((const void*)fwd_mega, dim3(grid), dim3(NTHR), args, LDS_BYTES, stream);
    if (e != hipSuccess) fprintf(stderr, "cooperative launch failed: %s (grid %d)\n", hipGetErrorString(e), grid);
}
```
